# Optimizing an MI355X kernel written in HIP

```python
import jax
import jax.numpy as jnp
from jax import lax
import numpy as np


D_MODEL = 2048
BATCH = 16
SEQ = 2048
DEPTH = 2

HEAD_DIM = 128
RET_HEADS = 8
RET_W = RET_HEADS * HEAD_DIM
RET_CHUNK = 128
ROPE_BASE = 10000.0
NSA_HEADS = 8
NSA_KV_HEADS = 2
NSA_Q_W = NSA_HEADS * HEAD_DIM
NSA_KV_W = NSA_KV_HEADS * HEAD_DIM
NSA_N_BRANCH = 3
CMP_LEN = 32
CMP_STRIDE = 16
SEL_BLOCK = 64
SEL_TOPK = 16
NSA_WINDOW = 512
NSA_Q_BLOCK = 16
BAND_BLOCK = 128
CONV_W = 1024
CONV_K = 31
DIL_PATTERNS = ((128, 1), (512, 4), (2048, 16))
DIL_GROUP_HEADS = 4
DIL_HEADS = DIL_GROUP_HEADS * len(DIL_PATTERNS)
DIL_QKV_W = DIL_HEADS * HEAD_DIM
DIL_OUT_W = DIL_GROUP_HEADS * HEAD_DIM
EVEN_SPLITS = (RET_W, RET_W, RET_W, RET_W, NSA_Q_W, NSA_KV_W, NSA_KV_W, NSA_KV_W, NSA_KV_W, NSA_KV_W, NSA_KV_W, NSA_N_BRANCH * NSA_HEADS, NSA_Q_W)
EVEN_IN = sum(EVEN_SPLITS)
EVEN_MIX_W = RET_W + NSA_Q_W
ODD_SPLITS = (CONV_W, CONV_W, CONV_W, DIL_QKV_W, DIL_QKV_W, DIL_QKV_W, DIL_OUT_W)
ODD_IN = sum(ODD_SPLITS)
ODD_MIX_W = CONV_W + DIL_OUT_W
N_EVEN = (DEPTH + 1) // 2
N_ODD = DEPTH // 2
NORM_EPS = 1e-6
NEG_INF = -1e30

kernel_name = 'hybrid_retnet_nsa_conformer_dilated'


def rms_norm(x, gain):
    xf = x.astype(jnp.float32)
    y = xf * lax.rsqrt(jnp.mean(xf * xf, axis=-1, keepdims=True) + NORM_EPS)
    return (y * gain.astype(jnp.float32)).astype(x.dtype)


def split_cols(h, sizes):
    offs = np.cumsum(np.array(sizes))[:-1].tolist()
    return jnp.split(h, offs, axis=-1)


def heads(t, n):
    B, S, _ = t.shape
    return t.reshape(B, S, n, -1).transpose(0, 2, 1, 3)


def merge(t):
    B, n, S, d = t.shape
    return t.transpose(0, 2, 1, 3).reshape(B, S, n * d)


def rotary(t, pos):
    d = t.shape[-1]
    half = d // 2
    inv = ROPE_BASE ** (-jnp.arange(half, dtype=jnp.float32) / half)
    ang = pos.astype(jnp.float32)[:, None] * inv[None, :]
    cos, sin = jnp.cos(ang), jnp.sin(ang)
    tf = t.astype(jnp.float32)
    t1, t2 = tf[..., :half], tf[..., half:]
    return jnp.concatenate([t1 * cos - t2 * sin, t2 * cos + t1 * sin], axis=-1).astype(t.dtype)


def retention_chunkwise(q, k, v):
    B, H, S, d = q.shape
    C = RET_CHUNK
    N = S // C
    log_g = jnp.log(1.0 - 2.0 ** (-5.0 - jnp.arange(H, dtype=jnp.float32)))
    idx = jnp.arange(C, dtype=jnp.float32)
    diff = idx[:, None] - idx[None, :]
    dmask = jnp.where(diff >= 0, jnp.exp(jnp.maximum(diff, 0.0)[None] * log_g[:, None, None]), 0.0)
    qc = q.astype(jnp.float32).reshape(B, H, N, C, d)
    kc = (k.astype(jnp.float32) * d ** -0.5).reshape(B, H, N, C, d)
    vc = v.astype(jnp.float32).reshape(B, H, N, C, d)
    scores = jnp.einsum('bhncd,bhnmd->bhncm', qc, kc) * dmask[:, None]
    o_inner = jnp.einsum('bhncm,bhnme->bhnce', scores, vc)
    k_dec = jnp.exp((C - 1 - idx)[None, :] * log_g[:, None])
    kv = jnp.einsum('bhnmd,bhnme->nbhde', kc * k_dec[:, None, :, None], vc)
    chunk_dec = jnp.exp(C * log_g)[:, None, None]

    def step(state, kv_i):
        return chunk_dec * state + kv_i, state

    _, state_prev = lax.scan(step, jnp.zeros((B, H, d, d), jnp.float32), kv)
    q_dec = jnp.exp((idx + 1.0)[None, :] * log_g[:, None])
    o_cross = jnp.einsum('bhncd,nbhde->bhnce', qc * q_dec[:, None, :, None], state_prev)
    return (o_inner + o_cross).reshape(B, H, S, d)


def banded_attention(q, k, v, max_dist, block):
    B, G, R, L, d = q.shape
    nb = -(-L // block)
    Lp = nb * block
    pad_end = Lp - L
    qp = jnp.pad(q, ((0, 0), (0, 0), (0, 0), (0, pad_end), (0, 0)))
    kp = jnp.pad(k, ((0, 0), (0, 0), (max_dist, pad_end), (0, 0)))
    vp = jnp.pad(v, ((0, 0), (0, 0), (max_dist, pad_end), (0, 0)))
    span = block + max_dist
    kidx = np.arange(nb)[:, None] * block + np.arange(span)[None, :]
    kb = kp[:, :, kidx]
    vb = vp[:, :, kidx]
    qb = qp.reshape(B, G, R, nb, block, d)
    s = jnp.einsum('bgrnqd,bgnkd->bgrnqk', qb, kb).astype(jnp.float32) * d ** -0.5
    qpos = np.arange(nb)[:, None] * block + np.arange(block)[None, :]
    kpos = kidx - max_dist
    rel = qpos[:, :, None] - kpos[:, None, :]
    mask = (rel >= 0) & (rel <= max_dist) & (kpos[:, None, :] >= 0)
    s = jnp.where(mask, s, NEG_INF)
    lse = jax.nn.logsumexp(s, axis=-1)
    p = jnp.exp(s - lse[..., None])
    o = jnp.einsum('bgrnqk,bgnkd->bgrnqd', p, vb)
    o = o.reshape(B, G, R, Lp, d)[:, :, :, :L]
    lse = lse.reshape(B, G, R, Lp)[:, :, :, :L]
    return o, lse


def compress(t, pos_emb, w1, w2):
    B, G, S, d = t.shape
    n_cmp = (S - CMP_LEN) // CMP_STRIDE + 1
    idx = np.arange(n_cmp)[:, None] * CMP_STRIDE + np.arange(CMP_LEN)[None, :]
    blk = (t[:, :, idx] + pos_emb).reshape(B, G, n_cmp, CMP_LEN * d)
    return jax.nn.gelu(blk @ w1) @ w2


def compressed_attention(q, kcmp, vcmp):
    B, G, R, S, d = q.shape
    n_cmp = kcmp.shape[2]
    s = jnp.einsum('bgrsd,bgnd->bgrsn', q, kcmp).astype(jnp.float32) * d ** -0.5
    ends = np.arange(n_cmp) * CMP_STRIDE + CMP_LEN - 1
    valid = ends[None, :] <= np.arange(S)[:, None]
    any_valid = valid.any(axis=-1).astype(np.float32)[:, None]
    s = jnp.where(valid, s, NEG_INF)
    p = jax.nn.softmax(s, axis=-1) * any_valid
    o = jnp.einsum('bgrsn,bgnd->bgrsd', p, vcmp)
    return o, p


def select_blocks(p_cmp, S):
    n_cmp = p_cmp.shape[-1]
    n_sel = S // SEL_BLOCK
    cs = np.arange(n_cmp) * CMP_STRIDE
    ss = np.arange(n_sel) * SEL_BLOCK
    overlap = ((cs[:, None] < ss[None, :] + SEL_BLOCK) & (cs[:, None] + CMP_LEN > ss[None, :])).astype(np.float32)
    imp = jnp.einsum('bgrsn,nj->bgsj', p_cmp, jnp.asarray(overlap))
    cur = np.arange(S) // SEL_BLOCK
    j = np.arange(n_sel)
    forced = (j[None, :] == 0) | (j[None, :] == cur[:, None]) | (j[None, :] == cur[:, None] - 1)
    future = j[None, :] > cur[:, None]
    imp = jnp.where(forced, -NEG_INF, jnp.where(future, NEG_INF, imp))
    _, idx = lax.top_k(imp, min(SEL_TOPK, n_sel))
    return idx


def selected_attention(q, k, v, sel_idx):
    B, G, R, S, d = q.shape
    K = sel_idx.shape[-1]
    n_sel = S // SEL_BLOCK
    kb = k.reshape(B, G, n_sel, SEL_BLOCK, d)
    vb = v.reshape(B, G, n_sel, SEL_BLOCK, d)
    nq = S // NSA_Q_BLOCK
    q_c = q.reshape(B, G, R, nq, NSA_Q_BLOCK, d).transpose(3, 0, 1, 2, 4, 5)
    i_c = sel_idx.reshape(B, G, nq, NSA_Q_BLOCK, K).transpose(2, 0, 1, 3, 4)
    t_c = jnp.arange(S).reshape(nq, NSA_Q_BLOCK)
    bi = jnp.arange(B)[:, None, None, None]
    gi = jnp.arange(G)[None, :, None, None]
    offs = jnp.arange(SEL_BLOCK)

    def one(args):
        qb, ib, tb = args
        kg = kb[bi, gi, ib]
        vg = vb[bi, gi, ib]
        s = jnp.einsum('bgrqd,bgqkld->bgrqkl', qb, kg).astype(jnp.float32) * d ** -0.5
        kpos = ib[..., None] * SEL_BLOCK + offs
        ok = kpos <= tb[:, None, None]
        s = jnp.where(ok[:, :, None], s, NEG_INF)
        shp = s.shape
        p = jax.nn.softmax(s.reshape(shp[0], shp[1], shp[2], shp[3], -1), axis=-1).reshape(shp)
        return jnp.einsum('bgrqkl,bgqkld->bgrqd', p, vg)

    o = lax.map(one, (q_c, i_c, t_c))
    return o.transpose(1, 2, 3, 0, 4, 5).reshape(B, G, R, S, d)


def nsa_attention(q, kc, vc, ks, vs, kw, vw, gate_logits, q_g, k_g, pos_k, pos_v, k_w1, k_w2, v_w1, v_w2):
    B, S, _ = q.shape
    G, R = NSA_KV_HEADS, NSA_HEADS // NSA_KV_HEADS
    qh = rms_norm(heads(q, NSA_HEADS), q_g).reshape(B, G, R, S, HEAD_DIM)
    kcmp = rms_norm(compress(heads(kc, G), pos_k, k_w1, k_w2), k_g[0])
    vcmp = compress(heads(vc, G), pos_v, v_w1, v_w2)
    o_cmp, p_cmp = compressed_attention(qh, kcmp, vcmp)
    sel_idx = select_blocks(p_cmp, S)
    o_sel = selected_attention(qh, rms_norm(heads(ks, G), k_g[1]), heads(vs, G), sel_idx)
    o_win, _ = banded_attention(qh, rms_norm(heads(kw, G), k_g[2]), heads(vw, G), NSA_WINDOW - 1, BAND_BLOCK)
    gates = jax.nn.sigmoid(gate_logits.astype(jnp.float32)).reshape(B, S, NSA_N_BRANCH, G, R).transpose(2, 0, 3, 4, 1)[..., None]
    o = gates[0] * o_cmp + gates[1] * o_sel + gates[2] * o_win
    return merge(o.reshape(B, NSA_HEADS, S, HEAD_DIM)).astype(q.dtype)


def conformer_conv(u, g, dw_w, dw_b, ln_g, ln_b):
    a = u * jax.nn.sigmoid(g)
    C = a.shape[-1]
    a = lax.conv_general_dilated(a, dw_w[:, None, :].astype(a.dtype), (1,), [(CONV_K - 1, 0)], dimension_numbers=('NWC', 'WIO', 'NWC'), feature_group_count=C) + dw_b
    af = a.astype(jnp.float32)
    mu = jnp.mean(af, axis=-1, keepdims=True)
    var = jnp.mean(jnp.square(af - mu), axis=-1, keepdims=True)
    a = ((af - mu) * lax.rsqrt(var + NORM_EPS) * ln_g + ln_b).astype(u.dtype)
    return jax.nn.silu(a)


def strided_window_attention(q, k, v, window, dil):
    B, H, S, d = q.shape
    L = S // dil

    def to_sub(t):
        return t.reshape(B, H, L, dil, d).transpose(0, 1, 3, 2, 4).reshape(B, H * dil, L, d)

    o, lse = banded_attention(to_sub(q)[:, :, None], to_sub(k), to_sub(v), window // dil, BAND_BLOCK)
    o = o[:, :, 0].reshape(B, H, dil, L, d).transpose(0, 1, 3, 2, 4).reshape(B, H, S, d)
    lse = lse[:, :, 0].reshape(B, H, dil, L).transpose(0, 1, 3, 2).reshape(B, H, S)
    return o, lse


def dilated_attention(q, k, v, q_g, k_g):
    qh = rms_norm(heads(q, DIL_HEADS), q_g)
    kh = rms_norm(heads(k, DIL_HEADS), k_g)
    vh = heads(v, DIL_HEADS)
    outs, lses = [], []
    for gi, (window, dil) in enumerate(DIL_PATTERNS):
        sl = slice(gi * DIL_GROUP_HEADS, (gi + 1) * DIL_GROUP_HEADS)
        o, lse = strided_window_attention(qh[:, sl], kh[:, sl], vh[:, sl], window, dil)
        outs.append(o)
        lses.append(lse)
    w = jax.nn.softmax(jnp.stack(lses), axis=0)
    o = jnp.sum(w[..., None] * jnp.stack(outs), axis=0)
    return merge(o).astype(q.dtype)


def even_layer(x, norm_g, w_in, w_out, ret_g, nsa_qn, nsa_kn, pos_k, pos_v, k_w1, k_w2, v_w1, v_w2):
    B, S, _ = x.shape
    h = rms_norm(x, norm_g) @ w_in
    rq, rk, rv, rz, nq, kc, vc, ks, vs, kw, vw, ng, nz = split_cols(h, EVEN_SPLITS)
    pos = jnp.arange(S)
    o = retention_chunkwise(rotary(heads(rq, RET_HEADS), pos), rotary(heads(rk, RET_HEADS), pos), heads(rv, RET_HEADS))
    o = rms_norm(o, ret_g[:, None, :]).astype(x.dtype)
    a_out = merge(o) * jax.nn.silu(rz)
    b_out = nsa_attention(nq, kc, vc, ks, vs, kw, vw, ng, nsa_qn, nsa_kn, pos_k, pos_v, k_w1, k_w2, v_w1, v_w2) * jax.nn.silu(nz)
    return x + jnp.concatenate([a_out, b_out], axis=-1) @ w_out


def odd_layer(x, norm_g, w_in, w_out, dw_w, dw_b, cn_g, cn_b, dil_qn, dil_kn):
    h = rms_norm(x, norm_g) @ w_in
    cu, cg, cz, dq, dk, dv, dz = split_cols(h, ODD_SPLITS)
    c_out = conformer_conv(cu, cg, dw_w, dw_b, cn_g, cn_b) * jax.nn.silu(cz)
    d_out = dilated_attention(dq, dk, dv, dil_qn, dil_kn) * jax.nn.silu(dz)
    return x + jnp.concatenate([c_out, d_out], axis=-1) @ w_out


def setup_inputs(seed: int = 0) -> dict:
    key = jax.random.key(seed)
    ks = jax.random.split(key, 24)

    def nrm(k, shape, scale):
        return jax.random.normal(k, shape, jnp.float32) * scale

    def gain(k, shape):
        return 1.0 + 0.02 * jax.random.normal(k, shape, jnp.float32)

    flat = CMP_LEN * HEAD_DIM
    return {
        'x': nrm(ks[0], (BATCH, SEQ, D_MODEL), 1.0),
        'ev_norm': gain(ks[1], (N_EVEN, D_MODEL)),
        'ev_w_in': nrm(ks[2], (N_EVEN, D_MODEL, EVEN_IN), D_MODEL ** -0.5),
        'ev_w_out': nrm(ks[3], (N_EVEN, EVEN_MIX_W, D_MODEL), EVEN_MIX_W ** -0.5),
        'ev_ret_norm': gain(ks[4], (N_EVEN, RET_HEADS, HEAD_DIM)),
        'ev_nsa_q_norm': gain(ks[5], (N_EVEN, HEAD_DIM)),
        'ev_nsa_k_norm': gain(ks[6], (N_EVEN, NSA_N_BRANCH, HEAD_DIM)),
        'ev_cmp_pos_k': nrm(ks[7], (N_EVEN, CMP_LEN, HEAD_DIM), 0.02),
        'ev_cmp_pos_v': nrm(ks[8], (N_EVEN, CMP_LEN, HEAD_DIM), 0.02),
        'ev_cmp_k_w1': nrm(ks[9], (N_EVEN, flat, HEAD_DIM), flat ** -0.5),
        'ev_cmp_k_w2': nrm(ks[10], (N_EVEN, HEAD_DIM, HEAD_DIM), HEAD_DIM ** -0.5),
        'ev_cmp_v_w1': nrm(ks[11], (N_EVEN, flat, HEAD_DIM), flat ** -0.5),
        'ev_cmp_v_w2': nrm(ks[12], (N_EVEN, HEAD_DIM, HEAD_DIM), HEAD_DIM ** -0.5),
        'od_norm': gain(ks[13], (N_ODD, D_MODEL)),
        'od_w_in': nrm(ks[14], (N_ODD, D_MODEL, ODD_IN), D_MODEL ** -0.5),
        'od_w_out': nrm(ks[15], (N_ODD, ODD_MIX_W, D_MODEL), ODD_MIX_W ** -0.5),
        'od_dw_w': nrm(ks[16], (N_ODD, CONV_K, CONV_W), CONV_K ** -0.5),
        'od_dw_b': nrm(ks[17], (N_ODD, CONV_W), 0.01),
        'od_conv_norm_g': gain(ks[18], (N_ODD, CONV_W)),
        'od_conv_norm_b': nrm(ks[19], (N_ODD, CONV_W), 0.01),
        'od_dil_q_norm': gain(ks[20], (N_ODD, HEAD_DIM)),
        'od_dil_k_norm': gain(ks[21], (N_ODD, HEAD_DIM)),
    }


def reference(x, ev_norm, ev_w_in, ev_w_out, ev_ret_norm, ev_nsa_q_norm, ev_nsa_k_norm, ev_cmp_pos_k, ev_cmp_pos_v, ev_cmp_k_w1, ev_cmp_k_w2, ev_cmp_v_w1, ev_cmp_v_w2, od_norm, od_w_in, od_w_out, od_dw_w, od_dw_b, od_conv_norm_g, od_conv_norm_b, od_dil_q_norm, od_dil_k_norm):
    for layer in range(DEPTH):
        i = layer // 2
        if layer % 2 == 0:
            x = even_layer(x, ev_norm[i], ev_w_in[i], ev_w_out[i], ev_ret_norm[i], ev_nsa_q_norm[i], ev_nsa_k_norm[i], ev_cmp_pos_k[i], ev_cmp_pos_v[i], ev_cmp_k_w1[i], ev_cmp_k_w2[i], ev_cmp_v_w1[i], ev_cmp_v_w2[i])
        else:
            x = odd_layer(x, od_norm[i], od_w_in[i], od_w_out[i], od_dw_w[i], od_dw_b[i], od_conv_norm_g[i], od_conv_norm_b[i], od_dil_q_norm[i], od_dil_k_norm[i])
    return x
```

```cpp
#include <hip/hip_runtime.h>
#include <cstdio>
#include <cstdint>
namespace pg8 {
#define PG8_LAS __attribute__((address_space(3)))
typedef unsigned short bf16_t;
typedef short bf16x8 __attribute__((ext_vector_type(8)));
typedef float f32x4 __attribute__((ext_vector_type(4)));
typedef unsigned u32x4 __attribute__((ext_vector_type(4)));
constexpr int BM = 256, BK = 64, HALF = 128, HTB = HALF * BK * 2  , STAGE_BYTES = 8 * HTB, NXCD = 8, WGM = 8;

__host__ __device__ __forceinline__ int lds_byte(int r, int c) { const int st = (r >> 4) * 2 + (c >> 5), rr = r & 15, cc = c & 31, ob = rr * 64 + cc * 2; return st * 1024 + (ob ^ (((ob >> 9) & 1) << 5)); }
__host__ __device__ __forceinline__ void stage_rc(int b, int& R, int& C) { const int st = b / 1024, sb = b % 1024, swz = sb ^ (((sb >> 9) & 1) << 5); R = (st >> 1) * 16 + swz / 64; C = (st & 1) * 32 + (swz % 64) / 2; }
__host__ __device__ __forceinline__ int perm32(int rho) { const int n = rho >> 4, i = rho & 15; return 8 * (i >> 2) + 4 * n + (i & 3); }

struct Unit { int pm, pn; };
struct Gemm { const bf16_t* A; const bf16_t* Bt; int M, N, K; int ktn = 0; };

struct StaticOrder {
    int nM, nN, nwg, G, c;
    __host__ __device__ void init(int M, int N, int G_, int c_) { nM = M / BM; nN = N / BM; nwg = nM * nN; G = G_; c = c_; }
    __host__ __device__ bool next(int i, Unit& u) const {
        const long L = (long)i * G + c; if (L >= nwg) return false;
        int wgid = (int)L; { const int q = nwg / NXCD, r = nwg % NXCD, xcd = wgid % NXCD, off = wgid / NXCD; wgid = (xcd < r ? xcd * (q + 1) : r * (q + 1) + (xcd - r) * q) + off; }
        const int nig = WGM * nN, gid = wgid / nig, fm = gid * WGM, gsz = (nM - fm) < WGM ? (nM - fm) : WGM;
        u.pm = fm + ((wgid % nig) % gsz); u.pn = (wgid % nig) / gsz; return true;
    }
    __device__ __forceinline__ void a_ready(const Unit&) const {}
    __device__ __forceinline__ void done(const Unit&) const {}
};
struct NotifyOrder : StaticOrder {
    unsigned* cnt; unsigned mask;
    __device__ __forceinline__ void done(const Unit& u) const {
        if ((mask >> u.pn) & 1u) {
            asm volatile("s_waitcnt vmcnt(0)" ::: "memory");
            __builtin_amdgcn_s_barrier();
            if (threadIdx.x == 0) { __threadfence(); __hip_atomic_fetch_add(cnt, 1u, __ATOMIC_RELAXED, __HIP_MEMORY_SCOPE_AGENT); }
        }
    }
};
typedef float cvt_f2_t __attribute__((ext_vector_type(2)));
typedef __bf16 cvt_b2_t __attribute__((ext_vector_type(2)));
__device__ __forceinline__ unsigned cvt_pk_bf16(float lo, float hi) { const cvt_f2_t v = {lo, hi}; return __builtin_bit_cast(unsigned, __builtin_convertvector(v, cvt_b2_t)); }

__device__ __forceinline__ float epi_silu(float x) { return x * __builtin_amdgcn_rcpf(1.0f + __builtin_amdgcn_exp2f(x * -1.4426950408889634f)); }
struct EpiH {
    static constexpr bool PERM = true, AFTER_DRAIN = false;
    bf16_t* O; size_t blk_stride; int sa0, sa1, sb0, sb1;
    const float* rope; int nrot;
    __device__ __forceinline__ void operator()(const f32x4 (&acc)[2][2][4][2], const Unit& u, int wr, int wc, int fr, int fq) const {
        const int row0 = u.pm * BM + wr * 64 + fr; const int col0 = wc * 32 + 8 * fq;
#pragma unroll
        for (int bj = 0; bj < 2; ++bj) { const int cb = u.pn * 2 + bj; const bool sl = (cb >= sa0 && cb < sa1) || (cb >= sb0 && cb < sb1);
            if (cb < nrot) {
                const int hh = cb & 7;
                constexpr float LG[8] = {-0.04580368961312479f, -0.02272007650008353f, -0.011315313227834146f, -0.005646563141142063f, -0.0028205190623786626f, -0.0014095702546713536f, -0.0007046129765893727f, -0.0003522634716290214f};
                float lg = LG[0];
#pragma unroll
                for (int k = 1; k < 8; ++k) lg = (hh == k) ? LG[k] : lg;
                const float lgs = cb < 8 ? lg : -lg, fm = cb < 8 ? 0.08838834764831845f : 1.f;
#pragma unroll
                for (int ai = 0; ai < 2; ++ai)
#pragma unroll
                    for (int m = 0; m < 4; ++m) { const int row = row0 + ai * HALF + m * 16, sp = row & 2047;
                        const f32x4 cs = *(const f32x4*)(rope + (size_t)sp * 128 + 16 * wc + 4 * fq), sn = *(const f32x4*)(rope + (size_t)sp * 128 + 64 + 16 * wc + 4 * fq);
                        const float fr_ = __builtin_amdgcn_exp2f((float)sp * lgs) * fm;
                        const f32x4 t1 = acc[ai][bj][m][0], t2 = acc[ai][bj][m][1];
                        const f32x4 o1 = (t1 * cs - t2 * sn) * fr_, o2 = (t2 * cs + t1 * sn) * fr_;
                        bf16_t* rowp = O + (size_t)cb * blk_stride + (size_t)row * 128 + col0;
                        u32x4 w; w.x = cvt_pk_bf16(o1[0], o1[1]); w.y = cvt_pk_bf16(o1[2], o1[3]); w.z = cvt_pk_bf16(o2[0], o2[1]); w.w = cvt_pk_bf16(o2[2], o2[3]);
                        __builtin_nontemporal_store(w, (u32x4*)rowp); }
                continue;
            }
#pragma unroll
            for (int ai = 0; ai < 2; ++ai)
#pragma unroll
                for (int m = 0; m < 4; ++m) { f32x4 v0 = acc[ai][bj][m][0], v1 = acc[ai][bj][m][1];
                    if (sl) { v0 = (f32x4){epi_silu(v0[0]), epi_silu(v0[1]), epi_silu(v0[2]), epi_silu(v0[3])}; v1 = (f32x4){epi_silu(v1[0]), epi_silu(v1[1]), epi_silu(v1[2]), epi_silu(v1[3])}; }
                    bf16_t* rowp = O + (size_t)cb * blk_stride + (size_t)(row0 + ai * HALF + m * 16) * 128 + col0;
                    u32x4 w; w.x = cvt_pk_bf16(v0[0], v0[1]); w.y = cvt_pk_bf16(v0[2], v0[3]); w.z = cvt_pk_bf16(v1[0], v1[1]); w.w = cvt_pk_bf16(v1[2], v1[3]);
                    __builtin_nontemporal_store(w, (u32x4*)rowp); } }
    }
};
struct EpiF32 {
    static constexpr bool PERM = false, AFTER_DRAIN = false;
    float* C; int ldc;
    __device__ __forceinline__ void operator()(const f32x4 (&acc)[2][2][4][2], const Unit& u, int wr, int wc, int fr, int fq) const {
        const int row0 = u.pm * BM + wr * 64 + fr, col0 = u.pn * BM + wc * 32 + 4 * fq;
#pragma unroll
        for (int ai = 0; ai < 2; ++ai)
#pragma unroll
            for (int m = 0; m < 4; ++m) { float* rowp = C + (size_t)(row0 + ai * HALF + m * 16) * ldc + col0;
#pragma unroll
                for (int bj = 0; bj < 2; ++bj)
#pragma unroll
                    for (int n = 0; n < 2; ++n) *(f32x4*)(rowp + bj * HALF + n * 16) = acc[ai][bj][m][n]; }
    }
};
struct EpiRes {
    static constexpr bool PERM = true, AFTER_DRAIN = false;
    const float* base; float* out; int ldc;
    __device__ __forceinline__ void operator()(const f32x4 (&acc)[2][2][4][2], const Unit& u, int wr, int wc, int fr, int fq) const {
        const int row0 = u.pm * BM + wr * 64 + fr, col0 = u.pn * BM + wc * 32 + 8 * fq;
#pragma unroll
        for (int ai = 0; ai < 2; ++ai) {
            f32x4 bs[4][2][2];
#pragma unroll
            for (int m = 0; m < 4; ++m) { const size_t off = (size_t)(row0 + ai * HALF + m * 16) * ldc + col0;
#pragma unroll
                for (int bj = 0; bj < 2; ++bj)
#pragma unroll
                    for (int n = 0; n < 2; ++n) bs[m][bj][n] = *(const f32x4*)(base + off + bj * HALF + n * 4); }
#pragma unroll
            for (int m = 0; m < 4; ++m) { const size_t off = (size_t)(row0 + ai * HALF + m * 16) * ldc + col0;
#pragma unroll
                for (int bj = 0; bj < 2; ++bj)
#pragma unroll
                    for (int n = 0; n < 2; ++n) __builtin_nontemporal_store(bs[m][bj][n] + acc[ai][bj][m][n], (f32x4*)(out + off + bj * HALF + n * 4)); }
            asm volatile("" ::: "memory"); }
    }
};
struct EpiRes2 {
    static constexpr bool PERM = true, AFTER_DRAIN = false;
    const float* base; float* out; bf16_t* xn; float* ss; int ldc;
    __device__ __forceinline__ void operator()(const f32x4 (&acc)[2][2][4][2], const Unit& u, int wr, int wc, int fr, int fq) const {
        const int row0 = u.pm * BM + wr * 64 + fr, col0 = u.pn * BM + wc * 32 + 8 * fq;
#pragma unroll
        for (int ai = 0; ai < 2; ++ai) {
            f32x4 bs[4][2][2];
#pragma unroll
            for (int m = 0; m < 4; ++m) { const size_t off = (size_t)(row0 + ai * HALF + m * 16) * ldc + col0;
#pragma unroll
                for (int bj = 0; bj < 2; ++bj)
#pragma unroll
                    for (int n = 0; n < 2; ++n) bs[m][bj][n] = *(const f32x4*)(base + off + bj * HALF + n * 4); }
#pragma unroll
            for (int m = 0; m < 4; ++m) { const int row = row0 + ai * HALF + m * 16; const size_t off = (size_t)row * ldc + col0;
                float sq = 0.f;
#pragma unroll
                for (int bj = 0; bj < 2; ++bj) { const f32x4 v0 = bs[m][bj][0] + acc[ai][bj][m][0], v1 = bs[m][bj][1] + acc[ai][bj][m][1];
                    __builtin_nontemporal_store(v0, (f32x4*)(out + off + bj * HALF)); __builtin_nontemporal_store(v1, (f32x4*)(out + off + bj * HALF + 4));
                    u32x4 w; w.x = cvt_pk_bf16(v0[0], v0[1]); w.y = cvt_pk_bf16(v0[2], v0[3]); w.z = cvt_pk_bf16(v1[0], v1[1]); w.w = cvt_pk_bf16(v1[2], v1[3]);
                    __builtin_nontemporal_store(w, (u32x4*)(xn + off + bj * HALF));
                    sq += (v0[0] * v0[0] + v0[1] * v0[1]) + (v0[2] * v0[2] + v0[3] * v0[3]) + (v1[0] * v1[0] + v1[1] * v1[1]) + (v1[2] * v1[2] + v1[3] * v1[3]); }
                sq += __shfl_xor(sq, 16); sq += __shfl_xor(sq, 32);
                if (fq == 0) __hip_atomic_fetch_add(ss + row, sq, __ATOMIC_RELAXED, __HIP_MEMORY_SCOPE_AGENT); }
            asm volatile("" ::: "memory"); }
    }
};
struct EpiHS {
    static constexpr bool PERM = true, AFTER_DRAIN = false;
    bf16_t* O; size_t blk_stride; const float* ss; float invk, eps; int nglu, sa0, sa1, sb0, sb1;
    __device__ __forceinline__ void operator()(const f32x4 (&acc)[2][2][4][2], const Unit& u, int wr, int wc, int fr, int fq) const {
        const int row0 = u.pm * BM + wr * 64 + fr; const int col0 = wc * 32 + 8 * fq;
        float rs[2][4];
#pragma unroll
        for (int ai = 0; ai < 2; ++ai)
#pragma unroll
            for (int m = 0; m < 4; ++m) rs[ai][m] = __builtin_amdgcn_rsqf(__hip_atomic_load(ss + row0 + ai * HALF + m * 16, __ATOMIC_RELAXED, __HIP_MEMORY_SCOPE_AGENT) * invk + eps);
        const bool glu = u.pn < nglu;
#pragma unroll
        for (int bj = 0; bj < 2; ++bj) { const int cb = u.pn * 2 + bj; const bool sl = (cb >= sa0 && cb < sa1) || (cb >= sb0 && cb < sb1);
#pragma unroll
            for (int ai = 0; ai < 2; ++ai)
#pragma unroll
                for (int m = 0; m < 4; ++m) { const int row = row0 + ai * HALF + m * 16; f32x4 v0 = acc[ai][bj][m][0] * rs[ai][m], v1 = acc[ai][bj][m][1] * rs[ai][m];
                    if (glu) {
                        const float a0 = v0[0] * __builtin_amdgcn_rcpf(1.0f + __builtin_amdgcn_exp2f(v1[0] * -1.4426950408889634f)), a1 = v0[1] * __builtin_amdgcn_rcpf(1.0f + __builtin_amdgcn_exp2f(v1[1] * -1.4426950408889634f));
                        const float a2 = v0[2] * __builtin_amdgcn_rcpf(1.0f + __builtin_amdgcn_exp2f(v1[2] * -1.4426950408889634f)), a3 = v0[3] * __builtin_amdgcn_rcpf(1.0f + __builtin_amdgcn_exp2f(v1[3] * -1.4426950408889634f));
                        typedef unsigned u32x2 __attribute__((ext_vector_type(2)));
                        u32x2 w; w.x = cvt_pk_bf16(a0, a1); w.y = cvt_pk_bf16(a2, a3);
                        *(u32x2*)(O + (size_t)u.pn * blk_stride + (size_t)row * 128 + 64 * bj + 16 * wc + 4 * fq) = w;
                    } else {
                        if (sl) { v0 = (f32x4){epi_silu(v0[0]), epi_silu(v0[1]), epi_silu(v0[2]), epi_silu(v0[3])}; v1 = (f32x4){epi_silu(v1[0]), epi_silu(v1[1]), epi_silu(v1[2]), epi_silu(v1[3])}; }
                        bf16_t* rowp = O + (size_t)cb * blk_stride + (size_t)row * 128 + col0;
                        u32x4 w; w.x = cvt_pk_bf16(v0[0], v0[1]); w.y = cvt_pk_bf16(v0[2], v0[3]); w.z = cvt_pk_bf16(v1[0], v1[1]); w.w = cvt_pk_bf16(v1[2], v1[3]);
                        __builtin_nontemporal_store(w, (u32x4*)rowp); } } }
    }
};

template <class Epi, class Sched, bool ALIGN_EPI = false, bool SP2 = false>
__device__ __forceinline__ void gemm_phase(PG8_LAS unsigned char* lds, const Gemm g, const Sched& S, const Epi& E) {
    const int tid = threadIdx.x, wid = __builtin_amdgcn_readfirstlane(tid >> 6), lane = tid & 63, wr = wid >> 2, wc = wid & 3, fr = lane & 15, fq = lane >> 4;
    const int K = g.K, nt = g.ktn ? g.ktn : K / BK;
    unsigned voffA[2], voffB[2];
#pragma unroll
    for (int i = 0; i < 2; ++i) { int R, C; stage_rc(tid * 16 + i * 8192, R, C); const int Rb = Epi::PERM ? ((R & ~31) + perm32(R & 31)) : R;
        voffA[i] = (unsigned)(R * K + C) * 2u; voffB[i] = (unsigned)(Rb * K + C) * 2u; }
    const size_t kstep = (size_t)(BK * 2);
    const size_t hstep = (size_t)HALF * K * 2;
    const size_t tstep = 2 * hstep;
    const unsigned ldsw = (unsigned)wid * 1024u;
    const int aoff = lds_byte(wr * 64 + fr, fq * 8), boff = lds_byte(wc * 32 + fr, fq * 8);
#define PG8_SA(b, h) (((b) * 2 + (h)) * HTB)
#define PG8_SB(b, h) ((4 + (b) * 2 + (h)) * HTB)
#define PG8_STAGE(bufoff, gbase, voff) do { _Pragma("unroll") for (int _i = 0; _i < 2; ++_i) \
        __builtin_amdgcn_global_load_lds((const unsigned*)((const char*)(gbase) + (voff)[_i]), (PG8_LAS unsigned*)(lds + (bufoff) + ldsw + _i * 8192), 16, 0, 0); } while (0)
#define PG8_LDA(dst, b, h) do { _Pragma("unroll") for (int m = 0; m < 4; ++m) _Pragma("unroll") for (int k = 0; k < 2; ++k) dst[m][k] = *(const PG8_LAS bf16x8*)(lds + PG8_SA(b, h) + aoff + m * 2048 + k * 1024); } while (0)
#define PG8_LDB(dst, b, h) do { _Pragma("unroll") for (int n = 0; n < 2; ++n) _Pragma("unroll") for (int k = 0; k < 2; ++k) dst[n][k] = *(const PG8_LAS bf16x8*)(lds + PG8_SB(b, h) + boff + n * 2048 + k * 1024); } while (0)
#define PG8_MMA(ai, bj, At, Bt) do { __builtin_amdgcn_s_setprio(1); _Pragma("unroll") for (int m = 0; m < 4; ++m) _Pragma("unroll") for (int n = 0; n < 2; ++n) _Pragma("unroll") for (int k = 0; k < 2; ++k) \
        acc[ai][bj][m][n] = __builtin_amdgcn_mfma_f32_16x16x32_bf16(Bt[n][k], At[m][k], acc[ai][bj][m][n], 0, 0, 0); __builtin_amdgcn_s_setprio(0); } while (0)
#define PG8_WAIT_V(n) asm volatile("s_waitcnt vmcnt(" #n ")" ::: "memory")
#define PG8_WAIT_L(n) asm volatile("s_waitcnt lgkmcnt(" #n ")" ::: "memory")
#define PG8_BAR __builtin_amdgcn_s_barrier()
#define PG8_SCHED __builtin_amdgcn_sched_barrier(0)
    Unit cur, nxt; int ui = 0;
    if (!S.next(0, cur)) return;
    f32x4 acc[2][2][4][2];
#pragma unroll
    for (int a = 0; a < 2; ++a)
#pragma unroll
        for (int b = 0; b < 2; ++b)
#pragma unroll
            for (int m = 0; m < 4; ++m)
#pragma unroll
                for (int n = 0; n < 2; ++n) acc[a][b][m][n] = (f32x4){0.f, 0.f, 0.f, 0.f};
    bf16x8 At[4][2], B0[2][2], B1[2][2];
    const char* cA = (const char*)g.A + (size_t)cur.pm * tstep; const char* cB = (const char*)g.Bt + (size_t)cur.pn * tstep;
    S.a_ready(cur);
    if constexpr (SP2) {
        PG8_STAGE(PG8_SB(0, 0), cB, voffB); PG8_STAGE(PG8_SB(0, 1), cB + hstep, voffB); PG8_STAGE(PG8_SA(0, 0), cA, voffA); PG8_STAGE(PG8_SA(0, 1), cA + hstep, voffA);
        if (wr == 1) PG8_BAR;
        PG8_WAIT_V(2); PG8_BAR;
        PG8_STAGE(PG8_SB(1, 0), cB + kstep, voffB); PG8_STAGE(PG8_SA(1, 0), cA + kstep, voffA); PG8_STAGE(PG8_SB(1, 1), cB + hstep + kstep, voffB);
        PG8_WAIT_V(6); PG8_BAR;
    } else {
        PG8_STAGE(PG8_SB(0, 0), cB, voffB); PG8_STAGE(PG8_SA(0, 0), cA, voffA); PG8_STAGE(PG8_SB(0, 1), cB + hstep, voffB); PG8_STAGE(PG8_SA(0, 1), cA + hstep, voffA);
        if (wr == 1) PG8_BAR;
        PG8_WAIT_V(4); PG8_BAR;
        PG8_STAGE(PG8_SB(1, 0), cB + kstep, voffB); PG8_STAGE(PG8_SA(1, 0), cA + kstep, voffA); PG8_STAGE(PG8_SB(1, 1), cB + hstep + kstep, voffB);
        PG8_WAIT_V(6); PG8_BAR;
    }
    for (;;) {
        const bool has_next = S.next(ui + 1, nxt);
        const char* nA = has_next ? (const char*)g.A + (size_t)nxt.pm * tstep : cA; const char* nB = has_next ? (const char*)g.Bt + (size_t)nxt.pn * tstep : cB;
        for (int t = 0; t < nt; t += 2) {
            const bool last = (t == nt - 2);
            const char* a1 = cA + (size_t)(t + 1) * kstep;
            const char* a2 = last ? nA : cA + (size_t)(t + 2) * kstep; const char* b2 = last ? nB : cB + (size_t)(t + 2) * kstep;
            const char* a3 = a2 + kstep; const char* b3 = b2 + kstep;
            if (last && has_next) S.a_ready(nxt);
            if constexpr (SP2) {
            PG8_LDB(B0, 0, 0); PG8_LDB(B1, 0, 1); PG8_SCHED; PG8_LDA(At, 0, 0); PG8_STAGE(PG8_SA(1, 1), a1 + hstep, voffA);
            PG8_WAIT_V(8); PG8_WAIT_L(0); PG8_BAR; PG8_MMA(0, 0, At, B0); PG8_MMA(0, 1, At, B1); PG8_BAR; PG8_SCHED;
            PG8_LDA(At, 0, 1); PG8_STAGE(PG8_SB(0, 0), b2, voffB); PG8_STAGE(PG8_SB(0, 1), b2 + hstep, voffB); PG8_STAGE(PG8_SA(0, 0), a2, voffA);
            PG8_WAIT_V(8); PG8_WAIT_L(0); PG8_BAR; PG8_MMA(1, 0, At, B0); PG8_MMA(1, 1, At, B1); PG8_BAR; PG8_SCHED;
            PG8_LDB(B0, 1, 0); PG8_LDB(B1, 1, 1); PG8_SCHED; PG8_LDA(At, 1, 0); PG8_STAGE(PG8_SA(0, 1), a2 + hstep, voffA);
            PG8_WAIT_V(8); PG8_WAIT_L(0); PG8_BAR; PG8_MMA(0, 0, At, B0); PG8_MMA(0, 1, At, B1); PG8_BAR; PG8_SCHED;
            PG8_LDA(At, 1, 1); PG8_STAGE(PG8_SB(1, 0), b3, voffB); PG8_STAGE(PG8_SB(1, 1), b3 + hstep, voffB); PG8_STAGE(PG8_SA(1, 0), a3, voffA);
            PG8_WAIT_V(8); PG8_WAIT_L(0); PG8_BAR; PG8_MMA(1, 0, At, B0); PG8_MMA(1, 1, At, B1); PG8_BAR; PG8_SCHED;
            } else {
            PG8_LDB(B0, 0, 0); PG8_SCHED; PG8_LDA(At, 0, 0); PG8_STAGE(PG8_SA(1, 1), a1 + hstep, voffA);
            PG8_WAIT_L(8); PG8_BAR; PG8_WAIT_L(0); PG8_MMA(0, 0, At, B0); PG8_BAR; PG8_SCHED;
            PG8_LDB(B1, 0, 1); PG8_STAGE(PG8_SB(0, 0), b2, voffB);
            PG8_BAR; PG8_WAIT_L(0); PG8_MMA(0, 1, At, B1); PG8_BAR;
            PG8_LDA(At, 0, 1); PG8_STAGE(PG8_SA(0, 0), a2, voffA);
            PG8_BAR; PG8_WAIT_L(0); PG8_MMA(1, 0, At, B0); PG8_BAR; PG8_SCHED;
            PG8_STAGE(PG8_SB(0, 1), b2 + hstep, voffB);
            PG8_WAIT_V(6); PG8_BAR; PG8_MMA(1, 1, At, B1); PG8_BAR;
            PG8_LDB(B0, 1, 0); PG8_SCHED; PG8_LDA(At, 1, 0); PG8_STAGE(PG8_SA(0, 1), a2 + hstep, voffA);
            PG8_WAIT_L(8); PG8_BAR; PG8_WAIT_L(0); PG8_MMA(0, 0, At, B0); PG8_BAR; PG8_SCHED;
            PG8_LDB(B1, 1, 1); PG8_STAGE(PG8_SB(1, 0), b3, voffB);
            PG8_BAR; PG8_WAIT_L(0); PG8_MMA(0, 1, At, B1); PG8_BAR;
            PG8_LDA(At, 1, 1); PG8_STAGE(PG8_SA(1, 0), a3, voffA);
            PG8_BAR; PG8_WAIT_L(0); PG8_MMA(1, 0, At, B0); PG8_BAR; PG8_SCHED;
            PG8_STAGE(PG8_SB(1, 1), b3 + hstep, voffB);
            PG8_WAIT_V(6); PG8_BAR; PG8_MMA(1, 1, At, B1); PG8_BAR;
            }
        }
        if constexpr (ALIGN_EPI) { if (wr == 0) PG8_BAR; }
        if constexpr (!Epi::AFTER_DRAIN) { E(acc, cur, wr, wc, fr, fq); S.done(cur); }
        if (!has_next) break;
#pragma unroll
        for (int a = 0; a < 2; ++a)
#pragma unroll
            for (int b = 0; b < 2; ++b)
#pragma unroll
                for (int m = 0; m < 4; ++m)
#pragma unroll
                    for (int n = 0; n < 2; ++n) acc[a][b][m][n] = (f32x4){0.f, 0.f, 0.f, 0.f};
        cur = nxt; cA = nA; cB = nB; ++ui;
        if constexpr (ALIGN_EPI) { if (wr == 1) PG8_BAR; }
    }
    PG8_WAIT_V(0);
    if constexpr (!ALIGN_EPI) { if (wr == 0) PG8_BAR; }
    PG8_BAR;
    if constexpr (Epi::AFTER_DRAIN) { E.fused(acc, cur, wr, wc, fr, fq, lds, wid, lane); S.done(cur); }
#undef PG8_SA
#undef PG8_SB
#undef PG8_STAGE
#undef PG8_LDA
#undef PG8_LDB
#undef PG8_MMA
#undef PG8_WAIT_V
#undef PG8_WAIT_L
#undef PG8_BAR
#undef PG8_SCHED
}
}

#define GAS __attribute__((address_space(1)))
#define LAS __attribute__((address_space(3)))
typedef unsigned short bf16;
typedef unsigned v4u __attribute__((ext_vector_type(4)));
typedef unsigned v2u __attribute__((ext_vector_type(2)));
typedef float f32x4 __attribute__((ext_vector_type(4)));
typedef float f32x2 __attribute__((ext_vector_type(2)));
typedef float f32x16 __attribute__((ext_vector_type(16)));
typedef short bf16x8 __attribute__((ext_vector_type(8)));
typedef short s16x4 __attribute__((ext_vector_type(4)));
typedef GAS unsigned gu32;
#define RLX_AGENT __ATOMIC_RELAXED, __HIP_MEMORY_SCOPE_AGENT
#define LDS_WAIT() asm volatile("s_waitcnt lgkmcnt(0)" ::: "memory")
#define VM_WAIT() asm volatile("s_waitcnt vmcnt(0)" ::: "memory")
#define SBAR() __builtin_amdgcn_sched_barrier(0)
__device__ __forceinline__ unsigned cvtpk(float lo, float hi) { return pg8::cvt_pk_bf16(lo, hi); }
__device__ __forceinline__ float bflo(unsigned w) { return __uint_as_float(w << 16); }
__device__ __forceinline__ float bfhi(unsigned w) { return __uint_as_float(w & 0xffff0000u); }
__device__ __forceinline__ float bf2f(bf16 v) { return __uint_as_float(((unsigned)v) << 16); }
__device__ __forceinline__ float fast_exp(float x) { return __builtin_amdgcn_exp2f(x * 1.4426950408889634f); }
__device__ __forceinline__ float sigmoidf_(float x) { return __builtin_amdgcn_rcpf(1.0f + fast_exp(-x)); }
__device__ __forceinline__ float siluf_(float x) { return x * sigmoidf_(x); }

#ifndef DBG_SKIP
#define DBG_SKIP 0
#endif
constexpr int NWAVES = 8, NTHREADS = 512;
constexpr int BATCH = 16, SEQ = 2048, DM = 2048, MROWS = BATCH * SEQ;
constexpr int N0 = 7936, NB0 = 62;
constexpr int N1 = 8192, NB1 = 64;
constexpr int K1OUT = 1536;
constexpr float NORM_EPS = 1e-6f;
constexpr float ATT_SCALE = 0.08838834764831845f;
constexpr int CB_RQ = 0, CB_RK = 8, CB_RV = 16, CB_RZ = 24, CB_NQ = 32, CB_KC = 40, CB_VC = 42, CB_KS = 44, CB_VS = 46, CB_KW = 48, CB_VW = 50, CB_NG = 52, CB_NZ = 53;
constexpr int CB_CU = 0, CB_CG = 8, CB_CZ = 16, CB_DQ = 24, CB_DK = 36, CB_DV = 48, CB_DZ = 60;

constexpr size_t MiB = 1u << 20;
constexpr size_t WS_CTL = 0, CTL_ZERO_BYTES = 1 * MiB;
constexpr size_t WS_W0IN = 2 * MiB;
constexpr size_t WS_W0OUT = 34 * MiB;
constexpr size_t WS_W1IN = 42 * MiB;
constexpr size_t WS_W1OUT = 74 * MiB;
constexpr size_t WS_CW = 80 * MiB;
constexpr size_t WS_MISC = 82 * MiB;
constexpr size_t WS_KCMP = 84 * MiB;
constexpr size_t WS_CPR = 86 * MiB;
constexpr size_t WS_A = 96 * MiB;
constexpr size_t WS_MIX = 224 * MiB;
constexpr size_t WS_H = 352 * MiB;
constexpr size_t WS_END = 864 * MiB;
constexpr size_t HBLK = (size_t)MROWS * 128;
constexpr size_t ROPE_OFF = 4096;
#ifndef P0_REP_SKIP
#define P0_REP_SKIP 0
#endif
#ifndef CONV_FIN_IN_UNIT
#define CONV_FIN_IN_UNIT 1
#endif
#ifndef DEFER_W1
#define DEFER_W1 0
#endif
#ifndef FOLD_P2
#define FOLD_P2 1
#endif
#ifndef FX_FORCE
#define FX_FORCE 0
#endif
#ifndef FX_CONST
#define FX_CONST 0
#endif
#ifndef FX_NSA
#define FX_NSA 1
#endif
#ifndef FX_DIL
#define FX_DIL 1
#endif
constexpr size_t FXB_OFF = 1280 * 1024;
constexpr size_t WS_DPART = WS_A, WS_DLSE = WS_A + 96 * MiB;
constexpr size_t WS_CPR2 = WS_H + (size_t)62 * 8 * MiB;
constexpr int CW_BAR = 4096;
constexpr int CW_Q = 8192;

constexpr int RING_BYTES = 131072;
constexpr int XTRA_OFF = RING_BYTES;
constexpr int LDS_BYTES = 147456;
constexpr int LDSCTL_OFF = LDS_BYTES - 1024;

#define XB_TMO      128
#define XB_XCNT(j)  (256  + 64 * (j))
#define XB_XSUB(j)  (1280 + 64 * (j))
#define XB_XGEN(j)  (2304 + 64 * (j))
#define XB_TOP      3328
#define XB_TOPGEN   3392
#define XCD_BAR_WORDS 3456
#define XB_SPIN_CAP (1u << 18)

__device__ __forceinline__ unsigned xb_ld(unsigned* p)              { return __hip_atomic_load(p, __ATOMIC_RELAXED, __HIP_MEMORY_SCOPE_AGENT); }
__device__ __forceinline__ unsigned xb_add(unsigned* p, unsigned v) { return __hip_atomic_fetch_add(p, v, __ATOMIC_RELAXED, __HIP_MEMORY_SCOPE_AGENT); }
__device__ __forceinline__ unsigned xb_xcc_id() { return (unsigned)__builtin_amdgcn_s_getreg((3 << 11) | 20) & 0xFu; }
#define XB_SPIN(cond, bar) do { unsigned _sp = 0; while (cond) { __builtin_amdgcn_s_sleep(1); \
    if ((++_sp & 255u) == 0u) { if (xb_ld(&(bar)[XB_TMO])) break; if (_sp > XB_SPIN_CAP) { atomicAdd(&(bar)[XB_TMO], 1u); break; } } } } while (0)

struct XcdBarrier {
    unsigned* bar; unsigned x;
    volatile LAS unsigned* st;
};

__device__ __forceinline__ XcdBarrier xcd_barrier_post(unsigned* bar, volatile LAS unsigned* st) {
    XcdBarrier b; b.bar = bar; b.x = xb_xcc_id(); b.st = st;
    if (threadIdx.x == 0) (void)xb_add(&bar[XB_XCNT(b.x)], 1u);
    return b;
}
__device__ __forceinline__ void xcd_barrier_complete(unsigned* bar, unsigned x, unsigned& nloc, unsigned& nx) {
    const unsigned G = gridDim.x * gridDim.y * gridDim.z;
    unsigned sum, cnt, mine, sp = 0u;
    for (;;) {
        sum = 0u; cnt = 0u; mine = 0u;
#pragma unroll
        for (unsigned j = 0; j < 16; ++j) { const unsigned c = xb_ld(&bar[XB_XCNT(j)]); sum += c; cnt += (c > 0u) ? 1u : 0u; mine = (j == x) ? c : mine; }
        if (sum == G) break;
        __builtin_amdgcn_s_sleep(1);
        if ((++sp & 255u) == 0u) { if (xb_ld(&bar[XB_TMO])) break; if (sp > XB_SPIN_CAP) { atomicAdd(&bar[XB_TMO], 1u); break; } }
    }
    nloc = mine > 0u ? mine : 1u; nx = cnt > 0u ? cnt : 1u;
}

__device__ __forceinline__ void xcd_barrier(const XcdBarrier& b) {
    asm volatile("s_waitcnt vmcnt(0)" ::: "memory");
    __syncthreads();
    if (threadIdx.x == 0) {
        unsigned* bar = b.bar;
        __builtin_amdgcn_s_waitcnt(0);
        unsigned nloc = b.st[0], nx = b.st[1];
        if (nloc == 0u) { xcd_barrier_complete(bar, b.x, nloc, nx); b.st[0] = nloc; b.st[1] = nx; }
        const unsigned old = xb_add(&bar[XB_XSUB(b.x)], 1u);
        const unsigned gen = old / nloc;
        if (old + 1u == (gen + 1u) * nloc) {
            __builtin_amdgcn_fence(__ATOMIC_RELEASE, "agent");
            asm volatile("s_waitcnt vmcnt(0)" ::: "memory");
            const unsigned og = xb_add(&bar[XB_TOP], 1u);
            const unsigned tg = og / nx;
            if (og + 1u == (tg + 1u) * nx) xb_add(&bar[XB_TOPGEN], 1u);
            else XB_SPIN(xb_ld(&bar[XB_TOPGEN]) == tg, bar);
            __builtin_amdgcn_fence(__ATOMIC_ACQUIRE, "agent");
            xb_add(&bar[XB_XGEN(b.x)], 1u);
            asm volatile("s_waitcnt vmcnt(0)" ::: "memory");
        } else {
            XB_SPIN(xb_ld(&bar[XB_XGEN(b.x)]) == gen, bar);
            __builtin_amdgcn_fence(__ATOMIC_ACQUIRE, "agent");
            asm volatile("s_waitcnt vmcnt(0)" ::: "memory");
        }
    }
    __syncthreads();
}


struct Frame {
    LAS unsigned char* lds;
    volatile LAS unsigned* MISC;
    gu32* ctl;
    int tid, lane, wave, G;
    unsigned char* ws;
    const float* in[22];
    float* out;
};
__device__ __forceinline__ float wave_sum(float v) {
#pragma unroll
    for (int o = 1; o < 64; o <<= 1) v += __shfl_xor(v, o);
    return v;
}
__device__ __forceinline__ int wq_first(Frame& F, int q) {
    __syncthreads();
    if (F.tid == 0) F.MISC[16] = __hip_atomic_fetch_add(F.ctl + CW_Q + 64 * q, 1u, RLX_AGENT);
    __syncthreads();
    return (int)F.MISC[16];
}
__device__ __forceinline__ unsigned wq_issue(Frame& F, int q) {
    unsigned r = 0u;
    if (F.tid == 0) r = __hip_atomic_fetch_add(F.ctl + CW_Q + 64 * q, 1u, RLX_AGENT);
    return r;
}
__device__ __forceinline__ int wq_take(Frame& F, unsigned r) {
    __syncthreads();
    if (F.tid == 0) F.MISC[16] = r;
    __syncthreads();
    return (int)F.MISC[16];
}
__device__ __forceinline__ bf16* hblk(Frame& F, int cb) { return (bf16*)(F.ws + WS_H) + (size_t)cb * HBLK; }

namespace att {
constexpr int SHM = 16384;
constexpr int OFF_V = 0, OFF_K = 2 * SHM, OFF_WS = 4 * SHM, OFF_KG = 4 * SHM + 8192 + 24576;
constexpr float THR = 8.f;
#define KSWZ(row, colB) ((row) * 256 + ((colB) ^ (((row) & 7) << 4)))
__device__ __forceinline__ int v_st(int k, int c) { const int kk = (k & ~0xC) | ((k & 4) << 1) | ((k & 8) >> 1); return ((kk >> 3) * 4 + (c >> 5)) * 512 + ((kk & 7) * 32 + (c & 31)) * 2; }
__device__ __forceinline__ int v_rd_base(int lane) { return ((lane & 3) << 3) | (((lane >> 2) & 3) << 6) | (((lane >> 4) & 1) << 5) | (((lane >> 5) & 1) << 8); }
constexpr int v_rd_off(int d0, int ks, int half) { return d0 * 512 + ks * 4096 + half * 2048; }
__device__ __forceinline__ int crow(int r, int hi) { return (r & 3) + 8 * (r >> 2) + 4 * hi; }
__device__ __forceinline__ float xhi_f(float v, int hi) { auto rr = __builtin_amdgcn_permlane32_swap(__float_as_uint(v), __float_as_uint(v), false, false); return __uint_as_float(hi ? rr[0] : rr[1]); }
__device__ __forceinline__ unsigned xhi_u(unsigned v, int hi) { auto rr = __builtin_amdgcn_permlane32_swap(v, v, false, false); return hi ? rr[0] : rr[1]; }
__device__ __forceinline__ void mask_tile(f32x16& p0, f32x16& p1, int dq, unsigned W) {
    const float NEG = -__builtin_inff();
#pragma unroll
    for (int r = 0; r < 16; ++r) {
        const int c = (r & 3) + 8 * (r >> 2);
        if ((unsigned)(dq - c) >= W) p0[r] = NEG;
        if ((unsigned)(dq - c - 32) >= W) p1[r] = NEG;
    }
}
__device__ __forceinline__ void partialSM(f32x16& p0, f32x16& p1, float& m_reg, float& mn, float& alpha) {
    float pmax = p0[0];
#pragma unroll
    for (int r = 1; r < 16; ++r) pmax = fmaxf(pmax, p0[r]);
#pragma unroll
    for (int r = 0; r < 16; ++r) pmax = fmaxf(pmax, p1[r]);
    { auto rr = __builtin_amdgcn_permlane32_swap(__float_as_uint(pmax), __float_as_uint(pmax), false, false);
      pmax = fmaxf(__uint_as_float(rr[0]), __uint_as_float(rr[1])); }
    constexpr float C2 = 1.4426950408889634f * ATT_SCALE;
    if (__builtin_expect(__all((pmax - m_reg) * ATT_SCALE <= THR), 1)) { mn = m_reg; alpha = 1.f; }
    else { mn = fmaxf(m_reg, pmax); alpha = __builtin_amdgcn_exp2f((m_reg - mn) * C2); m_reg = mn; }
    const float mnL = -mn * C2;
#pragma unroll
    for (int r = 0; r < 16; ++r) p0[r] = fmaf(p0[r], C2, mnL);
#pragma unroll
    for (int r = 0; r < 16; ++r) p1[r] = fmaf(p1[r], C2, mnL);
#pragma unroll
    for (int r = 0; r < 16; ++r) p0[r] = __builtin_amdgcn_exp2f(p0[r]);
}
#define ATT_PK4(P, B_, OUT) do { unsigned a0 = cvtpk(P[B_+0], P[B_+1]), a1 = cvtpk(P[B_+2], P[B_+3]);                          \
        unsigned b0 = cvtpk(P[B_+4], P[B_+5]), b1 = cvtpk(P[B_+6], P[B_+7]);                                             \
        auto r0 = __builtin_amdgcn_permlane32_swap(a0, b0, false, false); auto r1 = __builtin_amdgcn_permlane32_swap(a1, b1, false, false); \
        v4u w = {r0[0], r1[0], r0[1], r1[1]}; OUT = *reinterpret_cast<bf16x8*>(&w); } while (0)
__device__ __forceinline__ void pack_p(const f32x16& p0, const f32x16& p1, bf16x8& pa0, bf16x8& pa1, bf16x8& pa2, bf16x8& pa3) {
    ATT_PK4(p0, 0, pa0); ATT_PK4(p0, 8, pa1); ATT_PK4(p1, 0, pa2); ATT_PK4(p1, 8, pa3);
}
__device__ __forceinline__ void finishSM(f32x16& p0, f32x16& p1, float alpha, float& l_reg, bf16x8& pa0, bf16x8& pa1, bf16x8& pa2, bf16x8& pa3) {
#pragma unroll
    for (int r = 0; r < 16; ++r) p1[r] = __builtin_amdgcn_exp2f(p1[r]);
    float ps = 0;
#pragma unroll
    for (int r = 0; r < 16; ++r) ps += p0[r];
#pragma unroll
    for (int r = 0; r < 16; ++r) ps += p1[r];
    { auto rr = __builtin_amdgcn_permlane32_swap(__float_as_uint(ps), __float_as_uint(ps), false, false);
      ps = __uint_as_float(rr[0]) + __uint_as_float(rr[1]); }
    l_reg = l_reg * alpha + ps;
    pack_p(p0, p1, pa0, pa1, pa2, pa3);
}
template <int KB>
__device__ __forceinline__ void qkt(f32x16& p0, f32x16& p1, const LAS char* lds, int r32, int hi, const bf16x8 (&qr)[8]) {
    p0 = f32x16{}; p1 = f32x16{};
    const LAS char* kb[4];
#pragma unroll
    for (int dd = 0; dd < 4; ++dd) kb[dd] = lds + OFF_K + KB * SHM + KSWZ(r32, (dd * 16 + hi * 8) * 2);
    bf16x8 f[2][4];
#define QK_LD(g, s) do { const LAS char* a0_ = kb[(2 * (g)) & 3] + ((2 * (g)) >> 2) * 128; const LAS char* a1_ = kb[(2 * (g) + 1) & 3] + ((2 * (g) + 1) >> 2) * 128; \
        f[s][0] = *reinterpret_cast<const LAS bf16x8*>(a0_); f[s][1] = *reinterpret_cast<const LAS bf16x8*>(a0_ + 32 * 256); \
        f[s][2] = *reinterpret_cast<const LAS bf16x8*>(a1_); f[s][3] = *reinterpret_cast<const LAS bf16x8*>(a1_ + 32 * 256); } while (0)
#define QK_MM(g, s) do { p0 = __builtin_amdgcn_mfma_f32_32x32x16_bf16(f[s][0], qr[2 * (g)], p0, 0, 0, 0); p1 = __builtin_amdgcn_mfma_f32_32x32x16_bf16(f[s][1], qr[2 * (g)], p1, 0, 0, 0); \
        p0 = __builtin_amdgcn_mfma_f32_32x32x16_bf16(f[s][2], qr[2 * (g) + 1], p0, 0, 0, 0); p1 = __builtin_amdgcn_mfma_f32_32x32x16_bf16(f[s][3], qr[2 * (g) + 1], p1, 0, 0, 0); } while (0)
    QK_LD(0, 0); SBAR();
    QK_LD(1, 1); SBAR(); QK_MM(0, 0); SBAR();
    QK_LD(2, 0); SBAR(); QK_MM(1, 1); SBAR();
    QK_LD(3, 1); SBAR(); QK_MM(2, 0); SBAR();
    QK_MM(3, 1); SBAR();
#undef QK_LD
#undef QK_MM
}
template <int VB>
__device__ __forceinline__ void pv_tile(f32x16 (&o)[4], int vb0, bf16x8 pa0, bf16x8 pa1, bf16x8 pa2, bf16x8 pa3) {
#define TRRD(dst, off) asm volatile("ds_read_b64_tr_b16 %0, %1 offset:%2" : "=&v"(dst) : "v"(vb0), "i"(off) : "memory")
#define PV_D0(d0) do { s16x4 l0, l1, l2, l3, h0, h1, h2, h3; constexpr int b_ = VB * SHM + v_rd_off(d0, 0, 0); \
        TRRD(l0, b_); TRRD(h0, b_ + 2048); TRRD(l1, b_ + 4096); TRRD(h1, b_ + 6144); TRRD(l2, b_ + 8192); TRRD(h2, b_ + 10240); TRRD(l3, b_ + 12288); TRRD(h3, b_ + 14336); \
        asm volatile("s_waitcnt lgkmcnt(0)" ::: "memory"); SBAR();   \
        o[d0] = __builtin_amdgcn_mfma_f32_32x32x16_bf16(pa0, (bf16x8){l0[0], l0[1], l0[2], l0[3], h0[0], h0[1], h0[2], h0[3]}, o[d0], 0, 0, 0);   \
        o[d0] = __builtin_amdgcn_mfma_f32_32x32x16_bf16(pa1, (bf16x8){l1[0], l1[1], l1[2], l1[3], h1[0], h1[1], h1[2], h1[3]}, o[d0], 0, 0, 0);   \
        o[d0] = __builtin_amdgcn_mfma_f32_32x32x16_bf16(pa2, (bf16x8){l2[0], l2[1], l2[2], l2[3], h2[0], h2[1], h2[2], h2[3]}, o[d0], 0, 0, 0);   \
        o[d0] = __builtin_amdgcn_mfma_f32_32x32x16_bf16(pa3, (bf16x8){l3[0], l3[1], l3[2], l3[3], h3[0], h3[1], h3[2], h3[3]}, o[d0], 0, 0, 0); } while (0)
    PV_D0(0); PV_D0(1); PV_D0(2); PV_D0(3);
#undef PV_D0
#undef TRRD
}
__device__ __forceinline__ void row_bcast(float v, LAS float* wsf, int r32, int hi, float (&f)[16]) {
    asm volatile("" ::: "memory");
    if (hi == 0) wsf[r32] = v;
    asm volatile("s_waitcnt lgkmcnt(0)" ::: "memory");
#pragma unroll
    for (int r = 0; r < 16; ++r) f[r] = wsf[crow(r, hi)];
    asm volatile("s_waitcnt lgkmcnt(0)" ::: "memory");
}
template <int N> __device__ __forceinline__ float dpp_ror(float v) { return __builtin_bit_cast(float, __builtin_amdgcn_update_dpp(0, __builtin_bit_cast(int, v), 0x120 + N, 0xf, 0xf, false)); }
__device__ __forceinline__ float row16_sum(float v) { v += dpp_ror<8>(v); v += dpp_ror<4>(v); v += dpp_ror<2>(v); v += dpp_ror<1>(v); return v; }
__device__ __forceinline__ void norm_row8(bf16x8& k, const LAS float* g8) {
    v4u w = *reinterpret_cast<v4u*>(&k);
    float x[8] = {bflo(w.x), bfhi(w.x), bflo(w.y), bfhi(w.y), bflo(w.z), bfhi(w.z), bflo(w.w), bfhi(w.w)};
    float ss = 0.f;
#pragma unroll
    for (int e = 0; e < 8; ++e) ss += x[e] * x[e];
    ss = row16_sum(ss);
    const float rstd = __builtin_amdgcn_rsqf(ss * (1.f / 128.f) + NORM_EPS);
    const f32x4 g0 = *(const LAS f32x4*)g8, g1 = *(const LAS f32x4*)(g8 + 4);
    w.x = cvtpk(x[0] * rstd * g0.x, x[1] * rstd * g0.y); w.y = cvtpk(x[2] * rstd * g0.z, x[3] * rstd * g0.w);
    w.z = cvtpk(x[4] * rstd * g1.x, x[5] * rstd * g1.y); w.w = cvtpk(x[6] * rstd * g1.z, x[7] * rstd * g1.w);
    k = *reinterpret_cast<bf16x8*>(&w);
}
__device__ __forceinline__ void norm_q(bf16x8 (&qr)[8], const float* g, int hi) {
    float ss = 0.f;
#pragma unroll
    for (int d0 = 0; d0 < 8; ++d0) { const v4u w = *reinterpret_cast<const v4u*>(&qr[d0]);
        const float a0 = bflo(w.x), a1 = bfhi(w.x), a2 = bflo(w.y), a3 = bfhi(w.y), a4 = bflo(w.z), a5 = bfhi(w.z), a6 = bflo(w.w), a7 = bfhi(w.w);
        ss += (a0 * a0 + a1 * a1) + (a2 * a2 + a3 * a3) + (a4 * a4 + a5 * a5) + (a6 * a6 + a7 * a7); }
    ss += xhi_f(ss, hi);
    const float rstd = __builtin_amdgcn_rsqf(ss * (1.f / 128.f) + NORM_EPS);
#pragma unroll
    for (int d0 = 0; d0 < 8; ++d0) { v4u w = *reinterpret_cast<v4u*>(&qr[d0]);
        const f32x4 g0 = *(const f32x4*)(g + d0 * 16 + hi * 8), g1 = *(const f32x4*)(g + d0 * 16 + hi * 8 + 4);
        w.x = cvtpk(bflo(w.x) * rstd * g0.x, bfhi(w.x) * rstd * g0.y); w.y = cvtpk(bflo(w.y) * rstd * g0.z, bfhi(w.y) * rstd * g0.w);
        w.z = cvtpk(bflo(w.z) * rstd * g1.x, bfhi(w.z) * rstd * g1.y); w.w = cvtpk(bflo(w.w) * rstd * g1.z, bfhi(w.w) * rstd * g1.w);
        qr[d0] = *reinterpret_cast<bf16x8*>(&w); }
}
__device__ __forceinline__ void settle_q(bf16x8 (&qr)[8]) {
#pragma unroll
    for (int d0 = 0; d0 < 8; ++d0) { v4u w = *reinterpret_cast<v4u*>(&qr[d0]);
        asm volatile("v_mov_b32 %0, %0\n\tv_mov_b32 %1, %1\n\tv_mov_b32 %2, %2\n\tv_mov_b32 %3, %3" : "+v"(w.x), "+v"(w.y), "+v"(w.z), "+v"(w.w));
        qr[d0] = *reinterpret_cast<bf16x8*>(&w); }
}
struct Stage { bf16x8 k0, k1, v0, v1; };
template <class Pol, class TI>
__device__ __forceinline__ void stage_load(const Pol& P, const TI& ti, Stage& S, int sr, int sc) {
    S.k0 = *reinterpret_cast<const bf16x8*>(P.krow(ti, sr) + sc); S.k1 = *reinterpret_cast<const bf16x8*>(P.krow(ti, 32 + sr) + sc);
    S.v0 = *reinterpret_cast<const bf16x8*>(P.vrow(ti, sr) + sc); S.v1 = *reinterpret_cast<const bf16x8*>(P.vrow(ti, 32 + sr) + sc);
}
__device__ __forceinline__ void stage_write(LAS char* lds, int buf, const Stage& S, int kws, int vst0, int vst1) {
    *(LAS bf16x8*)(lds + OFF_K + buf * SHM + kws) = S.k0; *(LAS bf16x8*)(lds + OFF_K + buf * SHM + kws + 32 * 256) = S.k1;
    *(LAS bf16x8*)(lds + OFF_V + buf * SHM + vst0) = S.v0; *(LAS bf16x8*)(lds + OFF_V + buf * SHM + vst1) = S.v1;
}
template <int BUF, int VAR, class Pol, class TI>
__device__ __forceinline__ void tile_compute(const Pol& P, const TI& ti, LAS char* lds, int vb0, LAS float* wsf, int wid, int r32, int hi,
                                             const bf16x8 (&qr)[8], f32x16 (&o)[4], float& m_reg, float& l_reg) {
    f32x16 p0, p1; bf16x8 pa0, pa1, pa2, pa3;
    if (VAR & 1) { p0 = f32x16{}; p1 = f32x16{}; p0[0] = (float)r32; } else qkt<BUF>(p0, p1, lds, r32, hi, qr);
    if constexpr (Pol::SOFTMAX) {
        P.mask(p0, p1, ti, wid, r32, hi);
        float mn, alpha;
        partialSM(p0, p1, m_reg, mn, alpha);
        if (__any(alpha < 1.f)) {
            float f[16]; row_bcast(alpha, wsf, r32, hi, f);
#pragma unroll
            for (int d = 0; d < 4; ++d)
#pragma unroll
                for (int r = 0; r < 16; ++r) o[d][r] *= f[r];
        }
        finishSM(p0, p1, alpha, l_reg, pa0, pa1, pa2, pa3);
    } else {
        P.weights(p0, p1, ti, wid, r32, hi);
        pack_p(p0, p1, pa0, pa1, pa2, pa3);
    }
    SBAR();
    if (VAR & 2) { o[0][0] += __builtin_bit_cast(float, (int)pa0[0]) + __builtin_bit_cast(float, (int)pa1[0]) + __builtin_bit_cast(float, (int)pa2[0]) + __builtin_bit_cast(float, (int)pa3[0]); } else pv_tile<BUF>(o, vb0, pa0, pa1, pa2, pa3);
}
template <class Pol>
__device__ __forceinline__ void stage_prefetch(const Pol& P, Stage& S0, Stage& S1, int tid) {
    const int sr = tid >> 4, sc = (tid & 15) * 8;
    { const auto ti = P.tile(0); stage_load(P, ti, S0, sr, sc); }
    if (P.ntiles() > 1) { const auto t1 = P.tile(1); stage_load(P, t1, S1, sr, sc); }
}
template <class Pol, int VAR, bool PRE>
__device__ __forceinline__ void att_pass_core(const Pol& P, LAS char* lds, const bf16x8 (&qr)[8], f32x16 (&o)[4], float& m_reg, float& l_reg, int tid, Stage& S0, Stage& S1) {
    const int wid = __builtin_amdgcn_readfirstlane(tid >> 6), lane = tid & 63, r32 = lane & 31, hi = lane >> 5;
    const int sr = tid >> 4, sc = (tid & 15) * 8;
    const int kws = KSWZ(sr, sc * 2), vst0 = v_st(sr, sc), vst1 = v_st(32 + sr, sc);
    const int vb0 = (int)(unsigned)(uintptr_t)(lds + OFF_V) + v_rd_base(lane);
    LAS float* wsf = (LAS float*)(lds + OFF_WS) + wid * 256;
    const int NT = P.ntiles();
    const LAS float* kg = (const LAS float*)(lds + OFF_KG) + sc;
    if constexpr (Pol::KNORM) { int tk = tid; asm volatile("" : "+v"(tk)); if (tk < 128) ((LAS float*)(lds + OFF_KG))[tk] = P.kgain[tk]; }
    { if constexpr (!PRE) { const auto ti = P.tile(0); stage_load(P, ti, S0, sr, sc);
      if (NT > 1) { const auto t1 = P.tile(1); stage_load(P, t1, S1, sr, sc); } }
      if constexpr (Pol::KNORM) { __syncthreads(); norm_row8(S0.k0, kg); norm_row8(S0.k1, kg); }
      stage_write(lds, 0, S0, kws, vst0, vst1);
      if (NT > 2) { const auto t2 = P.tile(2); stage_load(P, t2, S0, sr, sc); } }
    __syncthreads();
    for (int t = 0; t < NT; t += 2) {
        { const auto ti = P.tile(t);
          SBAR();
          if (P.active(ti, wid)) tile_compute<0, VAR>(P, ti, lds, vb0, wsf, wid, r32, hi, qr, o, m_reg, l_reg);
          SBAR();
          if (t + 1 < NT) { if constexpr (Pol::KNORM) { norm_row8(S1.k0, kg); norm_row8(S1.k1, kg); } if (!(VAR & 8)) stage_write(lds, 1, S1, kws, vst0, vst1);
              if (!(VAR & 4) && t + 3 < NT) { const auto tn = P.tile(t + 3); stage_load(P, tn, S1, sr, sc); } }
          if (!(VAR & 16)) __syncthreads(); }
        if (t + 1 >= NT) break;
        { const auto ti = P.tile(t + 1);
          SBAR();
          if (P.active(ti, wid)) tile_compute<1, VAR>(P, ti, lds, vb0, wsf, wid, r32, hi, qr, o, m_reg, l_reg);
          SBAR();
          if (t + 2 < NT) { if constexpr (Pol::KNORM) { norm_row8(S0.k0, kg); norm_row8(S0.k1, kg); } if (!(VAR & 8)) stage_write(lds, 0, S0, kws, vst0, vst1);
              if (!(VAR & 4) && t + 4 < NT) { const auto tn = P.tile(t + 4); stage_load(P, tn, S0, sr, sc); } }
          if (!(VAR & 16)) __syncthreads(); }
    }
}
template <class Pol, int VAR = 0>
__device__ __forceinline__ void att_pass(const Pol& P, LAS char* lds, const bf16x8 (&qr)[8], f32x16 (&o)[4], float& m_reg, float& l_reg, int tid) {
    Stage S0, S1; att_pass_core<Pol, VAR, false>(P, lds, qr, o, m_reg, l_reg, tid, S0, S1);
}
template <class Pol, int VAR = 0>
__device__ __forceinline__ void att_pass_pre(const Pol& P, LAS char* lds, const bf16x8 (&qr)[8], f32x16 (&o)[4], float& m_reg, float& l_reg, int tid, Stage& S0, Stage& S1) {
    att_pass_core<Pol, VAR, true>(P, lds, qr, o, m_reg, l_reg, tid, S0, S1);
}
#ifndef ATT2_KDEPTH
#define ATT2_KDEPTH 1
#endif
template <int KB>
__device__ __forceinline__ void qkt_asm(f32x16& p0, f32x16& p1, const int (&ka)[4], const bf16x8 (&qr)[8]) {
    p0 = f32x16{}; p1 = f32x16{};
    bf16x8 f[2][4];
#define QA_RD(dst, dd, off) asm volatile("ds_read_b128 %0, %1 offset:%2" : "=&v"(dst) : "v"(ka[dd]), "i"(off) : "memory")
#define QA_LD(g, s) do { QA_RD(f[s][0], (2 * (g)) & 3, KB * SHM + ((2 * (g)) >> 2) * 128); QA_RD(f[s][1], (2 * (g)) & 3, KB * SHM + ((2 * (g)) >> 2) * 128 + 8192); \
        QA_RD(f[s][2], (2 * (g) + 1) & 3, KB * SHM + ((2 * (g) + 1) >> 2) * 128); QA_RD(f[s][3], (2 * (g) + 1) & 3, KB * SHM + ((2 * (g) + 1) >> 2) * 128 + 8192); } while (0)
#define QA_MM(g, s) do { p0 = __builtin_amdgcn_mfma_f32_32x32x16_bf16(f[s][0], qr[2 * (g)], p0, 0, 0, 0); p1 = __builtin_amdgcn_mfma_f32_32x32x16_bf16(f[s][1], qr[2 * (g)], p1, 0, 0, 0); \
        p0 = __builtin_amdgcn_mfma_f32_32x32x16_bf16(f[s][2], qr[2 * (g) + 1], p0, 0, 0, 0); p1 = __builtin_amdgcn_mfma_f32_32x32x16_bf16(f[s][3], qr[2 * (g) + 1], p1, 0, 0, 0); } while (0)
#define QA_W(n) asm volatile("s_waitcnt lgkmcnt(" #n ")" ::: "memory")
#if ATT2_KDEPTH == 2
    QA_LD(0, 0); QA_LD(1, 1); QA_W(4); SBAR(); QA_MM(0, 0); SBAR();
    QA_LD(2, 0); QA_W(4); SBAR(); QA_MM(1, 1); SBAR();
    QA_LD(3, 1); QA_W(4); SBAR(); QA_MM(2, 0); SBAR();
    QA_W(0); SBAR(); QA_MM(3, 1); SBAR();
#else
    QA_LD(0, 0); QA_W(0); SBAR(); QA_MM(0, 0); SBAR();
    QA_LD(1, 0); QA_W(0); SBAR(); QA_MM(1, 0); SBAR();
    QA_LD(2, 0); QA_W(0); SBAR(); QA_MM(2, 0); SBAR();
    QA_LD(3, 0); QA_W(0); SBAR(); QA_MM(3, 0); SBAR();
#endif
#undef QA_RD
#undef QA_LD
#undef QA_MM
#undef QA_W
}
template <int BUF, class Pol, class TI>
__device__ __forceinline__ void tile_x(const Pol& P, const TI& ti, const int (&ka)[4], int wid, int r32, int hi, const bf16x8 (&qr)[8], f32x16& p0, f32x16& p1, float& m_reg, float& alpha) {
    qkt_asm<BUF>(p0, p1, ka, qr);
    P.mask(p0, p1, ti, wid, r32, hi);
    float mn; partialSM(p0, p1, m_reg, mn, alpha);
}
template <int BUF>
__device__ __forceinline__ void tile_y(int vb0, LAS float* wsf, int r32, int hi, f32x16 (&o)[4], f32x16& p0, f32x16& p1, float alpha, float& l_reg) {
    if (__any(alpha < 1.f)) {
        float f[16]; row_bcast(alpha, wsf, r32, hi, f);
#pragma unroll
        for (int d = 0; d < 4; ++d)
#pragma unroll
            for (int r = 0; r < 16; ++r) o[d][r] *= f[r];
    }
    bf16x8 pa0, pa1, pa2, pa3;
    finishSM(p0, p1, alpha, l_reg, pa0, pa1, pa2, pa3);
    SBAR();
    pv_tile<BUF>(o, vb0, pa0, pa1, pa2, pa3);
}
template <class Pol>
__device__ __forceinline__ void att_pass2(const Pol& P, LAS char* lds, const bf16x8 (&qr)[8], f32x16 (&o)[4], float& m_reg, float& l_reg, int tid) {
    const int wid = __builtin_amdgcn_readfirstlane(tid >> 6), lane = tid & 63, r32 = lane & 31, hi = lane >> 5;
    const int sr = tid >> 4, sc = (tid & 15) * 8;
    int ka[4];
#pragma unroll
    for (int dd = 0; dd < 4; ++dd) ka[dd] = (int)(unsigned)(uintptr_t)(lds + OFF_K) + KSWZ(r32, (dd * 16 + hi * 8) * 2);
    const int kws = KSWZ(sr, sc * 2), vst0 = v_st(sr, sc), vst1 = v_st(32 + sr, sc);
    const int vb0 = (int)(unsigned)(uintptr_t)(lds + OFF_V) + v_rd_base(lane);
    LAS float* wsf = (LAS float*)(lds + OFF_WS) + wid * 256;
    const bool grpB = wid >= 4;
    const int NT = P.ntiles();
    Stage S;
    const LAS float* kg = (const LAS float*)(lds + OFF_KG) + sc;
    if constexpr (Pol::KNORM) { int tk = tid; asm volatile("" : "+v"(tk)); if (tk < 128) ((LAS float*)(lds + OFF_KG))[tk] = P.kgain[tk]; }
    { const auto ti = P.tile(0); stage_load(P, ti, S, sr, sc);
      if constexpr (Pol::KNORM) { __syncthreads(); norm_row8(S.k0, kg); norm_row8(S.k1, kg); }
      stage_write(lds, 0, S, kws, vst0, vst1);
      if (NT > 1) { const auto t1 = P.tile(1); stage_load(P, t1, S, sr, sc); } }
    __syncthreads();
#define ATT2_STAGE(s_, WB) do { \
        if ((s_) + 1 < NT) { if constexpr (Pol::KNORM) { norm_row8(S.k0, kg); norm_row8(S.k1, kg); } stage_write(lds, WB, S, kws, vst0, vst1); \
            if ((s_) + 2 < NT) { const auto tn = P.tile((s_) + 2); stage_load(P, tn, S, sr, sc); } } } while (0)
#define ATT2_BODY(s_, B_, WB) do { const auto ti = P.tile(s_); f32x16 p0, p1; float alpha = 1.f; const bool act = P.active(ti, wid); \
        if (grpB) ATT2_STAGE(s_, WB); \
        SBAR(); if (act) tile_x<B_>(P, ti, ka, wid, r32, hi, qr, p0, p1, m_reg, alpha); SBAR(); \
        __syncthreads(); \
        SBAR(); if (act) tile_y<B_>(vb0, wsf, r32, hi, o, p0, p1, alpha, l_reg); SBAR(); \
        if (!grpB) ATT2_STAGE(s_, WB); \
        __syncthreads(); } while (0)
    if (grpB) __syncthreads();
    for (int s = 0; s < NT; s += 2) { ATT2_BODY(s, 0, 1); if (s + 1 >= NT) break; ATT2_BODY(s + 1, 1, 0); }
    if (!grpB) __syncthreads();
#undef ATT2_BODY
#undef ATT2_STAGE
}
__device__ __forceinline__ void fx_softmax(f32x16& p0, f32x16& p1, float shiftC2, bf16x8& pa0, bf16x8& pa1, bf16x8& pa2, bf16x8& pa3) {
    constexpr float C2 = 1.4426950408889634f * ATT_SCALE;
#pragma unroll
    for (int r = 0; r < 16; ++r) { p0[r] = __builtin_amdgcn_exp2f(fmaf(p0[r], C2, -shiftC2)); p1[r] = __builtin_amdgcn_exp2f(fmaf(p1[r], C2, -shiftC2)); }
    pack_p(p0, p1, pa0, pa1, pa2, pa3);
}
__device__ __forceinline__ float gain_maxabs(const float* g, int lane) {
    float v = fmaxf(fabsf(g[lane]), fabsf(g[lane + 64]));
#pragma unroll
    for (int off = 1; off < 64; off <<= 1) v = fmaxf(v, __shfl_xor(v, off));
    return __builtin_bit_cast(float, __builtin_amdgcn_readfirstlane(__builtin_bit_cast(int, v)));
}
constexpr float FX_BOUND = 11.313708499f * 1.01f;
constexpr float FX_MAX = 40.f, LOG2E = 1.4426950408889634f;
__device__ __forceinline__ void fx_rowsum(f32x16& lacc, bf16x8 pa0, bf16x8 pa1, bf16x8 pa2, bf16x8 pa3) {
    const bf16x8 ones = (bf16x8){0x3F80, 0x3F80, 0x3F80, 0x3F80, 0x3F80, 0x3F80, 0x3F80, 0x3F80};
    lacc = __builtin_amdgcn_mfma_f32_32x32x16_bf16(pa0, ones, lacc, 0, 0, 0); lacc = __builtin_amdgcn_mfma_f32_32x32x16_bf16(pa1, ones, lacc, 0, 0, 0);
    lacc = __builtin_amdgcn_mfma_f32_32x32x16_bf16(pa2, ones, lacc, 0, 0, 0); lacc = __builtin_amdgcn_mfma_f32_32x32x16_bf16(pa3, ones, lacc, 0, 0, 0);
}
template <int BUF, class Pol, class TI>
__device__ __forceinline__ void tile_compute_fx(const Pol& P, const TI& ti, LAS char* lds, int vb0, int wid, int r32, int hi, const bf16x8 (&qr)[8], f32x16 (&o)[4], f32x16& lacc, float shiftC2) {
    f32x16 p0, p1; bf16x8 pa0, pa1, pa2, pa3;
    qkt<BUF>(p0, p1, lds, r32, hi, qr);
    P.mask(p0, p1, ti, wid, r32, hi);
    fx_softmax(p0, p1, shiftC2, pa0, pa1, pa2, pa3);
    SBAR();
    fx_rowsum(lacc, pa0, pa1, pa2, pa3);
    pv_tile<BUF>(o, vb0, pa0, pa1, pa2, pa3);
}
template <class Pol, bool PRE>
__device__ __forceinline__ void att_pass_fx_core(const Pol& P, LAS char* lds, const bf16x8 (&qr)[8], f32x16 (&o)[4], f32x16& lacc, float shiftC2, int tid, Stage& S0, Stage& S1) {
    const int wid = __builtin_amdgcn_readfirstlane(tid >> 6), lane = tid & 63, r32 = lane & 31, hi = lane >> 5;
    const int sr = tid >> 4, sc = (tid & 15) * 8;
    const int kws = KSWZ(sr, sc * 2), vst0 = v_st(sr, sc), vst1 = v_st(32 + sr, sc);
    const int vb0 = (int)(unsigned)(uintptr_t)(lds + OFF_V) + v_rd_base(lane);
    const int NT = P.ntiles();
    const LAS float* kg = (const LAS float*)(lds + OFF_KG) + sc;
    if constexpr (Pol::KNORM) { int tk = tid; asm volatile("" : "+v"(tk)); if (tk < 128) ((LAS float*)(lds + OFF_KG))[tk] = P.kgain[tk]; }
    { if constexpr (!PRE) { const auto ti = P.tile(0); stage_load(P, ti, S0, sr, sc);
      if (NT > 1) { const auto t1 = P.tile(1); stage_load(P, t1, S1, sr, sc); } }
      if constexpr (Pol::KNORM) { __syncthreads(); norm_row8(S0.k0, kg); norm_row8(S0.k1, kg); }
      stage_write(lds, 0, S0, kws, vst0, vst1);
      if (NT > 2) { const auto t2 = P.tile(2); stage_load(P, t2, S0, sr, sc); } }
    __syncthreads();
    for (int t = 0; t < NT; t += 2) {
        { const auto ti = P.tile(t);
          SBAR();
          if (P.active(ti, wid)) tile_compute_fx<0>(P, ti, lds, vb0, wid, r32, hi, qr, o, lacc, shiftC2);
          SBAR();
          if (t + 1 < NT) { if constexpr (Pol::KNORM) { norm_row8(S1.k0, kg); norm_row8(S1.k1, kg); } stage_write(lds, 1, S1, kws, vst0, vst1);
              if (t + 3 < NT) { const auto tn = P.tile(t + 3); stage_load(P, tn, S1, sr, sc); } }
          __syncthreads(); }
        if (t + 1 >= NT) break;
        { const auto ti = P.tile(t + 1);
          SBAR();
          if (P.active(ti, wid)) tile_compute_fx<1>(P, ti, lds, vb0, wid, r32, hi, qr, o, lacc, shiftC2);
          SBAR();
          if (t + 2 < NT) { if constexpr (Pol::KNORM) { norm_row8(S0.k0, kg); norm_row8(S0.k1, kg); } stage_write(lds, 0, S0, kws, vst0, vst1);
              if (t + 4 < NT) { const auto tn = P.tile(t + 4); stage_load(P, tn, S0, sr, sc); } }
          __syncthreads(); }
    }
}
template <class Pol>
__device__ __forceinline__ void att_pass_fx(const Pol& P, LAS char* lds, const bf16x8 (&qr)[8], f32x16 (&o)[4], f32x16& lacc, float shiftC2, int tid) {
    Stage S0, S1; att_pass_fx_core<Pol, false>(P, lds, qr, o, lacc, shiftC2, tid, S0, S1);
}
template <class Pol>
__device__ __forceinline__ void att_pass_fx_pre(const Pol& P, LAS char* lds, const bf16x8 (&qr)[8], f32x16 (&o)[4], f32x16& lacc, float shiftC2, int tid, Stage& S0, Stage& S1) {
    att_pass_fx_core<Pol, true>(P, lds, qr, o, lacc, shiftC2, tid, S0, S1);
}
constexpr int OFF_V3 = 0, OFF_K3 = 3 * SHM, OFF_WS3 = 6 * SHM;
template <int KB>
__device__ __forceinline__ void qkt3(f32x16& p0, f32x16& p1, const LAS char* lds, int r32, int hi, const bf16x8 (&qr)[8]) {
    p0 = f32x16{}; p1 = f32x16{};
    const LAS char* kb[4];
#pragma unroll
    for (int dd = 0; dd < 4; ++dd) kb[dd] = lds + OFF_K3 + KB * SHM + KSWZ(r32, (dd * 16 + hi * 8) * 2);
    bf16x8 f[2][4];
#define QK_LD(g, s) do { const LAS char* a0_ = kb[(2 * (g)) & 3] + ((2 * (g)) >> 2) * 128; const LAS char* a1_ = kb[(2 * (g) + 1) & 3] + ((2 * (g) + 1) >> 2) * 128; \
        f[s][0] = *reinterpret_cast<const LAS bf16x8*>(a0_); f[s][1] = *reinterpret_cast<const LAS bf16x8*>(a0_ + 32 * 256); \
        f[s][2] = *reinterpret_cast<const LAS bf16x8*>(a1_); f[s][3] = *reinterpret_cast<const LAS bf16x8*>(a1_ + 32 * 256); } while (0)
#define QK_MM(g, s) do { p0 = __builtin_amdgcn_mfma_f32_32x32x16_bf16(f[s][0], qr[2 * (g)], p0, 0, 0, 0); p1 = __builtin_amdgcn_mfma_f32_32x32x16_bf16(f[s][1], qr[2 * (g)], p1, 0, 0, 0); \
        p0 = __builtin_amdgcn_mfma_f32_32x32x16_bf16(f[s][2], qr[2 * (g) + 1], p0, 0, 0, 0); p1 = __builtin_amdgcn_mfma_f32_32x32x16_bf16(f[s][3], qr[2 * (g) + 1], p1, 0, 0, 0); } while (0)
    QK_LD(0, 0); SBAR();
    QK_LD(1, 1); SBAR(); QK_MM(0, 0); SBAR();
    QK_LD(2, 0); SBAR(); QK_MM(1, 1); SBAR();
    QK_LD(3, 1); SBAR(); QK_MM(2, 0); SBAR();
    QK_MM(3, 1); SBAR();
#undef QK_LD
#undef QK_MM
}
template <int BUF, class Pol, class TI>
__device__ __forceinline__ void tile_compute_fx3(const Pol& P, const TI& ti, LAS char* lds, int vb0, int wid, int r32, int hi, const bf16x8 (&qr)[8], f32x16 (&o)[4], f32x16& lacc, float shiftC2) {
    f32x16 p0, p1; bf16x8 pa0, pa1, pa2, pa3;
    qkt3<BUF>(p0, p1, lds, r32, hi, qr);
    float sh = shiftC2;
    if constexpr (Pol::LANEPRED) {
        if (ti.bit == P.cur) P.mask(p0, p1, ti, wid, r32, hi); else sh = ((P.sel >> ti.bit) & 1u) ? shiftC2 : __builtin_inff();
    } else P.mask(p0, p1, ti, wid, r32, hi);
    fx_softmax(p0, p1, sh, pa0, pa1, pa2, pa3);
    SBAR();
    fx_rowsum(lacc, pa0, pa1, pa2, pa3);
    pv_tile<BUF>(o, vb0, pa0, pa1, pa2, pa3);
}
__device__ __forceinline__ void fxd_offsets(int wid, int lane, unsigned (&koff)[2], unsigned (&voff)[2]) {
#pragma unroll
    for (int i = 0; i < 2; ++i) { const int q = wid * 128 + i * 64 + lane;
        { const int row = q >> 4, pos = q & 15; koff[i] = (unsigned)(row * 256 + ((pos ^ (row & 7)) << 4)); }
        { const int sidx = q >> 5, w = q & 31, kk = (sidx >> 2) * 8 + (w >> 2), c = (sidx & 3) * 32 + (w & 3) * 8; const int k = (kk & ~0xC) | ((kk & 4) << 1) | ((kk & 8) >> 1); voff[i] = (unsigned)(k * 256 + c * 2); } }
}
template <class Pol>
__device__ __forceinline__ void fxd_prefetch(const Pol& P, LAS char* lds, int tid) {
    const int wid = __builtin_amdgcn_readfirstlane(tid >> 6), lane = tid & 63;
    unsigned koff[2], voff[2]; fxd_offsets(wid, lane, koff, voff);
    const unsigned ldsw = (unsigned)wid * 2048u;
    const int NT = P.ntiles();
#pragma unroll
    for (int t = 0; t < 2; ++t) { if (t < NT) { const auto ti_ = P.tile(t); const char* kt_ = (const char*)P.krow(ti_, 0); const char* vt_ = (const char*)P.vrow(ti_, 0);
#pragma unroll
        for (int i = 0; i < 2; ++i) {
            __builtin_amdgcn_global_load_lds((const unsigned*)(kt_ + koff[i]), (LAS unsigned*)(lds + OFF_K3 + t * SHM + ldsw + i * 1024), 16, 0, 0);
            __builtin_amdgcn_global_load_lds((const unsigned*)(vt_ + voff[i]), (LAS unsigned*)(lds + OFF_V3 + t * SHM + ldsw + i * 1024), 16, 0, 0); } } }
}
template <class Pol, bool PRE = false>
__device__ __forceinline__ void att_pass_fxd(const Pol& P, LAS char* lds, const bf16x8 (&qr)[8], f32x16 (&o)[4], f32x16& lacc, float shiftC2, int tid) {
    const int wid = __builtin_amdgcn_readfirstlane(tid >> 6), lane = tid & 63, r32 = lane & 31, hi = lane >> 5;
    const int vb0 = (int)(unsigned)(uintptr_t)(lds + OFF_V3) + v_rd_base(lane);
    const int NT = P.ntiles();
    unsigned koff[2], voff[2]; fxd_offsets(wid, lane, koff, voff);
    const unsigned ldsw = (unsigned)wid * 2048u;
#define DMA_BAR() do { asm volatile("s_waitcnt lgkmcnt(0)" ::: "memory"); __builtin_amdgcn_s_barrier(); asm volatile("" ::: "memory"); } while (0)
#define DMA_TILE(t_, buf_) do { const auto ti_ = P.tile(t_); const char* kt_ = (const char*)P.krow(ti_, 0); const char* vt_ = (const char*)P.vrow(ti_, 0); \
        _Pragma("unroll") for (int i = 0; i < 2; ++i) { \
            __builtin_amdgcn_global_load_lds((const unsigned*)(kt_ + koff[i]), (LAS unsigned*)(lds + OFF_K3 + (buf_) * SHM + ldsw + i * 1024), 16, 0, 0); \
            __builtin_amdgcn_global_load_lds((const unsigned*)(vt_ + voff[i]), (LAS unsigned*)(lds + OFF_V3 + (buf_) * SHM + ldsw + i * 1024), 16, 0, 0); } } while (0)
    if constexpr (PRE) asm volatile("s_waitcnt vmcnt(0)" ::: "memory");
    else { DMA_TILE(0, 0);
        if (NT > 1) { DMA_TILE(1, 1); asm volatile("s_waitcnt vmcnt(4)" ::: "memory"); } else asm volatile("s_waitcnt vmcnt(0)" ::: "memory"); }
    DMA_BAR();
#define DMA_STEP(t_, B_, BN2_) do { const auto ti = P.tile(t_); \
        if ((t_) + 2 < NT) DMA_TILE((t_) + 2, BN2_);                        \
        SBAR(); \
        if (P.active(ti, wid)) tile_compute_fx3<B_>(P, ti, lds, vb0, wid, r32, hi, qr, o, lacc, shiftC2); \
        SBAR(); \
        if ((t_) + 2 < NT) asm volatile("s_waitcnt vmcnt(4)" ::: "memory"); else asm volatile("s_waitcnt vmcnt(0)" ::: "memory");     \
        DMA_BAR(); } while (0)
    for (int t = 0; t < NT; t += 3) {
        DMA_STEP(t, 0, 2);
        if (t + 1 >= NT) break;
        DMA_STEP(t + 1, 1, 0);
        if (t + 2 >= NT) break;
        DMA_STEP(t + 2, 2, 1);
    }
    __syncthreads();
#undef DMA_STEP
#undef DMA_TILE
#undef DMA_BAR
}
}

template <int MAP>
__device__ __forceinline__ int src_col(int n) {
    if (MAP == 0) return n;
    if (MAP == 2) {
        if (n >= 2048) return n;
        const int pn = n >> 8, q = (n >> 3) & 31, e = n & 7, c = 128 * pn + 4 * q + (e & 3);
        return e < 4 ? c : 1024 + c;
    }
    const int cb = n >> 7, c = n & 127;
    if (cb < 16) { const int q8 = c >> 3, e = c & 7; return cb * 128 + (e < 4 ? 4 * q8 + e : 64 + 4 * q8 + (e - 4)); }
    if (cb < 52) return n;
    if (cb == 52) return c < 24 ? 6656 + c : -1;
    if (cb < 61) return 6680 + (cb - 53) * 128 + c;
    return -1;
}
template <int MAP>
__device__ __forceinline__ void p0_transpose_item(const float* W, int K, int N, int ldw, const float* gk, bf16* WT, LAS float* scr, int item, int lane) {
    const int nblk = N / 32, kb = item / nblk, nb = item % nblk, k0 = 64 * kb, n0 = 32 * nb;
    const int sc = src_col<MAP>(n0 + (lane & 31));
    float vv[32];
#pragma unroll
    for (int i = 0; i < 32; ++i) { const int kk = 2 * i + (lane >> 5); vv[i] = (sc >= 0) ? __builtin_nontemporal_load(W + (size_t)(k0 + kk) * ldw + sc) : 0.f; }
    if (gk) {
        const float g0 = gk[k0 + (lane & 31) * 2 + (lane >> 5)];
#pragma unroll
        for (int i = 0; i < 32; ++i) vv[i] *= __shfl(g0, i + (lane & 32));
    }
#pragma unroll
    for (int i = 0; i < 32; ++i) { const int kk = 2 * i + (lane >> 5); scr[kk * 33 + (lane & 31)] = vv[i]; }
    LDS_WAIT(); asm volatile("" ::: "memory");
    const int c = lane & 7;
#pragma unroll
    for (int j = 0; j < 4; ++j) { const int n = (lane >> 3) + 8 * j; const LAS float* s = scr + (8 * c) * 33 + n;
        v4u o; o.x = cvtpk(s[0 * 33], s[1 * 33]); o.y = cvtpk(s[2 * 33], s[3 * 33]); o.z = cvtpk(s[4 * 33], s[5 * 33]); o.w = cvtpk(s[6 * 33], s[7 * 33]);
        *(v4u*)(WT + (size_t)(n0 + n) * K + k0 + 8 * c) = o; }
    LDS_WAIT(); asm volatile("" ::: "memory");
}
__device__ __forceinline__ void rms_row_to_bf16(const float* xrow, bf16* orow, int lane) {
    const f32x4* xr = (const f32x4*)xrow + lane;
    f32x4 v[8]; float s = 0.f;
#pragma unroll
    for (int j = 0; j < 8; ++j) { v[j] = xr[64 * j]; s += (v[j].x * v[j].x + v[j].y * v[j].y) + (v[j].z * v[j].z + v[j].w * v[j].w); }
    const float rstd = __builtin_amdgcn_rsqf(wave_sum(s) * (1.f / DM) + NORM_EPS);
    v2u* o8 = (v2u*)orow + lane;
#pragma unroll
    for (int j = 0; j < 8; ++j) { v2u w; w.x = cvtpk(v[j].x * rstd, v[j].y * rstd); w.y = cvtpk(v[j].z * rstd, v[j].w * rstd); o8[64 * j] = w; }
}
__device__ __forceinline__ void rms_row2_to_bf16(const float* xrow, bf16* orow, int lane) {
    const f32x4* xr = (const f32x4*)xrow + lane;
    f32x4 v[16]; float s0 = 0.f, s1 = 0.f;
#pragma unroll
    for (int j = 0; j < 16; ++j) v[j] = __builtin_nontemporal_load(xr + 64 * j);
#pragma unroll
    for (int j = 0; j < 8; ++j) { s0 += (v[j].x * v[j].x + v[j].y * v[j].y) + (v[j].z * v[j].z + v[j].w * v[j].w); s1 += (v[8 + j].x * v[8 + j].x + v[8 + j].y * v[8 + j].y) + (v[8 + j].z * v[8 + j].z + v[8 + j].w * v[8 + j].w); }
    const float r0 = __builtin_amdgcn_rsqf(wave_sum(s0) * (1.f / DM) + NORM_EPS), r1 = __builtin_amdgcn_rsqf(wave_sum(s1) * (1.f / DM) + NORM_EPS);
    v2u* o8 = (v2u*)orow + lane;
#pragma unroll
    for (int j = 0; j < 16; ++j) { const float r = j < 8 ? r0 : r1; v2u w; w.x = cvtpk(v[j].x * r, v[j].y * r); w.y = cvtpk(v[j].z * r, v[j].w * r); o8[64 * j] = w; }
}
constexpr int P0_IA = (DM / 64) * (N0 / 32);
constexpr int P0_IB = (2048 / 64) * (DM / 32);
constexpr int P0_IC = (DM / 64) * (N1 / 32);
constexpr int P0_ID = (K1OUT / 64) * (DM / 32);
constexpr int P0_IE = (2048 / 64) * (128 / 32);
constexpr int P0_NITEMS = P0_IA + P0_IB + P0_IC + P0_ID + 4 * P0_IE;
constexpr int P0_DEFER = 5120;
__device__ __forceinline__ void p0_weight_items(Frame& F, int first, int last, int stride) {
    LAS float* scr = (LAS float*)(F.lds + F.wave * 16384);
    bf16* W0IN = (bf16*)(F.ws + WS_W0IN); bf16* W0OUT = (bf16*)(F.ws + WS_W0OUT); bf16* W1IN = (bf16*)(F.ws + WS_W1IN); bf16* W1OUT = (bf16*)(F.ws + WS_W1OUT); bf16* CW = (bf16*)(F.ws + WS_CW);
    for (int it = first; it < last; it += stride) {
        int r = it;
        if (r < P0_IA) { p0_transpose_item<1>(F.in[2], DM, N0, 7704, F.in[1], W0IN, scr, r, F.lane); continue; } r -= P0_IA;
        if (r < P0_IB) { p0_transpose_item<0>(F.in[3], 2048, DM, DM, nullptr, W0OUT, scr, r, F.lane); continue; } r -= P0_IB;
        if (r < 4 * P0_IE) { const int q = r / P0_IE, rr = r % P0_IE, kv = q >> 1, half = q & 1;
            p0_transpose_item<0>(F.in[kv ? 11 : 9] + (size_t)half * 2048 * 128, 2048, 128, 128, nullptr, CW + (size_t)kv * 256 * 2048 + (size_t)half * 128 * 2048, scr, rr, F.lane); continue; } r -= 4 * P0_IE;
        if (r < P0_IC) { p0_transpose_item<2>(F.in[14], DM, N1, N1, F.in[13], W1IN, scr, r, F.lane); continue; } r -= P0_IC;
        p0_transpose_item<0>(F.in[15], K1OUT, DM, DM, nullptr, W1OUT, scr, r, F.lane);
    }
}
template <int SKIP = 0>
__device__ __forceinline__ void p0_prologue(Frame& F, int defer = 0) {
    const int gw = blockIdx.x * NWAVES + F.wave, NGW = F.G * NWAVES;
    if (!(SKIP & 1)) p0_weight_items(F, gw, P0_NITEMS - defer, NGW);
    bf16* XN = (bf16*)(F.ws + WS_A);
    if (!(SKIP & 2)) for (int m = 2 * gw; m < MROWS; m += 2 * NGW) rms_row2_to_bf16(F.in[0] + (size_t)m * DM, XN + (size_t)m * DM, F.lane);
    float* rope = (float*)(F.ws + WS_MISC + ROPE_OFF);
    for (int e = blockIdx.x * NTHREADS + F.tid; e < SEQ * 64; e += F.G * NTHREADS) {
        const int s = e >> 6, i = e & 63;
        double iv = 1.0; for (int k = 0; k < i; ++k) iv *= 0.8659643233600653;
        const float ang = (float)s * (float)iv;
        const double x = (double)ang; const double q = __builtin_rint(x * 0.6366197723675814); const double r = __builtin_fma(-q, 1.5707963267948966, x) - q * 6.123233995736766e-17;
        const double r2 = r * r;
        double sp = -7.647163731819816e-13; sp = sp * r2 + 1.6059043836821613e-10; sp = sp * r2 - 2.505210838544172e-08; sp = sp * r2 + 2.7557319223985893e-06; sp = sp * r2 - 1.984126984126984e-04; sp = sp * r2 + 8.333333333333333e-03; sp = sp * r2 - 1.6666666666666666e-01;
        const double sn = r + r * r2 * sp;
        double cp = 4.779477332387385e-14; cp = cp * r2 - 1.1470745597729725e-11; cp = cp * r2 + 2.08767569878681e-09; cp = cp * r2 - 2.755731922398589e-07; cp = cp * r2 + 2.48015873015873e-05; cp = cp * r2 - 1.388888888888889e-03; cp = cp * r2 + 4.1666666666666664e-02; cp = cp * r2 - 0.5;
        const double cs = 1.0 + r2 * cp;
        const int qi = ((int)q) & 3;
        const double sv = (qi == 0) ? sn : (qi == 1) ? cs : (qi == 2) ? -sn : -cs;
        const double cv = (qi == 0) ? cs : (qi == 1) ? -sn : (qi == 2) ? -cs : sn;
        rope[(size_t)s * 128 + i] = (float)cv; rope[(size_t)s * 128 + 64 + i] = (float)sv;
    }
    if (blockIdx.x == 0 && F.wave == 0) {
        const float a = att::gain_maxabs(F.in[5], F.lane), ks = att::gain_maxabs(F.in[6] + 128, F.lane), kw = att::gain_maxabs(F.in[6] + 256, F.lane);
        const float dq = att::gain_maxabs(F.in[20], F.lane), dk = att::gain_maxabs(F.in[21], F.lane);
        float* fxb = (float*)(F.ws + WS_MISC + FXB_OFF);
        const float kc = att::gain_maxabs(F.in[6], F.lane);
        if (F.lane == 0) { fxb[0] = att::FX_BOUND * a * ks; fxb[1] = att::FX_BOUND * a * kw; fxb[2] = att::FX_BOUND * dq * dk; fxb[3] = att::FX_BOUND * a * kc; }
    }
    { float* cbp = (float*)(F.ws + WS_MISC + 1536 * 1024);
      for (int it = gw; it < 64; it += NGW) { const int kv = it >> 5, pt = it & 31;
          const float* pos = F.in[kv ? 8 : 7] + pt * 128; const float* w1 = F.in[kv ? 11 : 9] + (size_t)pt * 128 * 128;
          float s0 = 0.f, s1 = 0.f;
#pragma unroll 8
          for (int kk = 0; kk < 128; ++kk) { const float pv = pos[kk]; s0 += pv * w1[(size_t)kk * 128 + F.lane]; s1 += pv * w1[(size_t)kk * 128 + 64 + F.lane]; }
          cbp[(size_t)it * 128 + F.lane] = s0; cbp[(size_t)it * 128 + 64 + F.lane] = s1; } }
}

template <int MODE>
__device__ __forceinline__ void rowop_item(bf16* blk, int row0, const float* g, const float* rope, int tid, float lgs = 0.f, float fmul = 1.f) {
    const int c = tid & 15, rr = tid >> 4;
#pragma unroll 2
    for (int p = 0; p < 8; ++p) {
        const int row = row0 + p * 32 + rr;
        v4u* ptr = (v4u*)(blk + (size_t)row * 128 + c * 8);
        const v4u w = *ptr;
        float x[8] = {bflo(w.x), bfhi(w.x), bflo(w.y), bfhi(w.y), bflo(w.z), bfhi(w.z), bflo(w.w), bfhi(w.w)};
        float y[8];
        if (MODE == 0) {
            v4u pw; pw.x = __shfl_xor(w.x, 8); pw.y = __shfl_xor(w.y, 8); pw.z = __shfl_xor(w.z, 8); pw.w = __shfl_xor(w.w, 8);
            const float px[8] = {bflo(pw.x), bfhi(pw.x), bflo(pw.y), bfhi(pw.y), bflo(pw.z), bfhi(pw.z), bflo(pw.w), bfhi(pw.w)};
            const int s = row & (SEQ - 1), i0 = (c & 7) * 8;
            const f32x4 c0 = *(const f32x4*)(rope + (size_t)s * 128 + i0), c1 = *(const f32x4*)(rope + (size_t)s * 128 + i0 + 4);
            const f32x4 s0 = *(const f32x4*)(rope + (size_t)s * 128 + 64 + i0), s1 = *(const f32x4*)(rope + (size_t)s * 128 + 64 + i0 + 4);
            const float cs[8] = {c0.x, c0.y, c0.z, c0.w, c1.x, c1.y, c1.z, c1.w}, sn[8] = {s0.x, s0.y, s0.z, s0.w, s1.x, s1.y, s1.z, s1.w};
            const float sg = (c < 8) ? -1.f : 1.f;
            const float fr = __builtin_amdgcn_exp2f((float)s * lgs) * fmul;
#pragma unroll
            for (int k = 0; k < 8; ++k) y[k] = (x[k] * cs[k] + sg * px[k] * sn[k]) * fr;
        } else {
            float ss = 0.f;
#pragma unroll
            for (int k = 0; k < 8; ++k) ss += x[k] * x[k];
            ss += __shfl_xor(ss, 1); ss += __shfl_xor(ss, 2); ss += __shfl_xor(ss, 4); ss += __shfl_xor(ss, 8);
            const float rstd = __builtin_amdgcn_rsqf(ss * (1.f / 128.f) + NORM_EPS);
            const f32x4 g0 = *(const f32x4*)(g + c * 8), g1 = *(const f32x4*)(g + c * 8 + 4);
            const float gg[8] = {g0.x, g0.y, g0.z, g0.w, g1.x, g1.y, g1.z, g1.w};
#pragma unroll
            for (int k = 0; k < 8; ++k) y[k] = x[k] * rstd * gg[k];
        }
        v4u o; o.x = cvtpk(y[0], y[1]); o.y = cvtpk(y[2], y[3]); o.z = cvtpk(y[4], y[5]); o.w = cvtpk(y[6], y[7]);
        *ptr = o;
    }
}

__device__ __forceinline__ void cmp_tail_unit(Frame& F, int unit) {
    const int kv = unit >> 5, b = (unit >> 1) & 15, g = unit & 1;
    int tid = F.tid; asm volatile("" : "+v"(tid));
    LAS float* Ws = (LAS float*)F.lds;
    LAS float* Gt = (LAS float*)(F.lds + 65536);
    const float* cpr = (const float*)(F.ws + WS_CPR) + (size_t)kv * 4096 * 256;
    const float* cpr2 = (const float*)(F.ws + WS_CPR2) + (size_t)kv * 4096 * 256;
    LAS float* bias = (LAS float*)(F.lds + 65536 + 66048);
    if (tid < 128) { const float* cbp = (const float*)(F.ws + WS_MISC + 1536 * 1024) + (size_t)kv * 32 * 128 + tid; float sb = 0.f;
#pragma unroll 8
        for (int pt = 0; pt < 32; ++pt) sb += cbp[pt * 128];
        bias[tid] = sb; }
    __syncthreads();
    const float* w2 = F.in[kv ? 12 : 10];
    const int rbase = g * 2048 + b * 128;
    for (int idx = tid; idx < 128 * 128; idx += NTHREADS) {
        const int n = idx >> 7, j = idx & 127;
        Ws[idx] = w2[idx];
        float v = 0.f;
        if (n < 127) {
            const float pre = (cpr[(size_t)(rbase + n) * 256 + j] + cpr2[(size_t)(rbase + n) * 256 + j]) + (cpr[(size_t)(rbase + n + 1) * 256 + 128 + j] + cpr2[(size_t)(rbase + n + 1) * 256 + 128 + j]) + bias[j];
            const float u = 0.7978845608028654f * (pre + 0.044715f * pre * pre * pre);
            const float th = 1.0f - 2.0f * __builtin_amdgcn_rcpf(fast_exp(2.0f * u) + 1.0f);
            v = 0.5f * pre * (1.0f + th);
        }
        Gt[j * 129 + n] = v;
    }
    __syncthreads();
    const int n = tid >> 2, cg = tid & 3;
    float acc[32];
#pragma unroll
    for (int c = 0; c < 32; ++c) acc[c] = 0.f;
    for (int j = 0; j < 128; ++j) {
        const float a = Gt[j * 129 + n];
        const LAS f32x4* wr = (const LAS f32x4*)(Ws + j * 128 + cg * 32);
#pragma unroll
        for (int q = 0; q < 8; ++q) { const f32x4 w = wr[q]; acc[4 * q] += a * w.x; acc[4 * q + 1] += a * w.y; acc[4 * q + 2] += a * w.z; acc[4 * q + 3] += a * w.w; }
    }
    if (kv == 0) {
        float ss = 0.f;
#pragma unroll
        for (int c = 0; c < 32; ++c) ss += acc[c] * acc[c];
        ss += __shfl_xor(ss, 1); ss += __shfl_xor(ss, 2);
        const float rstd = __builtin_amdgcn_rsqf(ss * (1.f / 128.f) + NORM_EPS);
        const float* kg = F.in[6];
#pragma unroll
        for (int c = 0; c < 32; ++c) acc[c] *= rstd * kg[cg * 32 + c];
    }
    bf16* dst = (bf16*)(F.ws + WS_KCMP) + ((size_t)kv * 32 + (b * 2 + g)) * 128 * 128 + (size_t)n * 128 + cg * 32;
#pragma unroll
    for (int q = 0; q < 4; ++q) { v4u o;
        o.x = cvtpk(acc[8 * q], acc[8 * q + 1]); o.y = cvtpk(acc[8 * q + 2], acc[8 * q + 3]); o.z = cvtpk(acc[8 * q + 4], acc[8 * q + 5]); o.w = cvtpk(acc[8 * q + 6], acc[8 * q + 7]);
        if (n == 127) o = (v4u){0u, 0u, 0u, 0u};
        *(v4u*)(dst + 8 * q) = o; }
}

struct PolRet {
    static constexpr bool SOFTMAX = false, KNORM = false;
    const bf16 *Kb, *Vb; int t0; const float* kgain;
    struct TI { int kb; };
    __device__ __forceinline__ int ntiles() const { return 4; }
    __device__ __forceinline__ TI tile(int t) const { return TI{t0 + 64 * t}; }
    __device__ __forceinline__ const bf16* krow(const TI& ti, int i) const { return Kb + (size_t)(ti.kb + i) * 128; }
    __device__ __forceinline__ const bf16* vrow(const TI& ti, int i) const { return Vb + (size_t)(ti.kb + i) * 128; }
    __device__ __forceinline__ bool active(const TI& ti, int wid) const { return ti.kb <= t0 + 32 * wid + 31; }
    __device__ __forceinline__ void weights(f32x16& p0, f32x16& p1, const TI& ti, int wid, int r32, int hi) const {
        const int qlo = t0 + 32 * wid;
        if (ti.kb + 63 > qlo) {
            const int dq = qlo + r32 - ti.kb - 4 * hi;
#pragma unroll
            for (int r = 0; r < 16; ++r) { const int c = (r & 3) + 8 * (r >> 2);
                p0[r] = (dq - c >= 0) ? p0[r] : 0.f; p1[r] = (dq - c - 32 >= 0) ? p1[r] : 0.f; }
        }
    }
};
constexpr size_t WS_TST = WS_A + 64 * MiB;
__device__ __forceinline__ void ret_state_unit(Frame& F, int unit) {
    int tid = F.tid; asm volatile("" : "+v"(tid));
    const int wid = F.wave, lane = tid & 63, r32 = lane & 31, hi = lane >> 5;
    const int b = unit >> 3, h = unit & 7;
    const size_t rowb = (size_t)b * SEQ;
    const bf16* Kb = hblk(F, CB_RK + h) + rowb * 128; const bf16* Vb = hblk(F, CB_RV + h) + rowb * 128;
    bf16* tst = (bf16*)(F.ws + WS_TST) + (size_t)unit * 7 * 16384;
    LAS char* lds = (LAS char*)F.lds;
    const int sr = tid >> 4, sc = (tid & 15) * 8, vst0 = att::v_st(sr, sc), vst1 = att::v_st(32 + sr, sc);
    const int a = wid >> 1, c0 = 2 * (wid & 1);
    const int vbK = (int)(unsigned)(uintptr_t)(lds + att::OFF_K) + att::v_rd_base(lane) + a * 512;
    const int vbV = (int)(unsigned)(uintptr_t)(lds + att::OFF_V) + att::v_rd_base(lane) + c0 * 512;
    f32x16 acc0 = {}, acc1 = {};
    bf16x8 k0, k1, v0, v1;
#define RS_LOAD(t_) do { k0 = *reinterpret_cast<const bf16x8*>(Kb + (size_t)(64 * (t_) + sr) * 128 + sc); k1 = *reinterpret_cast<const bf16x8*>(Kb + (size_t)(64 * (t_) + 32 + sr) * 128 + sc); \
        v0 = *reinterpret_cast<const bf16x8*>(Vb + (size_t)(64 * (t_) + sr) * 128 + sc); v1 = *reinterpret_cast<const bf16x8*>(Vb + (size_t)(64 * (t_) + 32 + sr) * 128 + sc); } while (0)
#define RS_WRITE(buf_) do { *(LAS bf16x8*)(lds + att::OFF_K + (buf_) * att::SHM + vst0) = k0; *(LAS bf16x8*)(lds + att::OFF_K + (buf_) * att::SHM + vst1) = k1; \
        *(LAS bf16x8*)(lds + att::OFF_V + (buf_) * att::SHM + vst0) = v0; *(LAS bf16x8*)(lds + att::OFF_V + (buf_) * att::SHM + vst1) = v1; } while (0)
#define RS_TR(dst, base, off) asm volatile("ds_read_b64_tr_b16 %0, %1 offset:%2" : "=&v"(dst) : "v"(base), "i"(off) : "memory")
#define RS_COMPUTE(BUF) do { _Pragma("unroll") for (int ks = 0; ks < 4; ++ks) { s16x4 al, ah, bl0, bh0, bl1, bh1; \
            if (ks == 0) { RS_TR(al, vbK, BUF * att::SHM + 0); RS_TR(ah, vbK, BUF * att::SHM + 2048); RS_TR(bl0, vbV, BUF * att::SHM + 0); RS_TR(bh0, vbV, BUF * att::SHM + 2048); RS_TR(bl1, vbV, BUF * att::SHM + 512); RS_TR(bh1, vbV, BUF * att::SHM + 512 + 2048); } \
            if (ks == 1) { RS_TR(al, vbK, BUF * att::SHM + 4096); RS_TR(ah, vbK, BUF * att::SHM + 4096 + 2048); RS_TR(bl0, vbV, BUF * att::SHM + 4096); RS_TR(bh0, vbV, BUF * att::SHM + 4096 + 2048); RS_TR(bl1, vbV, BUF * att::SHM + 4096 + 512); RS_TR(bh1, vbV, BUF * att::SHM + 4096 + 512 + 2048); } \
            if (ks == 2) { RS_TR(al, vbK, BUF * att::SHM + 8192); RS_TR(ah, vbK, BUF * att::SHM + 8192 + 2048); RS_TR(bl0, vbV, BUF * att::SHM + 8192); RS_TR(bh0, vbV, BUF * att::SHM + 8192 + 2048); RS_TR(bl1, vbV, BUF * att::SHM + 8192 + 512); RS_TR(bh1, vbV, BUF * att::SHM + 8192 + 512 + 2048); } \
            if (ks == 3) { RS_TR(al, vbK, BUF * att::SHM + 12288); RS_TR(ah, vbK, BUF * att::SHM + 12288 + 2048); RS_TR(bl0, vbV, BUF * att::SHM + 12288); RS_TR(bh0, vbV, BUF * att::SHM + 12288 + 2048); RS_TR(bl1, vbV, BUF * att::SHM + 12288 + 512); RS_TR(bh1, vbV, BUF * att::SHM + 12288 + 512 + 2048); } \
            asm volatile("s_waitcnt lgkmcnt(0)" ::: "memory"); SBAR(); \
            const bf16x8 A_ = (bf16x8){al[0], al[1], al[2], al[3], ah[0], ah[1], ah[2], ah[3]}; \
            acc0 = __builtin_amdgcn_mfma_f32_32x32x16_bf16(A_, (bf16x8){bl0[0], bl0[1], bl0[2], bl0[3], bh0[0], bh0[1], bh0[2], bh0[3]}, acc0, 0, 0, 0); \
            acc1 = __builtin_amdgcn_mfma_f32_32x32x16_bf16(A_, (bf16x8){bl1[0], bl1[1], bl1[2], bl1[3], bh1[0], bh1[1], bh1[2], bh1[3]}, acc1, 0, 0, 0); } } while (0)
#define RS_STORE(t_) do { if (((t_) & 3) == 3) { bf16* tp = tst + (size_t)((t_) >> 2) * 16384; \
            _Pragma("unroll") for (int r = 0; r < 16; ++r) { const int row = 32 * a + att::crow(r, hi); \
                const float x0 = acc0[r], x0n = __shfl_xor(x0, 1), x1 = acc1[r], x1n = __shfl_xor(x1, 1); \
                if ((r32 & 1) == 0) { *(unsigned*)(tp + (size_t)row * 128 + 32 * c0 + r32) = cvtpk(x0, x0n); *(unsigned*)(tp + (size_t)row * 128 + 32 * (c0 + 1) + r32) = cvtpk(x1, x1n); } } } } while (0)
    RS_LOAD(0); RS_WRITE(0);
    __syncthreads();
#pragma unroll 1
    for (int t = 0; t < 28; t += 2) {
        RS_LOAD(t + 1);
        SBAR(); RS_COMPUTE(0); SBAR();
        RS_WRITE(1); RS_STORE(t);
        __syncthreads();
        if (t + 2 < 28) RS_LOAD(t + 2);
        SBAR(); RS_COMPUTE(1); SBAR();
        if (t + 2 < 28) RS_WRITE(0);
        RS_STORE(t + 1);
        __syncthreads();
    }
#undef RS_LOAD
#undef RS_WRITE
#undef RS_TR
#undef RS_COMPUTE
#undef RS_STORE
}
template <int VAR>
__device__ __forceinline__ void retention_unit(Frame& F, int unit) {
    const int qb = 7 - (unit >> 7), bh = unit & 127, b = bh >> 3, h = bh & 7;
    int tid = F.tid; asm volatile("" : "+v"(tid));
    const int wid = F.wave, lane = tid & 63, r32 = lane & 31, hi = lane >> 5;
    const int t0 = qb * 256;
    const size_t rowb = (size_t)b * SEQ;
    const bf16* Qb = hblk(F, CB_RQ + h) + rowb * 128;
    bf16x8 qr[8];
    { const bf16* qp = Qb + (size_t)(t0 + wid * 32 + r32) * 128 + hi * 8;
#pragma unroll
      for (int d0 = 0; d0 < 8; ++d0) qr[d0] = *reinterpret_cast<const bf16x8*>(qp + d0 * 16); }
    PolRet P{hblk(F, CB_RK + h) + rowb * 128, hblk(F, CB_RV + h) + rowb * 128, t0, nullptr};
    att::Stage S0, S1; att::stage_prefetch(P, S0, S1, tid);
    att::settle_q(qr);
    f32x16 o[4] = {}; float m_reg = 0.f, l_reg = 0.f;
    if (qb > 0) {
        const bf16* tp = (const bf16*)(F.ws + WS_TST) + ((size_t)bh * 7 + (qb - 1)) * 16384;
        const int sr = tid >> 4, sc = (tid & 15) * 8, vst0 = att::v_st(sr, sc), vst1 = att::v_st(32 + sr, sc);
        LAS char* lds = (LAS char*)F.lds;
        { const bf16x8 a0 = *reinterpret_cast<const bf16x8*>(tp + (size_t)sr * 128 + sc), a1 = *reinterpret_cast<const bf16x8*>(tp + (size_t)(32 + sr) * 128 + sc);
          const bf16x8 b0 = *reinterpret_cast<const bf16x8*>(tp + (size_t)(64 + sr) * 128 + sc), b1 = *reinterpret_cast<const bf16x8*>(tp + (size_t)(96 + sr) * 128 + sc);
          *(LAS bf16x8*)(lds + att::OFF_V + vst0) = a0; *(LAS bf16x8*)(lds + att::OFF_V + vst1) = a1;
          *(LAS bf16x8*)(lds + att::OFF_V + att::SHM + vst0) = b0; *(LAS bf16x8*)(lds + att::OFF_V + att::SHM + vst1) = b1; }
        __syncthreads();
        const int vb0 = (int)(unsigned)(uintptr_t)(lds + att::OFF_V) + att::v_rd_base(lane);
        att::pv_tile<0>(o, vb0, qr[0], qr[1], qr[2], qr[3]);
        att::pv_tile<1>(o, vb0, qr[4], qr[5], qr[6], qr[7]);
        __syncthreads();
    }
    att::att_pass_pre<PolRet, VAR>(P, (LAS char*)F.lds, qr, o, m_reg, l_reg, tid, S0, S1);
    if (VAR != 0) { if (o[0][0] + o[1][1] + o[2][2] + o[3][3] == 12345.678f) F.MISC[20] = 1u; return; }
    float ss[16];
#pragma unroll
    for (int r = 0; r < 16; ++r) { float s = 0.f;
#pragma unroll
        for (int d = 0; d < 4; ++d) s += o[d][r] * o[d][r];
        s += __shfl_xor(s, 1); s += __shfl_xor(s, 2); s += __shfl_xor(s, 4); s += __shfl_xor(s, 8); s += __shfl_xor(s, 16);
        ss[r] = __builtin_amdgcn_rsqf(s * (1.f / 128.f) + NORM_EPS); }
    const float* rg = F.in[4] + h * 128;
    const bf16* Zb = hblk(F, CB_RZ + h) + rowb * 128;
    bf16* mix = (bf16*)(F.ws + WS_MIX);
    int rl = r32, hl = hi; asm volatile("" : "+v"(rl), "+v"(hl));
    float gd[4];
#pragma unroll
    for (int d = 0; d < 4; ++d) gd[d] = rg[d * 32 + rl];
    LAS float* st = (LAS float*)(F.lds + wid * 16384);
#pragma unroll
    for (int r = 0; r < 16; ++r)
#pragma unroll
        for (int d = 0; d < 4; ++d) st[att::crow(r, hl) * 128 + d * 32 + rl] = o[d][r] * ss[r] * gd[d];
    asm volatile("s_waitcnt lgkmcnt(0)" ::: "memory");
    int ll = lane; asm volatile("" : "+v"(ll));
    const int c8 = (ll & 15) * 8, rq = ll >> 4;
    v4u zz[8];
#pragma unroll
    for (int p = 0; p < 8; ++p) zz[p] = *(const v4u*)(Zb + (size_t)(t0 + wid * 32 + 4 * p + rq) * 128 + c8);
#pragma unroll
    for (int p = 0; p < 8; ++p) { const int row = 4 * p + rq;
        const f32x4 a = *(const LAS f32x4*)(st + row * 128 + c8), bq = *(const LAS f32x4*)(st + row * 128 + c8 + 4);
        v4u w; w.x = cvtpk(a.x * bflo(zz[p].x), a.y * bfhi(zz[p].x)); w.y = cvtpk(a.z * bflo(zz[p].y), a.w * bfhi(zz[p].y));
        w.z = cvtpk(bq.x * bflo(zz[p].z), bq.y * bfhi(zz[p].z)); w.w = cvtpk(bq.z * bflo(zz[p].w), bq.w * bfhi(zz[p].w));
        *(v4u*)(mix + (rowb + t0 + wid * 32 + row) * DM + h * 128 + c8) = w; }
}

struct PolWin {
    static constexpr bool SOFTMAX = true, KNORM = false, LANEPRED = false;
    const bf16 *Kb, *Vb; int t0, tile0, nt; const float* kgain;
    struct TI { int kb; };
    __device__ __forceinline__ int ntiles() const { return nt; }
    __device__ __forceinline__ TI tile(int t) const { return TI{64 * (tile0 + t)}; }
    __device__ __forceinline__ const bf16* krow(const TI& ti, int i) const { return Kb + (size_t)(ti.kb + i) * 128; }
    __device__ __forceinline__ const bf16* vrow(const TI& ti, int i) const { return Vb + (size_t)(ti.kb + i) * 128; }
    __device__ __forceinline__ bool active(const TI& ti, int wid) const { const int slo = t0 + 8 * wid; return ti.kb <= slo + 7 && ti.kb + 63 >= slo - 511; }
    __device__ __forceinline__ void mask(f32x16& p0, f32x16& p1, const TI& ti, int wid, int r32, int hi) const {
        const int slo = t0 + 8 * wid;
        if (ti.kb + 63 > slo || ti.kb < slo + 7 - 511) att::mask_tile(p0, p1, slo + (r32 >> 2) - ti.kb - 4 * hi, 512u);
    }
};
struct PolSel {
    static constexpr bool SOFTMAX = true, KNORM = false, LANEPRED = true;
    const bf16 *Kb, *Vb; int t0, cur; unsigned umask, wmask, sel; const float* kgain;
    struct TI { int kb, bit; };
    __device__ __forceinline__ int ntiles() const { return __builtin_popcount(umask); }
    __device__ __forceinline__ TI tile(int t) const { unsigned m = umask; for (int k = 0; k < t; ++k) m &= m - 1u; const int bit = __builtin_ctz(m); return TI{64 * bit, bit}; }
    __device__ __forceinline__ const bf16* krow(const TI& ti, int i) const { return Kb + (size_t)(ti.kb + i) * 128; }
    __device__ __forceinline__ const bf16* vrow(const TI& ti, int i) const { return Vb + (size_t)(ti.kb + i) * 128; }
    __device__ __forceinline__ bool active(const TI& ti, int wid) const { return (wmask >> ti.bit) & 1u; }
    __device__ __forceinline__ void mask(f32x16& p0, f32x16& p1, const TI& ti, int wid, int r32, int hi) const {
        const bool on = (sel >> ti.bit) & 1u;
        if (ti.bit == cur) {
            const int dq = on ? (t0 + 8 * wid + (r32 >> 2) - ti.kb - 4 * hi) : -100000;
            att::mask_tile(p0, p1, dq, 0x7fffffffu);
        } else if (!__all(on)) {
            const float NEG = -__builtin_inff();
#pragma unroll
            for (int r = 0; r < 16; ++r) { p0[r] = on ? p0[r] : NEG; p1[r] = on ? p1[r] : NEG; }
        }
    }
};
template <int VAR>
__device__ __forceinline__ void nsa_unit(Frame& F, int unit) {
    const int j = 31 - (unit >> 5), bg = unit & 31, b = bg >> 1, g = bg & 1;
    int tid = F.tid; asm volatile("" : "+v"(tid));
    const int wid = F.wave, lane = tid & 63, r32 = lane & 31, hi = lane >> 5;
    const int t0 = 64 * j, cur = j;
    const size_t rowb = (size_t)b * SEQ;
    const int tok = t0 + 8 * wid + (r32 >> 2), hd = g * 4 + (r32 & 3);
    LAS char* lds = (LAS char*)F.lds;
    LAS float* wsf = (LAS float*)(lds + att::OFF_WS) + wid * 256;
    LAS float* wsf3 = (LAS float*)(lds + att::OFF_WS3) + wid * 256;
    float* slab = (float*)(F.ws + WS_A) + (size_t)blockIdx.x * 65536;
#define NSA_LOADQ(qr_, zz_) do { const bf16* qp_ = hblk(F, CB_NQ + hd) + (rowb + tok + (size_t)(zz_)) * 128 + hi * 8; \
        _Pragma("unroll") for (int d0 = 0; d0 < 8; ++d0) qr_[d0] = *reinterpret_cast<const bf16x8*>(qp_ + d0 * 16); att::norm_q(qr_, F.in[5], hi); } while (0)
#define NSA_GATE(br_, zz_) sigmoidf_(bf2f(hblk(F, CB_NG)[(rowb + tok + (size_t)(zz_)) * 128 + (br_) * 8 + hd]))
    const int sr = tid >> 4, sc = (tid & 15) * 8;
    const int kws = KSWZ(sr, sc * 2), vst0 = att::v_st(sr, sc), vst1 = att::v_st(32 + sr, sc);
    const int vb0 = (int)(unsigned)(uintptr_t)(lds + att::OFF_V) + att::v_rd_base(lane);
    unsigned sel;
    sel = 0xffffffffu;
    if (!((DBG_SKIP | VAR) & 8)) {
        bf16x8 qr[8]; NSA_LOADQ(qr, 0); const float g0 = NSA_GATE(0, 0);
        const bf16* kc = (const bf16*)(F.ws + WS_KCMP) + (size_t)(b * 2 + g) * 128 * 128;
        const bf16* vc = kc + (size_t)32 * 128 * 128;
        const bool two = t0 >= 992;
#pragma unroll
        for (int T = 0; T < 2; ++T) { if (T == 1 && !two) break; att::Stage S;
            S.k0 = *reinterpret_cast<const bf16x8*>(kc + (size_t)(64 * T + sr) * 128 + sc); S.k1 = *reinterpret_cast<const bf16x8*>(kc + (size_t)(64 * T + 32 + sr) * 128 + sc);
            S.v0 = *reinterpret_cast<const bf16x8*>(vc + (size_t)(64 * T + sr) * 128 + sc); S.v1 = *reinterpret_cast<const bf16x8*>(vc + (size_t)(64 * T + 32 + sr) * 128 + sc);
            att::stage_write(lds, T, S, kws, vst0, vst1); }
        __syncthreads();
        const int nmax = (tok - 31) >> 4;
        const bool anyv = nmax >= 0;
        constexpr float C2 = 1.4426950408889634f * ATT_SCALE;
        const float bn0 = ((const float*)(F.ws + WS_MISC + FXB_OFF))[3];
        float mb;
        if (FX_NSA && bn0 <= att::FX_MAX) mb = anyv ? -bn0 * att::LOG2E : 0.f;
        else {
        float mx;
        { f32x16 p0, p1;
          att::qkt<0>(p0, p1, lds, r32, hi, qr); att::mask_tile(p0, p1, nmax - 4 * hi, 0x7fffffffu);
          mx = p0[0];
#pragma unroll
          for (int r = 0; r < 16; ++r) { mx = fmaxf(mx, p0[r]); mx = fmaxf(mx, p1[r]); }
          SBAR();
          if (two) { att::qkt<1>(p0, p1, lds, r32, hi, qr); att::mask_tile(p0, p1, nmax - 64 - 4 * hi, 0x7fffffffu);
#pragma unroll
              for (int r = 0; r < 16; ++r) { mx = fmaxf(mx, p0[r]); mx = fmaxf(mx, p1[r]); } }
          mx = fmaxf(mx, att::xhi_f(mx, hi)); }
        mb = anyv ? -mx * C2 : 0.f; }
        float sum = 0.f; float im[16], ls[16];
        f32x16 o[4] = {};
        SBAR();
        { f32x16 p0, p1; bf16x8 pa0, pa1, pa2, pa3;
          att::qkt<0>(p0, p1, lds, r32, hi, qr); att::mask_tile(p0, p1, nmax - 4 * hi, 0x7fffffffu);
#pragma unroll
          for (int r = 0; r < 16; ++r) { p0[r] = __builtin_amdgcn_exp2f(fmaf(p0[r], C2, mb)); p1[r] = __builtin_amdgcn_exp2f(fmaf(p1[r], C2, mb)); sum += p0[r] + p1[r]; }
#pragma unroll
          for (int q = 0; q < 4; ++q) { im[q] = (p0[4 * q] + p0[4 * q + 1]) + (p0[4 * q + 2] + p0[4 * q + 3]); ls[q] = p0[4 * q + 3];
              im[4 + q] = (p1[4 * q] + p1[4 * q + 1]) + (p1[4 * q + 2] + p1[4 * q + 3]); ls[4 + q] = p1[4 * q + 3]; }
          att::pack_p(p0, p1, pa0, pa1, pa2, pa3); SBAR(); att::pv_tile<0>(o, vb0, pa0, pa1, pa2, pa3); }
        SBAR();
        if (two) { f32x16 p0, p1; bf16x8 pa0, pa1, pa2, pa3;
          att::qkt<1>(p0, p1, lds, r32, hi, qr); att::mask_tile(p0, p1, nmax - 64 - 4 * hi, 0x7fffffffu);
#pragma unroll
          for (int r = 0; r < 16; ++r) { p0[r] = __builtin_amdgcn_exp2f(fmaf(p0[r], C2, mb)); p1[r] = __builtin_amdgcn_exp2f(fmaf(p1[r], C2, mb)); sum += p0[r] + p1[r]; }
#pragma unroll
          for (int q = 0; q < 4; ++q) { im[8 + q] = (p0[4 * q] + p0[4 * q + 1]) + (p0[4 * q + 2] + p0[4 * q + 3]); ls[8 + q] = p0[4 * q + 3];
              im[12 + q] = (p1[4 * q] + p1[4 * q + 1]) + (p1[4 * q + 2] + p1[4 * q + 3]); ls[12 + q] = p1[4 * q + 3]; }
          att::pack_p(p0, p1, pa0, pa1, pa2, pa3); SBAR(); att::pv_tile<1>(o, vb0, pa0, pa1, pa2, pa3); }
        else {
#pragma unroll
            for (int u = 8; u < 16; ++u) { im[u] = 0.f; ls[u] = 0.f; } }
        SBAR();
        sum += att::xhi_f(sum, hi);
        const float inv = (anyv && sum > 0.f) ? __builtin_amdgcn_rcpf(sum) : 0.f;
        { float f[16]; att::row_bcast(g0 * inv, wsf, r32, hi, f);
          int rl = r32, hl = hi; asm volatile("" : "+v"(rl), "+v"(hl));
#pragma unroll
          for (int r = 0; r < 16; ++r)
#pragma unroll
              for (int d = 0; d < 4; ++d) slab[(size_t)(wid * 32 + att::crow(r, hl)) * 128 + d * 32 + rl] = o[d][r] * f[r]; }
        SBAR();
        if (!((DBG_SKIP | VAR) & 1) && cur >= 16) {
            LAS float* Gs = (LAS float*)(lds + 73728 + wid * 3072); LAS float* Ls = Gs + 256; LAS float* Vs = Gs + 512;
            const int tl = r32 >> 2;
#pragma unroll
            for (int u = 0; u < 16; ++u) { float a = im[u] * inv, c = ls[u] * inv;
                a += __shfl_xor(a, 1); a += __shfl_xor(a, 2); c += __shfl_xor(c, 1); c += __shfl_xor(c, 2);
                if ((r32 & 3) == 0) { Gs[tl * 32 + 2 * u + hi] = a; Ls[tl * 32 + 2 * u + hi] = c; } }
            asm volatile("s_waitcnt lgkmcnt(0)" ::: "memory");
            int k4 = 4 * (2 * (r32 & 3) + hi); asm volatile("" : "+v"(k4));
            float my[4];
#pragma unroll
            for (int i = 0; i < 4; ++i) { const int jj = k4 + i; const float prev = jj > 0 ? Ls[tl * 32 + (jj > 0 ? jj - 1 : 0)] : 0.f;
                const float v = Gs[tl * 32 + jj] + prev; const bool forced = (jj == 0) || (jj == cur) || (jj == cur - 1);
                my[i] = forced ? 1e30f : (jj > cur ? -1e30f : v); }
            *(LAS f32x4*)(Vs + tl * 32 + k4) = (f32x4){my[0], my[1], my[2], my[3]};
            asm volatile("s_waitcnt lgkmcnt(0)" ::: "memory");
            int cnt[4] = {0, 0, 0, 0};
#pragma unroll
            for (int q = 0; q < 8; ++q) { const f32x4 c = *(const LAS f32x4*)(Vs + tl * 32 + 4 * q);
#pragma unroll
                for (int i = 0; i < 4; ++i) { const int jm = k4 + i;
                    cnt[i] += (int)(c.x > my[i]) | ((int)(c.x == my[i]) & (int)(4 * q + 0 < jm)); cnt[i] += (int)(c.y > my[i]) | ((int)(c.y == my[i]) & (int)(4 * q + 1 < jm));
                    cnt[i] += (int)(c.z > my[i]) | ((int)(c.z == my[i]) & (int)(4 * q + 2 < jm)); cnt[i] += (int)(c.w > my[i]) | ((int)(c.w == my[i]) & (int)(4 * q + 3 < jm)); } }
            unsigned bits = 0u;
#pragma unroll
            for (int i = 0; i < 4; ++i) if (cnt[i] < 16) bits |= 1u << (k4 + i);
            bits |= __shfl_xor(bits, 1); bits |= __shfl_xor(bits, 2); bits |= att::xhi_u(bits, hi);
            sel = bits & ((2u << cur) - 1u);
        } else {
            sel = (2u << cur) - 1u;
        }
        __syncthreads();
    }
    asm volatile("" : "+v"(sel));
    bool winpre = false;
    if (!((DBG_SKIP | VAR) & 2)) {
        unsigned wm = sel;
#pragma unroll
        for (int off = 1; off < 64; off <<= 1) wm |= __shfl_xor(wm, off);
        wm = __builtin_amdgcn_readfirstlane(wm);
        LAS unsigned* xs = (LAS unsigned*)(F.lds + XTRA_OFF);
        if (lane == 0) xs[wid] = wm;
        __syncthreads();
        unsigned um = 0u;
#pragma unroll
        for (int w = 0; w < 8; ++w) um |= xs[w];
        um = __builtin_amdgcn_readfirstlane(um);
        int z2 = 0; asm volatile("" : "+s"(z2));
        const size_t rb2 = rowb + (size_t)z2;
        PolSel P{hblk(F, CB_KS + g) + rb2 * 128, hblk(F, CB_VS + g) + rb2 * 128, t0, cur, um, wm, sel, F.in[6] + 128};
        const float bn = ((const float*)(F.ws + WS_MISC + FXB_OFF))[0];
        const bool fx2 = FX_NSA && bn <= att::FX_MAX;
        if (fx2) { int tp_ = tid; asm volatile("" : "+v"(tp_)); att::fxd_prefetch(P, lds, tp_); }
        bf16x8 qr[8]; NSA_LOADQ(qr, z2);
        f32x16 o[4] = {}; float f[16];
        if (fx2) {
            f32x16 lacc = {};
            { int tp_ = tid; asm volatile("" : "+v"(tp_)); att::att_pass_fxd<PolSel, true>(P, lds, qr, o, lacc, bn * att::LOG2E, tp_); }
            if (!((DBG_SKIP | VAR) & 4) && FX_NSA && ((const float*)(F.ws + WS_MISC + FXB_OFF))[1] <= att::FX_MAX) {
                const int tile0w = j > 8 ? j - 8 : 0;
                PolWin Pw{hblk(F, CB_KW + g) + rb2 * 128, hblk(F, CB_VW + g) + rb2 * 128, t0, tile0w, j - tile0w + 1, F.in[6] + 256};
                int tp_ = tid; asm volatile("" : "+v"(tp_)); att::fxd_prefetch(Pw, lds, tp_); winpre = true; }
            const float g1 = NSA_GATE(1, z2);
            att::row_bcast(g1, wsf3, r32, hi, f);
#pragma unroll
            for (int r = 0; r < 16; ++r) f[r] *= __builtin_amdgcn_rcpf(lacc[r]);
        } else {
            float m_reg = -1e30f, l_reg = 0.f;
            { int tp_ = tid; asm volatile("" : "+v"(tp_)); att::att_pass(P, lds, qr, o, m_reg, l_reg, tp_); }
            const float g1 = NSA_GATE(1, z2);
            att::row_bcast(g1 * __builtin_amdgcn_rcpf(l_reg), wsf, r32, hi, f);
        }
        int rl = r32, hl = hi; asm volatile("" : "+v"(rl), "+v"(hl));
#pragma unroll
        for (int r = 0; r < 16; ++r)
#pragma unroll
            for (int d = 0; d < 4; ++d) slab[32768 + (size_t)(wid * 32 + att::crow(r, hl)) * 128 + d * 32 + rl] = o[d][r] * f[r];
    }
    if (!((DBG_SKIP | VAR) & 4)) {
        const int tile0 = j > 8 ? j - 8 : 0;
        int z3 = 0; asm volatile("" : "+s"(z3));
        const size_t rb3 = rowb + (size_t)z3;
        bf16x8 qr[8]; NSA_LOADQ(qr, z3);
        PolWin P{hblk(F, CB_KW + g) + rb3 * 128, hblk(F, CB_VW + g) + rb3 * 128, t0, tile0, j - tile0 + 1, F.in[6] + 256};
        f32x16 o[4] = {}; float f[16];
        const float bn = ((const float*)(F.ws + WS_MISC + FXB_OFF))[1];
        if (FX_NSA && bn <= att::FX_MAX) {
            f32x16 lacc = {};
            if (!winpre) { int tp_ = tid; asm volatile("" : "+v"(tp_)); att::fxd_prefetch(P, lds, tp_); }
            { int tp_ = tid; asm volatile("" : "+v"(tp_)); att::att_pass_fxd<PolWin, true>(P, lds, qr, o, lacc, bn * att::LOG2E, tp_); }
            const float g2 = NSA_GATE(2, z3);
            att::row_bcast(g2, wsf3, r32, hi, f);
#pragma unroll
            for (int r = 0; r < 16; ++r) f[r] *= __builtin_amdgcn_rcpf(lacc[r]);
        } else {
            float m_reg = -1e30f, l_reg = 0.f;
            { int tp_ = tid; asm volatile("" : "+v"(tp_)); att::att_pass(P, lds, qr, o, m_reg, l_reg, tp_); }
            const float g2 = NSA_GATE(2, z3);
            att::row_bcast(g2 * __builtin_amdgcn_rcpf(l_reg), wsf, r32, hi, f);
        }
        bf16* mix = (bf16*)(F.ws + WS_MIX);
        int rl = r32, hl = hi; asm volatile("" : "+v"(rl), "+v"(hl));
        LAS float* st = (LAS float*)(F.lds + wid * 16384);
        __syncthreads();
#pragma unroll
        for (int r = 0; r < 16; ++r)
#pragma unroll
            for (int d = 0; d < 4; ++d) st[att::crow(r, hl) * 128 + d * 32 + rl] = o[d][r] * f[r];
        asm volatile("s_waitcnt lgkmcnt(0)" ::: "memory");
        int ll = lane; asm volatile("" : "+v"(ll));
        const int c8 = (ll & 15) * 8, rq = ll >> 4;
#pragma unroll
        for (int half = 0; half < 4; ++half) {
            asm volatile("" ::: "memory");
            f32x4 s0[2][2], s1[2][2]; v4u zz[2];
#pragma unroll
            for (int p = 0; p < 2; ++p) { const int row = 4 * (2 * half + p) + rq; const int tk = t0 + 8 * wid + (row >> 2), hh = g * 4 + (row & 3);
                const float* sp = slab + (size_t)(wid * 32 + row) * 128 + c8;
                s0[p][0] = *(const f32x4*)sp; s0[p][1] = *(const f32x4*)(sp + 4); s1[p][0] = *(const f32x4*)(sp + 32768); s1[p][1] = *(const f32x4*)(sp + 32768 + 4);
                zz[p] = *(const v4u*)(hblk(F, CB_NZ + hh) + (rb3 + tk) * 128 + c8); }
#pragma unroll
            for (int p = 0; p < 2; ++p) { const int row = 4 * (2 * half + p) + rq; const int tk = t0 + 8 * wid + (row >> 2), hh = g * 4 + (row & 3);
                const f32x4 a = *(const LAS f32x4*)(st + row * 128 + c8) + s0[p][0] + s1[p][0], bq = *(const LAS f32x4*)(st + row * 128 + c8 + 4) + s0[p][1] + s1[p][1];
                v4u w; w.x = cvtpk(a.x * bflo(zz[p].x), a.y * bfhi(zz[p].x)); w.y = cvtpk(a.z * bflo(zz[p].y), a.w * bfhi(zz[p].y));
                w.z = cvtpk(bq.x * bflo(zz[p].z), bq.y * bfhi(zz[p].z)); w.w = cvtpk(bq.z * bflo(zz[p].w), bq.w * bfhi(zz[p].w));
                if (VAR == 0) *(v4u*)(mix + (rb3 + tk) * DM + 1024 + hh * 128 + c8) = w; else if (w.x == 0x12345678u) F.MISC[21] = 1u; }
        }
    }
#undef NSA_LOADQ
#undef NSA_GATE
}

__device__ __forceinline__ float wave_sum_dpp(float v) {
    v = att::row16_sum(v);
    const float a = __builtin_bit_cast(float, __builtin_amdgcn_readlane(__builtin_bit_cast(int, v), 0)), b = __builtin_bit_cast(float, __builtin_amdgcn_readlane(__builtin_bit_cast(int, v), 16));
    const float c = __builtin_bit_cast(float, __builtin_amdgcn_readlane(__builtin_bit_cast(int, v), 32)), d = __builtin_bit_cast(float, __builtin_amdgcn_readlane(__builtin_bit_cast(int, v), 48));
    return (a + b) + (c + d);
}
constexpr int CFR = 2;
__device__ __forceinline__ void conv_finalize_rows(Frame& F, size_t m0, int n, int lane) {
    bf16* mix = (bf16*)(F.ws + WS_MIX);
    float g[16], bb[16];
#pragma unroll
    for (int q = 0; q < 4; ++q) { const f32x4 a = *(const f32x4*)(F.in[18] + 16 * lane + 4 * q), c = *(const f32x4*)(F.in[19] + 16 * lane + 4 * q);
        g[4 * q] = a.x; g[4 * q + 1] = a.y; g[4 * q + 2] = a.z; g[4 * q + 3] = a.w; bb[4 * q] = c.x; bb[4 * q + 1] = c.y; bb[4 * q + 2] = c.z; bb[4 * q + 3] = c.w; }
    const bf16* czb = hblk(F, CB_CZ + (lane >> 3)) + (lane & 7) * 16;
#pragma unroll 1
    for (int r0 = 0; r0 < n; r0 += CFR) {
        v4u yq[CFR][2], zq[CFR][2];
#pragma unroll
        for (int j = 0; j < CFR; ++j) { const size_t m = m0 + r0 + j; const v4u* yp = (const v4u*)(mix + m * K1OUT + 16 * lane);
            yq[j][0] = yp[0]; yq[j][1] = yp[1]; zq[j][0] = *(const v4u*)(czb + m * 128); zq[j][1] = *(const v4u*)(czb + m * 128 + 8); }
#pragma unroll
        for (int j = 0; j < CFR; ++j) { const size_t m = m0 + r0 + j; const v4u y0 = yq[j][0], y1 = yq[j][1], z0 = zq[j][0], z1 = zq[j][1];
            float y[16] = {bflo(y0.x), bfhi(y0.x), bflo(y0.y), bfhi(y0.y), bflo(y0.z), bfhi(y0.z), bflo(y0.w), bfhi(y0.w), bflo(y1.x), bfhi(y1.x), bflo(y1.y), bfhi(y1.y), bflo(y1.z), bfhi(y1.z), bflo(y1.w), bfhi(y1.w)};
            const float z[16] = {bflo(z0.x), bfhi(z0.x), bflo(z0.y), bfhi(z0.y), bflo(z0.z), bfhi(z0.z), bflo(z0.w), bfhi(z0.w), bflo(z1.x), bfhi(z1.x), bflo(z1.y), bfhi(z1.y), bflo(z1.z), bfhi(z1.z), bflo(z1.w), bfhi(z1.w)};
            float s = 0.f;
#pragma unroll
            for (int e = 0; e < 16; ++e) s += y[e];
            const float mu = wave_sum_dpp(s) * (1.f / 1024.f);
            float q = 0.f;
#pragma unroll
            for (int e = 0; e < 16; ++e) { y[e] -= mu; q += y[e] * y[e]; }
            const float rstd = __builtin_amdgcn_rsqf(wave_sum_dpp(q) * (1.f / 1024.f) + NORM_EPS);
            float o[16];
#pragma unroll
            for (int e = 0; e < 16; ++e) o[e] = siluf_(y[e] * rstd * g[e] + bb[e]) * z[e];
            v4u w0, w1;
            w0.x = cvtpk(o[0], o[1]); w0.y = cvtpk(o[2], o[3]); w0.z = cvtpk(o[4], o[5]); w0.w = cvtpk(o[6], o[7]);
            w1.x = cvtpk(o[8], o[9]); w1.y = cvtpk(o[10], o[11]); w1.z = cvtpk(o[12], o[13]); w1.w = cvtpk(o[14], o[15]);
            v4u* yo = (v4u*)(mix + m * K1OUT + 16 * lane); yo[0] = w0; yo[1] = w1; }
    }
}
__device__ __forceinline__ void conv_dma_rows(Frame& F, LAS unsigned char* at, size_t rowb, int T0, int tok0, int nrows, int wid, int lane) {
    for (int r = wid; r < nrows; r += NWAVES) { const int s = tok0 + r; LAS unsigned char* dst = at + ((s - T0 + 32) & 63) * 2048;
#pragma unroll
        for (int h = 0; h < 2; ++h) { const int chunk = h * 64 + lane;
            __builtin_amdgcn_global_load_lds((const unsigned*)(hblk(F, chunk >> 4) + (rowb + s) * 128 + (chunk & 15) * 8), (LAS unsigned*)(dst + h * 1024), 16, 0, 0); } }
}
template <int VAR>
__device__ __forceinline__ void conv_unit(Frame& F, int unit) {
    const int b = unit >> 4, T0 = (unit & 15) * 128;
    int tid = F.tid; asm volatile("" : "+v"(tid));
    const int wid = F.wave, lane = tid & 63;
    const size_t rowb = (size_t)b * SEQ;
    LAS unsigned char* at = F.lds;
    int c0 = 2 * tid; asm volatile("" : "+v"(c0));
    if (T0 == 0) { for (int idx = tid; idx < 30 * 128; idx += NTHREADS) *(LAS v4u*)(at + (((idx >> 7) - 30 + 32) & 63) * 2048 + (idx & 127) * 16) = (v4u){0u, 0u, 0u, 0u}; }
    else conv_dma_rows(F, at, rowb, T0, T0 - 30, 30, wid, lane);
    conv_dma_rows(F, at, rowb, T0, T0, 16, wid, lane);
    f32x2 ww[31];
    { const float* dw = F.in[16];
#pragma unroll
      for (int k = 0; k < 31; ++k) ww[k] = *(const f32x2*)(dw + (size_t)k * 1024 + c0); }
    const f32x2 bias = *(const f32x2*)(F.in[17] + c0);
    bf16* mix = (bf16*)(F.ws + WS_MIX);
#pragma unroll 1
    for (int st = 0; st < 8; ++st) {
        const int t0 = T0 + 16 * st;
        if (st == 0) asm volatile("s_waitcnt vmcnt(0) lgkmcnt(0)" ::: "memory");
        else asm volatile("s_waitcnt vmcnt(16) lgkmcnt(0)" ::: "memory");
        __syncthreads();
        if (st < 7) conv_dma_rows(F, at, rowb, T0, t0 + 16, 16, wid, lane);
        f32x2 yy[16];
#pragma unroll
        for (int i = 0; i < 16; ++i) yy[i] = bias;
        const int rb = 16 * st + 2;
#pragma unroll
        for (int jr = 0; jr < ((VAR & 2) ? 0 : 46); ++jr) {
            const unsigned w = *(const LAS unsigned*)(at + ((rb + jr) & 63) * 2048 + c0 * 2); const f32x2 a = (f32x2){bflo(w), bfhi(w)};
#pragma unroll
            for (int i = 0; i < 16; ++i) { const int k = jr - i; if (k >= 0 && k <= 30) yy[i] = __builtin_elementwise_fma(a, ww[k], yy[i]); }
        }
#pragma unroll
        for (int i = 0; i < 16; ++i) { if (VAR == 0) *(unsigned*)(mix + (rowb + t0 + i) * K1OUT + c0) = cvtpk(yy[i].x, yy[i].y);
            else if (yy[i].x == 12345.678f) at[0] = 1; }
    }
    asm volatile("s_waitcnt vmcnt(0)" ::: "memory");
    __syncthreads();
    if (VAR == 0 && CONV_FIN_IN_UNIT) { int l2 = tid & 63; asm volatile("" : "+v"(l2)); conv_finalize_rows(F, rowb + T0 + 16 * wid, 16, l2); }
}
__device__ __forceinline__ void conv_finalize(Frame& F) {
    const int gw = blockIdx.x * NWAVES + F.wave, NGW = F.G * NWAVES, lane = F.lane;
    bf16* mix = (bf16*)(F.ws + WS_MIX);
    float g[16], bb[16];
#pragma unroll
    for (int q = 0; q < 4; ++q) { const f32x4 a = *(const f32x4*)(F.in[18] + 16 * lane + 4 * q), c = *(const f32x4*)(F.in[19] + 16 * lane + 4 * q);
        g[4 * q] = a.x; g[4 * q + 1] = a.y; g[4 * q + 2] = a.z; g[4 * q + 3] = a.w; bb[4 * q] = c.x; bb[4 * q + 1] = c.y; bb[4 * q + 2] = c.z; bb[4 * q + 3] = c.w; }
    const bf16* czb = hblk(F, CB_CZ + (lane >> 3)) + (lane & 7) * 16;
    for (int m = gw; m < MROWS; m += NGW) {
        v4u* yp = (v4u*)(mix + (size_t)m * K1OUT + 16 * lane);
        const v4u y0 = yp[0], y1 = yp[1]; const v4u z0 = *(const v4u*)(czb + (size_t)m * 128), z1 = *(const v4u*)(czb + (size_t)m * 128 + 8);
        float y[16] = {bflo(y0.x), bfhi(y0.x), bflo(y0.y), bfhi(y0.y), bflo(y0.z), bfhi(y0.z), bflo(y0.w), bfhi(y0.w), bflo(y1.x), bfhi(y1.x), bflo(y1.y), bfhi(y1.y), bflo(y1.z), bfhi(y1.z), bflo(y1.w), bfhi(y1.w)};
        const float z[16] = {bflo(z0.x), bfhi(z0.x), bflo(z0.y), bfhi(z0.y), bflo(z0.z), bfhi(z0.z), bflo(z0.w), bfhi(z0.w), bflo(z1.x), bfhi(z1.x), bflo(z1.y), bfhi(z1.y), bflo(z1.z), bfhi(z1.z), bflo(z1.w), bfhi(z1.w)};
        float s = 0.f;
#pragma unroll
        for (int e = 0; e < 16; ++e) s += y[e];
        const float mu = wave_sum_dpp(s) * (1.f / 1024.f);
        float q = 0.f;
#pragma unroll
        for (int e = 0; e < 16; ++e) { y[e] -= mu; q += y[e] * y[e]; }
        const float rstd = __builtin_amdgcn_rsqf(wave_sum_dpp(q) * (1.f / 1024.f) + NORM_EPS);
        float o[16];
#pragma unroll
        for (int e = 0; e < 16; ++e) o[e] = siluf_(y[e] * rstd * g[e] + bb[e]) * z[e];
        v4u w0, w1;
        w0.x = cvtpk(o[0], o[1]); w0.y = cvtpk(o[2], o[3]); w0.z = cvtpk(o[4], o[5]); w0.w = cvtpk(o[6], o[7]);
        w1.x = cvtpk(o[8], o[9]); w1.y = cvtpk(o[10], o[11]); w1.z = cvtpk(o[12], o[13]); w1.w = cvtpk(o[14], o[15]);
        yp[0] = w0; yp[1] = w1;
    }
}

struct PolDil {
    static constexpr bool SOFTMAX = true, KNORM = true, LANEPRED = false;
    const bf16 *Kb, *Vb; int mul, addA, addB, tile0, ntc, q0; bool two; const float* kgain;
    struct TI { int kb, cls; };
    __device__ __forceinline__ int ntiles() const { return two ? 2 * ntc : ntc; }
    __device__ __forceinline__ TI tile(int t) const { const int cls = (two && t >= ntc) ? 1 : 0; return TI{64 * (tile0 + t - cls * ntc), cls}; }
    __device__ __forceinline__ const bf16* krow(const TI& ti, int i) const { return Kb + (size_t)(mul * (ti.kb + i) + (ti.cls ? addB : addA)) * 128; }
    __device__ __forceinline__ const bf16* vrow(const TI& ti, int i) const { return Vb + (size_t)(mul * (ti.kb + i) + (ti.cls ? addB : addA)) * 128; }
    __device__ __forceinline__ int qlo(int wid) const { return q0 + 32 * (two ? (wid & 3) : wid); }
    __device__ __forceinline__ bool active(const TI& ti, int wid) const { const int ql = qlo(wid); return (!two || (wid >> 2) == ti.cls) && ti.kb <= ql + 31 && ti.kb + 63 >= ql - 128; }
    __device__ __forceinline__ void mask(f32x16& p0, f32x16& p1, const TI& ti, int wid, int r32, int hi) const {
        const int ql = qlo(wid);
        if (ti.kb + 63 > ql || ti.kb < ql + 31 - 128) att::mask_tile(p0, p1, ql + r32 - ti.kb - 4 * hi, 129u);
    }
};
template <bool FX>
__device__ __forceinline__ void dil_unit(Frame& F, int unit) {
    const int typ = unit >> 9, u = unit & 511;
    int tid = F.tid; asm volatile("" : "+v"(tid));
    const int wid = F.wave, lane = tid & 63, r32 = lane & 31, hi = lane >> 5;
    int b, slot, mul, addA, addB = 0, q0, tile0, ntc; bool two = false;
    if (typ == 0) { b = u >> 5; slot = (u >> 3) & 3; const int qb = u & 7; mul = 1; addA = 0; q0 = 256 * qb; tile0 = qb ? 4 * qb - 2 : 0; ntc = 4 * qb + 4 - tile0; }
    else if (typ == 1) { b = u >> 5; slot = (u >> 3) & 3; const int c4 = (u >> 1) & 3, qb = u & 1; mul = 4; addA = c4; q0 = 256 * qb; tile0 = qb ? 2 : 0; ntc = 4 * qb + 4 - tile0; }
    else { b = u >> 5; slot = (u >> 3) & 3; const int pr = u & 7; mul = 16; addA = 2 * pr; addB = 2 * pr + 1; q0 = 0; tile0 = 0; ntc = 2; two = true; }
    const int head = typ * 4 + slot;
    const size_t rowb = (size_t)b * SEQ;
    PolDil P{hblk(F, CB_DK + head) + rowb * 128, hblk(F, CB_DV + head) + rowb * 128, mul, addA, addB, tile0, ntc, q0, two, F.in[21]};
    const int qpos = P.qlo(wid) + r32, cls = two ? (wid >> 2) : 0;
    const int tok = mul * qpos + (cls ? addB : addA);
    bf16x8 qr[8];
    { const bf16* qp = hblk(F, CB_DQ + head) + (rowb + tok) * 128 + hi * 8;
#pragma unroll
      for (int d0 = 0; d0 < 8; ++d0) qr[d0] = *reinterpret_cast<const bf16x8*>(qp + d0 * 16); }
    att::Stage S0, S1;
    if constexpr (FX) att::stage_prefetch(P, S0, S1, tid);
    att::norm_q(qr, F.in[20], hi);
    f32x16 o[4] = {}; float f[16];
    float* lse = (float*)(F.ws + WS_DLSE) + (size_t)typ * MROWS * 4;
    const int qbase = P.qlo(wid);
    const float bn = ((const float*)(F.ws + WS_MISC + FXB_OFF))[2];
    if constexpr (FX) {
        f32x16 lacc = {};
        att::att_pass_fx_pre(P, (LAS char*)F.lds, qr, o, lacc, bn * att::LOG2E, tid, S0, S1);
        int rl0 = r32, hl0 = hi; asm volatile("" : "+v"(rl0), "+v"(hl0));
#pragma unroll
        for (int r = 0; r < 16; ++r) { f[r] = __builtin_amdgcn_rcpf(lacc[r]);
            if (rl0 == 0) lse[(rowb + mul * (qbase + att::crow(r, hl0)) + (cls ? addB : addA)) * 4 + slot] = bn + __builtin_amdgcn_logf(lacc[r]) * 0.6931471805599453f; }
    } else {
        float m_reg = -1e30f, l_reg = 0.f;
        att::att_pass(P, (LAS char*)F.lds, qr, o, m_reg, l_reg, tid);
        LAS float* wsf = (LAS float*)(F.lds + att::OFF_WS) + wid * 256;
        att::row_bcast(__builtin_amdgcn_rcpf(l_reg), wsf, r32, hi, f);
        if (hi == 0) lse[(rowb + tok) * 4 + slot] = m_reg * ATT_SCALE + __builtin_amdgcn_logf(l_reg) * 0.6931471805599453f;
    }
    bf16* part = (bf16*)(F.ws + WS_DPART) + (size_t)typ * MROWS * 512;
    int rl = r32, hl = hi; asm volatile("" : "+v"(rl), "+v"(hl));
#pragma unroll
    for (int r = 0; r < 16; ++r) { const int tk = mul * (qbase + att::crow(r, hl)) + (cls ? addB : addA);
#pragma unroll
        for (int d = 0; d < 4; ++d) { const float v = o[d][r] * f[r]; const float vn = __shfl_xor(v, 1);
            if ((rl & 1) == 0) *(unsigned*)(part + (rowb + tk) * 512 + slot * 128 + d * 32 + rl) = cvtpk(v, vn); } }
}
__device__ __forceinline__ void dil_combine(Frame& F) {
    const bf16* part = (const bf16*)(F.ws + WS_DPART); const float* lse = (const float*)(F.ws + WS_DLSE);
    bf16* mix = (bf16*)(F.ws + WS_MIX);
    const size_t NE = (size_t)MROWS * 64, ST = (size_t)F.G * NTHREADS;
    for (size_t e0 = (size_t)blockIdx.x * NTHREADS + F.tid; e0 < NE; e0 += 2 * ST) {
        float l0[2], l1[2], l2[2]; v4u a[2], bq[2], cq[2], z[2]; bool ok[2];
#pragma unroll
        for (int u = 0; u < 2; ++u) { const size_t e = e0 + u * ST; ok[u] = e < NE; const size_t ee = ok[u] ? e : e0;
            const size_t m = ee >> 6; const int ch = (int)(ee & 63), slot = ch >> 4, c = (ch & 15) * 8;
            l0[u] = lse[m * 4 + slot]; l1[u] = lse[(size_t)MROWS * 4 + m * 4 + slot]; l2[u] = lse[(size_t)2 * MROWS * 4 + m * 4 + slot];
            a[u] = *(const v4u*)(part + m * 512 + slot * 128 + c); bq[u] = *(const v4u*)(part + (size_t)MROWS * 512 + m * 512 + slot * 128 + c); cq[u] = *(const v4u*)(part + (size_t)2 * MROWS * 512 + m * 512 + slot * 128 + c);
            z[u] = *(const v4u*)(hblk(F, CB_DZ + slot) + m * 128 + c); }
#pragma unroll
        for (int u = 0; u < 2; ++u) { const size_t e = e0 + u * ST; if (!ok[u]) continue;
            const size_t m = e >> 6; const int ch = (int)(e & 63), slot = ch >> 4, c = (ch & 15) * 8;
            const float mx = fmaxf(l0[u], fmaxf(l1[u], l2[u]));
            float w0 = fast_exp(l0[u] - mx), w1 = fast_exp(l1[u] - mx), w2 = fast_exp(l2[u] - mx);
            const float inv = 1.0f / (w0 + w1 + w2); w0 *= inv; w1 *= inv; w2 *= inv;
            v4u o;
#define DC_(X) cvtpk((w0 * bflo(a[u].X) + w1 * bflo(bq[u].X) + w2 * bflo(cq[u].X)) * bflo(z[u].X), (w0 * bfhi(a[u].X) + w1 * bfhi(bq[u].X) + w2 * bfhi(cq[u].X)) * bfhi(z[u].X))
            o.x = DC_(x); o.y = DC_(y); o.z = DC_(z); o.w = DC_(w);
#undef DC_
            *(v4u*)(mix + m * K1OUT + 1024 + slot * 128 + c) = o; }
    }
}

constexpr int N_PHASES = 12;
struct Args { const float* in[22]; float* out; unsigned char* ws; int ph_lo, ph_hi; };
__global__ void __launch_bounds__(NTHREADS, 2) hybrid_fwd(Args args) {
    extern __shared__ __attribute__((aligned(16))) unsigned char lds_raw[];
    Frame F;
    F.lds = (LAS unsigned char*)lds_raw;
    F.MISC = (volatile LAS unsigned*)(F.lds + LDSCTL_OFF);
    F.tid = threadIdx.x; F.lane = F.tid & 63; F.wave = __builtin_amdgcn_readfirstlane(F.tid >> 6);
    F.G = gridDim.x; F.ws = args.ws; F.ctl = (gu32*)(args.ws + WS_CTL); F.out = args.out;
#pragma unroll
    for (int i = 0; i < 22; ++i) F.in[i] = args.in[i];
    for (int u = F.tid; u < 256; u += NTHREADS) ((LAS unsigned*)(F.lds + LDSCTL_OFF))[u] = 0u;
    __syncthreads();
    XcdBarrier bar = xcd_barrier_post((unsigned*)(F.ctl + CW_BAR), F.MISC + 8);
    const int lo = args.ph_lo, hi = args.ph_hi;
#ifndef PH_MASK
#define PH_MASK 0xFFF
#endif
#define INR(k) (lo <= (k) && (k) < hi)
#define IN(k) (((PH_MASK >> (k)) & 1) && INR(k))
#ifndef REPEAT_MASK
#define REPEAT_MASK 0
#endif
#ifndef REP8_SKIP
#define REP8_SKIP 0
#endif
#ifndef CONV_VAR
#define CONV_VAR 0
#endif
#ifndef RET_VAR
#define RET_VAR 0
#endif
#ifndef NSA_VAR
#define NSA_VAR 0
#endif
#define NREP(k) (((REPEAT_MASK >> (k)) & 1) ? 2 : 1)
#define SEAM(k) do { if (INR(k) && INR((k) + 1)) xcd_barrier(bar); } while (0)
    bf16* XN = (bf16*)(F.ws + WS_A);
    bf16* MIX = (bf16*)(F.ws + WS_MIX);

    const bool fold = FOLD_P2 && F.G == 256 && lo <= 0 && hi > 2;
    if (IN(0)) { p0_prologue(F, (fold && DEFER_W1) ? P0_DEFER : 0); }
#if (REPEAT_MASK >> 0) & 1
    xcd_barrier(bar); if (IN(0)) { p0_prologue<P0_REP_SKIP>(F); }
#endif
    SEAM(0);
    if (IN(1)) {
        gu32* kv_done = F.ctl + CW_Q + 64 * 22;
        pg8::Gemm g{XN, (const bf16*)(F.ws + WS_W0IN), MROWS, N0, DM}; pg8::NotifyOrder S; S.init(MROWS, N0, F.G, (int)blockIdx.x);
        S.cnt = (unsigned*)kv_done; S.mask = fold ? ((1u << 20) | (1u << 21) | (1u << 22) | (1u << 24)) : 0u;
        pg8::EpiH E{hblk(F, 0), HBLK, CB_RZ, CB_RZ + 8, CB_NZ, CB_NZ + 8, (const float*)(F.ws + WS_MISC + ROPE_OFF), 16};
        pg8::gemm_phase<pg8::EpiH, pg8::NotifyOrder, true, true>(F.lds, g, S, E);
        if (fold && blockIdx.x >= 128) {
            if (F.tid < 64) {
                unsigned sp = 0;
                while ((unsigned)__builtin_amdgcn_readfirstlane(__hip_atomic_load(kv_done, RLX_AGENT)) < 512u) { __builtin_amdgcn_s_sleep(2); if (++sp > (1u << 22)) break; }
                __builtin_amdgcn_fence(__ATOMIC_ACQUIRE, "agent");
                asm volatile("s_waitcnt vmcnt(0)" ::: "memory");
            }
            __syncthreads();
            if (blockIdx.x < 192) {
                const int ix = (int)blockIdx.x - 128, kv = ix >> 5, kh = (ix >> 4) & 1;
                pg8::Gemm g2{hblk(F, kv ? CB_VC : CB_KC) + kh * 1024, (const bf16*)(F.ws + WS_CW) + (size_t)kv * 256 * 2048 + kh * 1024, 4096, 256, 2048, 16}; pg8::StaticOrder S2; S2.init(4096, 256, 16, ix & 15);
                pg8::EpiF32 E2{(float*)(F.ws + (kh ? WS_CPR2 : WS_CPR)) + (size_t)kv * 4096 * 256, 256};
                pg8::gemm_phase<pg8::EpiF32, pg8::StaticOrder, false, true>(F.lds, g2, S2, E2);
            }
            for (int it = wq_first(F, 0); it < 4 * 128;) {
                const unsigned nx = wq_issue(F, 0);
                const int bi = it >> 7, row0 = (it & 127) * 256;
                if (bi < 2) rowop_item<1>(hblk(F, CB_KS + bi), row0, F.in[6] + 128, nullptr, F.tid);
                else rowop_item<1>(hblk(F, CB_KW + bi - 2), row0, F.in[6] + 256, nullptr, F.tid);
                it = wq_take(F, nx);
            }
            if (DEFER_W1) p0_weight_items(F, P0_NITEMS - P0_DEFER + ((int)blockIdx.x - 128) * NWAVES + F.wave, P0_NITEMS, 128 * NWAVES);
        }
    }
#if (REPEAT_MASK >> 1) & 1
    xcd_barrier(bar);
    if (IN(1)) {
        pg8::Gemm g{XN, (const bf16*)(F.ws + WS_W0IN), MROWS, N0, DM}; pg8::StaticOrder S; S.init(MROWS, N0, F.G, (int)blockIdx.x);
        pg8::EpiH E{hblk(F, 0), HBLK, CB_RZ, CB_RZ + 8, CB_NZ, CB_NZ + 8, (const float*)(F.ws + WS_MISC + ROPE_OFF), 16};
        pg8::gemm_phase<pg8::EpiH, pg8::StaticOrder, true, true>(F.lds, g, S, E);
    }
#endif
    SEAM(1);
    if (IN(2) && !fold) {
        if (blockIdx.x < 64 && F.G >= 64) {
            const int kv = blockIdx.x >> 5, kh = (blockIdx.x >> 4) & 1;
            pg8::Gemm g{hblk(F, kv ? CB_VC : CB_KC) + kh * 1024, (const bf16*)(F.ws + WS_CW) + (size_t)kv * 256 * 2048 + kh * 1024, 4096, 256, 2048, 16}; pg8::StaticOrder S; S.init(4096, 256, 16, (int)(blockIdx.x & 15));
            pg8::EpiF32 E{(float*)(F.ws + (kh ? WS_CPR2 : WS_CPR)) + (size_t)kv * 4096 * 256, 256};
            pg8::gemm_phase<pg8::EpiF32, pg8::StaticOrder, false, true>(F.lds, g, S, E);
        }
        const float* rope = (const float*)(F.ws + WS_MISC + ROPE_OFF);
        constexpr int NITEM = 4 * 128;
        for (int it = wq_first(F, 0); it < NITEM;) {
            const unsigned nx = wq_issue(F, 0);
            const int bi = it >> 7, row0 = (it & 127) * 256;
            if (bi < 2) rowop_item<1>(hblk(F, CB_KS + bi), row0, F.in[6] + 128, nullptr, F.tid);
            else rowop_item<1>(hblk(F, CB_KW + bi - 2), row0, F.in[6] + 256, nullptr, F.tid);
            it = wq_take(F, nx);
        }
        if (F.G < 64) {
            for (int kv = 0; kv < 2; ++kv) {
                pg8::Gemm g{hblk(F, kv ? CB_VC : CB_KC), (const bf16*)(F.ws + WS_CW) + (size_t)kv * 256 * 2048, 4096, 256, 2048}; pg8::StaticOrder S; S.init(4096, 256, F.G, (int)blockIdx.x);
                pg8::EpiF32 E{(float*)(F.ws + WS_CPR) + (size_t)kv * 4096 * 256, 256};
                for (size_t e = (size_t)blockIdx.x * NTHREADS + F.tid; e < (size_t)4096 * 256; e += (size_t)F.G * NTHREADS) ((float*)(F.ws + WS_CPR2))[(size_t)kv * 4096 * 256 + e] = 0.f;
                __syncthreads();
                pg8::gemm_phase<pg8::EpiF32, pg8::StaticOrder, false, true>(F.lds, g, S, E);
            }
        }
    }
    if (!fold) SEAM(2);
    if (IN(3)) {
        gu32* cmp_done = F.ctl + CW_Q + 64 * 20; gu32* st_done = F.ctl + CW_Q + 64 * 21;
        bool cmp_ok = false, st_ok = false;
        for (int it = wq_first(F, 1); it < 64 + 128 + 1024 + 1024;) {
            const unsigned nx = wq_issue(F, 1);
            if (it < 64) {
                cmp_tail_unit(F, it);
                __threadfence();
                __syncthreads();
                if (F.tid == 0) __hip_atomic_fetch_add(cmp_done, 1u, RLX_AGENT);
            } else if (it < 64 + 128) {
                ret_state_unit(F, it - 64);
                __threadfence();
                __syncthreads();
                if (F.tid == 0) __hip_atomic_fetch_add(st_done, 1u, RLX_AGENT);
            } else if (it < 64 + 128 + 1024) {
                if (!cmp_ok) {
                    if (F.tid < 64) {
                        unsigned sp = 0;
                        while ((unsigned)__builtin_amdgcn_readfirstlane(__hip_atomic_load(cmp_done, RLX_AGENT)) < 64u) { __builtin_amdgcn_s_sleep(2); if (++sp > (1u << 22)) break; }
                        __builtin_amdgcn_fence(__ATOMIC_ACQUIRE, "agent");
                        asm volatile("s_waitcnt vmcnt(0)" ::: "memory");
                    }
                    __syncthreads();
                    cmp_ok = true;
                }
                nsa_unit<0>(F, it - 64 - 128);
            } else {
                if (!st_ok) {
                    if (F.tid < 64) {
                        unsigned sp = 0;
                        while ((unsigned)__builtin_amdgcn_readfirstlane(__hip_atomic_load(st_done, RLX_AGENT)) < 128u) { __builtin_amdgcn_s_sleep(2); if (++sp > (1u << 22)) break; }
                        __builtin_amdgcn_fence(__ATOMIC_ACQUIRE, "agent");
                        asm volatile("s_waitcnt vmcnt(0)" ::: "memory");
                    }
                    __syncthreads();
                    st_ok = true;
                }
                retention_unit<0>(F, it - 64 - 128 - 1024);
            }
            it = wq_take(F, nx);
        }
    }
    SEAM(3);
    if (IN(5)) {
        pg8::Gemm g{MIX, (const bf16*)(F.ws + WS_W0OUT), MROWS, DM, 2048}; pg8::StaticOrder S; S.init(MROWS, DM, F.G, (int)blockIdx.x);
        pg8::EpiRes2 E{F.in[0], F.out, XN, (float*)(F.ws + WS_CTL + 512 * 1024), DM};
        pg8::gemm_phase<pg8::EpiRes2, pg8::StaticOrder, false, true>(F.lds, g, S, E);
    }
    SEAM(5);
    if (IN(7)) {
        pg8::Gemm g{XN, (const bf16*)(F.ws + WS_W1IN), MROWS, N1, DM}; pg8::StaticOrder S; S.init(MROWS, N1, F.G, (int)blockIdx.x);
        pg8::EpiHS E{hblk(F, 0), HBLK, (const float*)(F.ws + WS_CTL + 512 * 1024), 1.f / DM, NORM_EPS, 8, CB_CZ, CB_CZ + 8, CB_DZ, CB_DZ + 4};
        pg8::gemm_phase<pg8::EpiHS, pg8::StaticOrder, false, true>(F.lds, g, S, E);
    }
    SEAM(7);
    if (IN(8)) {
        if (FX_DIL && ((const float*)(F.ws + WS_MISC + FXB_OFF))[2] <= att::FX_MAX) {
            for (int it = wq_first(F, 3); it < 1536 + 256;) {
                const unsigned nx = wq_issue(F, 3);
                if (it < 256) { if (!(DBG_SKIP & 16)) conv_unit<0>(F, it); } else if (!(DBG_SKIP & 32)) dil_unit<true>(F, it - 256);
                it = wq_take(F, nx);
            }
        } else {
            for (int it = wq_first(F, 3); it < 1536 + 256;) {
                const unsigned nx = wq_issue(F, 3);
                if (it < 256) { if (!(DBG_SKIP & 16)) conv_unit<0>(F, it); } else if (!(DBG_SKIP & 32)) dil_unit<false>(F, it - 256);
                it = wq_take(F, nx);
            }
        }
    }
#if (REPEAT_MASK >> 8) & 1
    xcd_barrier(bar);
    if (IN(8)) {
        for (int it = wq_first(F, 11); it < 1536 + 256;) {
            const unsigned nx = wq_issue(F, 11);
            if (it < 256) { if (!(REP8_SKIP & 1)) conv_unit<CONV_VAR>(F, it); } else if (!(REP8_SKIP & 2)) dil_unit<true>(F, it - 256);
            it = wq_take(F, nx);
        }
    }
#endif
    SEAM(8);
    if (IN(10)) { dil_combine(F); if (!CONV_FIN_IN_UNIT) conv_finalize(F); }
#if (REPEAT_MASK >> 10) & 1
    xcd_barrier(bar); if (IN(10)) { dil_combine(F); }
#endif
    SEAM(10);
    if (IN(11)) {
        pg8::Gemm g{MIX, (const bf16*)(F.ws + WS_W1OUT), MROWS, DM, K1OUT}; pg8::StaticOrder S; S.init(MROWS, DM, F.G, (int)blockIdx.x);
        pg8::EpiRes E{F.out, F.out, DM};
        pg8::gemm_phase<pg8::EpiRes, pg8::StaticOrder, false, true>(F.lds, g, S, E);
    }
#undef IN
#undef INR
#undef SEAM
}

#ifndef MK_CUTS
#define MK_CUTS 0
#endif
extern "C" void kernel_launch(void* const* d_in, const int* in_sizes, int n_in, void* d_out, int out_size, void* d_ws, size_t ws_size, hipStream_t stream) {
    static int grid = 0;
    if (grid == 0) {
        if (n_in != 22 || out_size != MROWS * DM || ws_size < WS_END) { fprintf(stderr, "kernel_launch: unexpected shapes (n_in %d, out %d, ws %zu)\n", n_in, out_size, ws_size); grid = -1; return; }
        int dev = 0, cus = 0, per_cu = 0;
        if (hipGetDevice(&dev) != hipSuccess || hipDeviceGetAttribute(&cus, hipDeviceAttributeMultiprocessorCount, dev) != hipSuccess) { grid = -1; return; }
        if (hipFuncSetAttribute((const void*)hybrid_fwd, hipFuncAttributeMaxDynamicSharedMemorySize, LDS_BYTES) != hipSuccess) { fprintf(stderr, "kernel_launch: hipFuncSetAttribute failed\n"); grid = -1; return; }
        if (hipOccupancyMaxActiveBlocksPerMultiprocessor(&per_cu, (const void*)hybrid_fwd, NTHREADS, LDS_BYTES) != hipSuccess || per_cu < 1)
            fprintf(stderr, "kernel_launch: note: occupancy query reports %d workgroups per CU\n", per_cu);
        (void)hipGetLastError();
        grid = cus;
        if (grid > 256) grid = 256;
    }
    if (grid < 0) return;
    if (hipMemsetAsync((char*)d_ws + WS_CTL, 0, CTL_ZERO_BYTES, stream) != hipSuccess) return;
    Args a{};
    for (int i = 0; i < 22; ++i) a.in[i] = (const float*)d_in[i];
    a.out = (float*)d_out; a.ws = (unsigned char*)d_ws;
#if MK_CUTS
    for (int p = 0; p < N_PHASES; ++p) { a.ph_lo = p; a.ph_hi = p + 1; hipLaunchKernelGGL(hybrid_fwd, dim3(grid), dim3(NTHREADS), LDS_BYTES, stream, a); }
#else
    a.ph_lo = 0; a.ph_hi = N_PHASES;
    hipLaunchKernelGGL(hybrid_fwd, dim3(grid), dim3(NTHREADS), LDS_BYTES, stream, a);
#endif
}
```

```cpp
#include <hip/hip_runtime.h>
#include <cstdio>
#include <cstdint>
namespace pg8 {
#define PG8_LAS __attribute__((address_space(3)))
typedef unsigned short bf16_t;
typedef short bf16x8 __attribute__((ext_vector_type(8)));
typedef float f32x4 __attribute__((ext_vector_type(4)));
typedef unsigned u32x4 __attribute__((ext_vector_type(4)));
constexpr int BM = 256, BK = 64, HALF = 128, HTB = HALF * BK * 2  , STAGE_BYTES = 8 * HTB, NXCD = 8, WGM = 8;

__host__ __device__ __forceinline__ int lds_byte(int r, int c) { const int st = (r >> 4) * 2 + (c >> 5), rr = r & 15, cc = c & 31, ob = rr * 64 + cc * 2; return st * 1024 + (ob ^ (((ob >> 9) & 1) << 5)); }
__host__ __device__ __forceinline__ void stage_rc(int b, int& R, int& C) { const int st = b / 1024, sb = b % 1024, swz = sb ^ (((sb >> 9) & 1) << 5); R = (st >> 1) * 16 + swz / 64; C = (st & 1) * 32 + (swz % 64) / 2; }
__host__ __device__ __forceinline__ int perm32(int rho) { const int n = rho >> 4, i = rho & 15; return 8 * (i >> 2) + 4 * n + (i & 3); }

struct Unit { int pm, pn; };
struct Gemm { const bf16_t* A; const bf16_t* Bt; int M, N, K; int ktn = 0; };

struct StaticOrder {
    int nM, nN, nwg, G, c;
    __host__ __device__ void init(int M, int N, int G_, int c_) { nM = M / BM; nN = N / BM; nwg = nM * nN; G = G_; c = c_; }
    __host__ __device__ bool next(int i, Unit& u) const {
        const long L = (long)i * G + c; if (L >= nwg) return false;
        int wgid = (int)L; { const int q = nwg / NXCD, r = nwg % NXCD, xcd = wgid % NXCD, off = wgid / NXCD; wgid = (xcd < r ? xcd * (q + 1) : r * (q + 1) + (xcd - r) * q) + off; }
        const int nig = WGM * nN, gid = wgid / nig, fm = gid * WGM, gsz = (nM - fm) < WGM ? (nM - fm) : WGM;
        u.pm = fm + ((wgid % nig) % gsz); u.pn = (wgid % nig) / gsz; return true;
    }
    __device__ __forceinline__ void a_ready(const Unit&) const {}
    __device__ __forceinline__ void done(const Unit&) const {}
};
struct NotifyOrder : StaticOrder {
    unsigned* cnt; unsigned mask;
    __device__ __forceinline__ void done(const Unit& u) const {
        if ((mask >> u.pn) & 1u) {
            asm volatile("s_waitcnt vmcnt(0)" ::: "memory");
            __builtin_amdgcn_s_barrier();
            if (threadIdx.x == 0) { __threadfence(); __hip_atomic_fetch_add(cnt, 1u, __ATOMIC_RELAXED, __HIP_MEMORY_SCOPE_AGENT); }
        }
    }
};
typedef float cvt_f2_t __attribute__((ext_vector_type(2)));
typedef __bf16 cvt_b2_t __attribute__((ext_vector_type(2)));
__device__ __forceinline__ unsigned cvt_pk_bf16(float lo, float hi) { const cvt_f2_t v = {lo, hi}; return __builtin_bit_cast(unsigned, __builtin_convertvector(v, cvt_b2_t)); }

__device__ __forceinline__ float epi_silu(float x) { return x * __builtin_amdgcn_rcpf(1.0f + __builtin_amdgcn_exp2f(x * -1.4426950408889634f)); }
struct EpiH {
    static constexpr bool PERM = true, AFTER_DRAIN = false;
    bf16_t* O; size_t blk_stride; int sa0, sa1, sb0, sb1;
    const float* rope; int nrot;
    __device__ __forceinline__ void operator()(const f32x4 (&acc)[2][2][4][2], const Unit& u, int wr, int wc, int fr, int fq) const {
        const int row0 = u.pm * BM + wr * 64 + fr; const int col0 = wc * 32 + 8 * fq;
#pragma unroll
        for (int bj = 0; bj < 2; ++bj) { const int cb = u.pn * 2 + bj; const bool sl = (cb >= sa0 && cb < sa1) || (cb >= sb0 && cb < sb1);
            if (cb < nrot) {
                const int hh = cb & 7;
                constexpr float LG[8] = {-0.04580368961312479f, -0.02272007650008353f, -0.011315313227834146f, -0.005646563141142063f, -0.0028205190623786626f, -0.0014095702546713536f, -0.0007046129765893727f, -0.0003522634716290214f};
                float lg = LG[0];
#pragma unroll
                for (int k = 1; k < 8; ++k) lg = (hh == k) ? LG[k] : lg;
                const float lgs = cb < 8 ? lg : -lg, fm = cb < 8 ? 0.08838834764831845f : 1.f;
#pragma unroll
                for (int ai = 0; ai < 2; ++ai)
#pragma unroll
                    for (int m = 0; m < 4; ++m) { const int row = row0 + ai * HALF + m * 16, sp = row & 2047;
                        const f32x4 cs = *(const f32x4*)(rope + (size_t)sp * 128 + 16 * wc + 4 * fq), sn = *(const f32x4*)(rope + (size_t)sp * 128 + 64 + 16 * wc + 4 * fq);
                        const float fr_ = __builtin_amdgcn_exp2f((float)sp * lgs) * fm;
                        const f32x4 t1 = acc[ai][bj][m][0], t2 = acc[ai][bj][m][1];
                        const f32x4 o1 = (t1 * cs - t2 * sn) * fr_, o2 = (t2 * cs + t1 * sn) * fr_;
                        bf16_t* rowp = O + (size_t)cb * blk_stride + (size_t)row * 128 + col0;
                        u32x4 w; w.x = cvt_pk_bf16(o1[0], o1[1]); w.y = cvt_pk_bf16(o1[2], o1[3]); w.z = cvt_pk_bf16(o2[0], o2[1]); w.w = cvt_pk_bf16(o2[2], o2[3]);
                        __builtin_nontemporal_store(w, (u32x4*)rowp); }
                continue;
            }
#pragma unroll
            for (int ai = 0; ai < 2; ++ai)
#pragma unroll
                for (int m = 0; m < 4; ++m) { f32x4 v0 = acc[ai][bj][m][0], v1 = acc[ai][bj][m][1];
                    if (sl) { v0 = (f32x4){epi_silu(v0[0]), epi_silu(v0[1]), epi_silu(v0[2]), epi_silu(v0[3])}; v1 = (f32x4){epi_silu(v1[0]), epi_silu(v1[1]), epi_silu(v1[2]), epi_silu(v1[3])}; }
                    bf16_t* rowp = O + (size_t)cb * blk_stride + (size_t)(row0 + ai * HALF + m * 16) * 128 + col0;
                    u32x4 w; w.x = cvt_pk_bf16(v0[0], v0[1]); w.y = cvt_pk_bf16(v0[2], v0[3]); w.z = cvt_pk_bf16(v1[0], v1[1]); w.w = cvt_pk_bf16(v1[2], v1[3]);
                    __builtin_nontemporal_store(w, (u32x4*)rowp); } }
    }
};
struct EpiF32 {
    static constexpr bool PERM = false, AFTER_DRAIN = false;
    float* C; int ldc;
    __device__ __forceinline__ void operator()(const f32x4 (&acc)[2][2][4][2], const Unit& u, int wr, int wc, int fr, int fq) const {
        const int row0 = u.pm * BM + wr * 64 + fr, col0 = u.pn * BM + wc * 32 + 4 * fq;
#pragma unroll
        for (int ai = 0; ai < 2; ++ai)
#pragma unroll
            for (int m = 0; m < 4; ++m) { float* rowp = C + (size_t)(row0 + ai * HALF + m * 16) * ldc + col0;
#pragma unroll
                for (int bj = 0; bj < 2; ++bj)
#pragma unroll
                    for (int n = 0; n < 2; ++n) *(f32x4*)(rowp + bj * HALF + n * 16) = acc[ai][bj][m][n]; }
    }
};
struct EpiRes {
    static constexpr bool PERM = true, AFTER_DRAIN = false;
    const float* base; float* out; int ldc;
    __device__ __forceinline__ void operator()(const f32x4 (&acc)[2][2][4][2], const Unit& u, int wr, int wc, int fr, int fq) const {
        const int row0 = u.pm * BM + wr * 64 + fr, col0 = u.pn * BM + wc * 32 + 8 * fq;
#pragma unroll
        for (int ai = 0; ai < 2; ++ai) {
            f32x4 bs[4][2][2];
#pragma unroll
            for (int m = 0; m < 4; ++m) { const size_t off = (size_t)(row0 + ai * HALF + m * 16) * ldc + col0;
#pragma unroll
                for (int bj = 0; bj < 2; ++bj)
#pragma unroll
                    for (int n = 0; n < 2; ++n) bs[m][bj][n] = *(const f32x4*)(base + off + bj * HALF + n * 4); }
#pragma unroll
            for (int m = 0; m < 4; ++m) { const size_t off = (size_t)(row0 + ai * HALF + m * 16) * ldc + col0;
#pragma unroll
                for (int bj = 0; bj < 2; ++bj)
#pragma unroll
                    for (int n = 0; n < 2; ++n) __builtin_nontemporal_store(bs[m][bj][n] + acc[ai][bj][m][n], (f32x4*)(out + off + bj * HALF + n * 4)); }
            asm volatile("" ::: "memory"); }
    }
};
struct EpiRes2 {
    static constexpr bool PERM = true, AFTER_DRAIN = false;
    const float* base; float* out; bf16_t* xn; float* ss; int ldc;
    __device__ __forceinline__ void operator()(const f32x4 (&acc)[2][2][4][2], const Unit& u, int wr, int wc, int fr, int fq) const {
        const int row0 = u.pm * BM + wr * 64 + fr, col0 = u.pn * BM + wc * 32 + 8 * fq;
#pragma unroll
        for (int ai = 0; ai < 2; ++ai) {
            f32x4 bs[4][2][2];
#pragma unroll
            for (int m = 0; m < 4; ++m) { const size_t off = (size_t)(row0 + ai * HALF + m * 16) * ldc + col0;
#pragma unroll
                for (int bj = 0; bj < 2; ++bj)
#pragma unroll
                    for (int n = 0; n < 2; ++n) bs[m][bj][n] = *(const f32x4*)(base + off + bj * HALF + n * 4); }
#pragma unroll
            for (int m = 0; m < 4; ++m) { const int row = row0 + ai * HALF + m * 16; const size_t off = (size_t)row * ldc + col0;
                float sq = 0.f;
#pragma unroll
                for (int bj = 0; bj < 2; ++bj) { const f32x4 v0 = bs[m][bj][0] + acc[ai][bj][m][0], v1 = bs[m][bj][1] + acc[ai][bj][m][1];
                    __builtin_nontemporal_store(v0, (f32x4*)(out + off + bj * HALF)); __builtin_nontemporal_store(v1, (f32x4*)(out + off + bj * HALF + 4));
                    u32x4 w; w.x = cvt_pk_bf16(v0[0], v0[1]); w.y = cvt_pk_bf16(v0[2], v0[3]); w.z = cvt_pk_bf16(v1[0], v1[1]); w.w = cvt_pk_bf16(v1[2], v1[3]);
                    __builtin_nontemporal_store(w, (u32x4*)(xn + off + bj * HALF));
                    sq += (v0[0] * v0[0] + v0[1] * v0[1]) + (v0[2] * v0[2] + v0[3] * v0[3]) + (v1[0] * v1[0] + v1[1] * v1[1]) + (v1[2] * v1[2] + v1[3] * v1[3]); }
                sq += __shfl_xor(sq, 16); sq += __shfl_xor(sq, 32);
                if (fq == 0) __hip_atomic_fetch_add(ss + row, sq, __ATOMIC_RELAXED, __HIP_MEMORY_SCOPE_AGENT); }
            asm volatile("" ::: "memory"); }
    }
};
struct EpiHS {
    static constexpr bool PERM = true, AFTER_DRAIN = false;
    bf16_t* O; size_t blk_stride; const float* ss; float invk, eps; int nglu, sa0, sa1, sb0, sb1;
    __device__ __forceinline__ void operator()(const f32x4 (&acc)[2][2][4][2], const Unit& u, int wr, int wc, int fr, int fq) const {
        const int row0 = u.pm * BM + wr * 64 + fr; const int col0 = wc * 32 + 8 * fq;
        float rs[2][4];
#pragma unroll
        for (int ai = 0; ai < 2; ++ai)
#pragma unroll
            for (int m = 0; m < 4; ++m) rs[ai][m] = __builtin_amdgcn_rsqf(__hip_atomic_load(ss + row0 + ai * HALF + m * 16, __ATOMIC_RELAXED, __HIP_MEMORY_SCOPE_AGENT) * invk + eps);
        const bool glu = u.pn < nglu;
#pragma unroll
        for (int bj = 0; bj < 2; ++bj) { const int cb = u.pn * 2 + bj; const bool sl = (cb >= sa0 && cb < sa1) || (cb >= sb0 && cb < sb1);
#pragma unroll
            for (int ai = 0; ai < 2; ++ai)
#pragma unroll
                for (int m = 0; m < 4; ++m) { const int row = row0 + ai * HALF + m * 16; f32x4 v0 = acc[ai][bj][m][0] * rs[ai][m], v1 = acc[ai][bj][m][1] * rs[ai][m];
                    if (glu) {
                        const float a0 = v0[0] * __builtin_amdgcn_rcpf(1.0f + __builtin_amdgcn_exp2f(v1[0] * -1.4426950408889634f)), a1 = v0[1] * __builtin_amdgcn_rcpf(1.0f + __builtin_amdgcn_exp2f(v1[1] * -1.4426950408889634f));
                        const float a2 = v0[2] * __builtin_amdgcn_rcpf(1.0f + __builtin_amdgcn_exp2f(v1[2] * -1.4426950408889634f)), a3 = v0[3] * __builtin_amdgcn_rcpf(1.0f + __builtin_amdgcn_exp2f(v1[3] * -1.4426950408889634f));
                        typedef unsigned u32x2 __attribute__((ext_vector_type(2)));
                        u32x2 w; w.x = cvt_pk_bf16(a0, a1); w.y = cvt_pk_bf16(a2, a3);
                        *(u32x2*)(O + (size_t)u.pn * blk_stride + (size_t)row * 128 + 64 * bj + 16 * wc + 4 * fq) = w;
                    } else {
                        if (sl) { v0 = (f32x4){epi_silu(v0[0]), epi_silu(v0[1]), epi_silu(v0[2]), epi_silu(v0[3])}; v1 = (f32x4){epi_silu(v1[0]), epi_silu(v1[1]), epi_silu(v1[2]), epi_silu(v1[3])}; }
                        bf16_t* rowp = O + (size_t)cb * blk_stride + (size_t)row * 128 + col0;
                        u32x4 w; w.x = cvt_pk_bf16(v0[0], v0[1]); w.y = cvt_pk_bf16(v0[2], v0[3]); w.z = cvt_pk_bf16(v1[0], v1[1]); w.w = cvt_pk_bf16(v1[2], v1[3]);
                        __builtin_nontemporal_store(w, (u32x4*)rowp); } } }
    }
};

template <class Epi, class Sched, bool ALIGN_EPI = false, bool SP2 = false>
__device__ __forceinline__ void gemm_phase(PG8_LAS unsigned char* lds, const Gemm g, const Sched& S, const Epi& E) {
    const int tid = threadIdx.x, wid = __builtin_amdgcn_readfirstlane(tid >> 6), lane = tid & 63, wr = wid >> 2, wc = wid & 3, fr = lane & 15, fq = lane >> 4;
    const int K = g.K, nt = g.ktn ? g.ktn : K / BK;
    unsigned voffA[2], voffB[2];
#pragma unroll
    for (int i = 0; i < 2; ++i) { int R, C; stage_rc(tid * 16 + i * 8192, R, C); const int Rb = Epi::PERM ? ((R & ~31) + perm32(R & 31)) : R;
        voffA[i] = (unsigned)(R * K + C) * 2u; voffB[i] = (unsigned)(Rb * K + C) * 2u; }
    const size_t kstep = (size_t)(BK * 2);
    const size_t hstep = (size_t)HALF * K * 2;
    const size_t tstep = 2 * hstep;
    const unsigned ldsw = (unsigned)wid * 1024u;
    const int aoff = lds_byte(wr * 64 + fr, fq * 8), boff = lds_byte(wc * 32 + fr, fq * 8);
#define PG8_SA(b, h) (((b) * 2 + (h)) * HTB)
#define PG8_SB(b, h) ((4 + (b) * 2 + (h)) * HTB)
#define PG8_STAGE(bufoff, gbase, voff) do { _Pragma("unroll") for (int _i = 0; _i < 2; ++_i) \
        __builtin_amdgcn_global_load_lds((const unsigned*)((const char*)(gbase) + (voff)[_i]), (PG8_LAS unsigned*)(lds + (bufoff) + ldsw + _i * 8192), 16, 0, 0); } while (0)
#define PG8_LDA(dst, b, h) do { _Pragma("unroll") for (int m = 0; m < 4; ++m) _Pragma("unroll") for (int k = 0; k < 2; ++k) dst[m][k] = *(const PG8_LAS bf16x8*)(lds + PG8_SA(b, h) + aoff + m * 2048 + k * 1024); } while (0)
#define PG8_LDB(dst, b, h) do { _Pragma("unroll") for (int n = 0; n < 2; ++n) _Pragma("unroll") for (int k = 0; k < 2; ++k) dst[n][k] = *(const PG8_LAS bf16x8*)(lds + PG8_SB(b, h) + boff + n * 2048 + k * 1024); } while (0)
#define PG8_MMA(ai, bj, At, Bt) do { __builtin_amdgcn_s_setprio(1); _Pragma("unroll") for (int m = 0; m < 4; ++m) _Pragma("unroll") for (int n = 0; n < 2; ++n) _Pragma("unroll") for (int k = 0; k < 2; ++k) \
        acc[ai][bj][m][n] = __builtin_amdgcn_mfma_f32_16x16x32_bf16(Bt[n][k], At[m][k], acc[ai][bj][m][n], 0, 0, 0); __builtin_amdgcn_s_setprio(0); } while (0)
#define PG8_WAIT_V(n) asm volatile("s_waitcnt vmcnt(" #n ")" ::: "memory")
#define PG8_WAIT_L(n) asm volatile("s_waitcnt lgkmcnt(" #n ")" ::: "memory")
#define PG8_BAR __builtin_amdgcn_s_barrier()
#define PG8_SCHED __builtin_amdgcn_sched_barrier(0)
    Unit cur, nxt; int ui = 0;
    if (!S.next(0, cur)) return;
    f32x4 acc[2][2][4][2];
#pragma unroll
    for (int a = 0; a < 2; ++a)
#pragma unroll
        for (int b = 0; b < 2; ++b)
#pragma unroll
            for (int m = 0; m < 4; ++m)
#pragma unroll
                for (int n = 0; n < 2; ++n) acc[a][b][m][n] = (f32x4){0.f, 0.f, 0.f, 0.f};
    bf16x8 At[4][2], B0[2][2], B1[2][2];
    const char* cA = (const char*)g.A + (size_t)cur.pm * tstep; const char* cB = (const char*)g.Bt + (size_t)cur.pn * tstep;
    S.a_ready(cur);
    if constexpr (SP2) {
        PG8_STAGE(PG8_SB(0, 0), cB, voffB); PG8_STAGE(PG8_SB(0, 1), cB + hstep, voffB); PG8_STAGE(PG8_SA(0, 0), cA, voffA); PG8_STAGE(PG8_SA(0, 1), cA + hstep, voffA);
        if (wr == 1) PG8_BAR;
        PG8_WAIT_V(2); PG8_BAR;
        PG8_STAGE(PG8_SB(1, 0), cB + kstep, voffB); PG8_STAGE(PG8_SA(1, 0), cA + kstep, voffA); PG8_STAGE(PG8_SB(1, 1), cB + hstep + kstep, voffB);
        PG8_WAIT_V(6); PG8_BAR;
    } else {
        PG8_STAGE(PG8_SB(0, 0), cB, voffB); PG8_STAGE(PG8_SA(0, 0), cA, voffA); PG8_STAGE(PG8_SB(0, 1), cB + hstep, voffB); PG8_STAGE(PG8_SA(0, 1), cA + hstep, voffA);
        if (wr == 1) PG8_BAR;
        PG8_WAIT_V(4); PG8_BAR;
        PG8_STAGE(PG8_SB(1, 0), cB + kstep, voffB); PG8_STAGE(PG8_SA(1, 0), cA + kstep, voffA); PG8_STAGE(PG8_SB(1, 1), cB + hstep + kstep, voffB);
        PG8_WAIT_V(6); PG8_BAR;
    }
    for (;;) {
        const bool has_next = S.next(ui + 1, nxt);
        const char* nA = has_next ? (const char*)g.A + (size_t)nxt.pm * tstep : cA; const char* nB = has_next ? (const char*)g.Bt + (size_t)nxt.pn * tstep : cB;
        for (int t = 0; t < nt; t += 2) {
            const bool last = (t == nt - 2);
            const char* a1 = cA + (size_t)(t + 1) * kstep;
            const char* a2 = last ? nA : cA + (size_t)(t + 2) * kstep; const char* b2 = last ? nB : cB + (size_t)(t + 2) * kstep;
            const char* a3 = a2 + kstep; const char* b3 = b2 + kstep;
            if (last && has_next) S.a_ready(nxt);
            if constexpr (SP2) {
            PG8_LDB(B0, 0, 0); PG8_LDB(B1, 0, 1); PG8_SCHED; PG8_LDA(At, 0, 0); PG8_STAGE(PG8_SA(1, 1), a1 + hstep, voffA);
            PG8_WAIT_V(8); PG8_WAIT_L(0); PG8_BAR; PG8_MMA(0, 0, At, B0); PG8_MMA(0, 1, At, B1); PG8_BAR; PG8_SCHED;
            PG8_LDA(At, 0, 1); PG8_STAGE(PG8_SB(0, 0), b2, voffB); PG8_STAGE(PG8_SB(0, 1), b2 + hstep, voffB); PG8_STAGE(PG8_SA(0, 0), a2, voffA);
            PG8_WAIT_V(8); PG8_WAIT_L(0); PG8_BAR; PG8_MMA(1, 0, At, B0); PG8_MMA(1, 1, At, B1); PG8_BAR; PG8_SCHED;
            PG8_LDB(B0, 1, 0); PG8_LDB(B1, 1, 1); PG8_SCHED; PG8_LDA(At, 1, 0); PG8_STAGE(PG8_SA(0, 1), a2 + hstep, voffA);
            PG8_WAIT_V(8); PG8_WAIT_L(0); PG8_BAR; PG8_MMA(0, 0, At, B0); PG8_MMA(0, 1, At, B1); PG8_BAR; PG8_SCHED;
            PG8_LDA(At, 1, 1); PG8_STAGE(PG8_SB(1, 0), b3, voffB); PG8_STAGE(PG8_SB(1, 1), b3 + hstep, voffB); PG8_STAGE(PG8_SA(1, 0), a3, voffA);
            PG8_WAIT_V(8); PG8_WAIT_L(0); PG8_BAR; PG8_MMA(1, 0, At, B0); PG8_MMA(1, 1, At, B1); PG8_BAR; PG8_SCHED;
            } else {
            PG8_LDB(B0, 0, 0); PG8_SCHED; PG8_LDA(At, 0, 0); PG8_STAGE(PG8_SA(1, 1), a1 + hstep, voffA);
            PG8_WAIT_L(8); PG8_BAR; PG8_WAIT_L(0); PG8_MMA(0, 0, At, B0); PG8_BAR; PG8_SCHED;
            PG8_LDB(B1, 0, 1); PG8_STAGE(PG8_SB(0, 0), b2, voffB);
            PG8_BAR; PG8_WAIT_L(0); PG8_MMA(0, 1, At, B1); PG8_BAR;
            PG8_LDA(At, 0, 1); PG8_STAGE(PG8_SA(0, 0), a2, voffA);
            PG8_BAR; PG8_WAIT_L(0); PG8_MMA(1, 0, At, B0); PG8_BAR; PG8_SCHED;
            PG8_STAGE(PG8_SB(0, 1), b2 + hstep, voffB);
            PG8_WAIT_V(6); PG8_BAR; PG8_MMA(1, 1, At, B1); PG8_BAR;
            PG8_LDB(B0, 1, 0); PG8_SCHED; PG8_LDA(At, 1, 0); PG8_STAGE(PG8_SA(0, 1), a2 + hstep, voffA);
            PG8_WAIT_L(8); PG8_BAR; PG8_WAIT_L(0); PG8_MMA(0, 0, At, B0); PG8_BAR; PG8_SCHED;
            PG8_LDB(B1, 1, 1); PG8_STAGE(PG8_SB(1, 0), b3, voffB);
            PG8_BAR; PG8_WAIT_L(0); PG8_MMA(0, 1, At, B1); PG8_BAR;
            PG8_LDA(At, 1, 1); PG8_STAGE(PG8_SA(1, 0), a3, voffA);
            PG8_BAR; PG8_WAIT_L(0); PG8_MMA(1, 0, At, B0); PG8_BAR; PG8_SCHED;
            PG8_STAGE(PG8_SB(1, 1), b3 + hstep, voffB);
            PG8_WAIT_V(6); PG8_BAR; PG8_MMA(1, 1, At, B1); PG8_BAR;
            }
        }
        if constexpr (ALIGN_EPI) { if (wr == 0) PG8_BAR; }
        if constexpr (!Epi::AFTER_DRAIN) { E(acc, cur, wr, wc, fr, fq); S.done(cur); }
        if (!has_next) break;
#pragma unroll
        for (int a = 0; a < 2; ++a)
#pragma unroll
            for (int b = 0; b < 2; ++b)
#pragma unroll
                for (int m = 0; m < 4; ++m)
#pragma unroll
                    for (int n = 0; n < 2; ++n) acc[a][b][m][n] = (f32x4){0.f, 0.f, 0.f, 0.f};
        cur = nxt; cA = nA; cB = nB; ++ui;
        if constexpr (ALIGN_EPI) { if (wr == 1) PG8_BAR; }
    }
    PG8_WAIT_V(0);
    if constexpr (!ALIGN_EPI) { if (wr == 0) PG8_BAR; }
    PG8_BAR;
    if constexpr (Epi::AFTER_DRAIN) { E.fused(acc, cur, wr, wc, fr, fq, lds, wid, lane); S.done(cur); }
#undef PG8_SA
#undef PG8_SB
#undef PG8_STAGE
#undef PG8_LDA
#undef PG8_LDB
#undef PG8_MMA
#undef PG8_WAIT_V
#undef PG8_WAIT_L
#undef PG8_BAR
#undef PG8_SCHED
}
}

#define GAS __attribute__((address_space(1)))
#define LAS __attribute__((address_space(3)))
typedef unsigned short bf16;
typedef unsigned v4u __attribute__((ext_vector_type(4)));
typedef unsigned v2u __attribute__((ext_vector_type(2)));
typedef float f32x4 __attribute__((ext_vector_type(4)));
typedef float f32x2 __attribute__((ext_vector_type(2)));
typedef float f32x16 __attribute__((ext_vector_type(16)));
typedef short bf16x8 __attribute__((ext_vector_type(8)));
typedef short s16x4 __attribute__((ext_vector_type(4)));
typedef GAS unsigned gu32;
#define RLX_AGENT __ATOMIC_RELAXED, __HIP_MEMORY_SCOPE_AGENT
#define LDS_WAIT() asm volatile("s_waitcnt lgkmcnt(0)" ::: "memory")
#define VM_WAIT() asm volatile("s_waitcnt vmcnt(0)" ::: "memory")
#define SBAR() __builtin_amdgcn_sched_barrier(0)
__device__ __forceinline__ unsigned cvtpk(float lo, float hi) { return pg8::cvt_pk_bf16(lo, hi); }
__device__ __forceinline__ float bflo(unsigned w) { return __uint_as_float(w << 16); }
__device__ __forceinline__ float bfhi(unsigned w) { return __uint_as_float(w & 0xffff0000u); }
__device__ __forceinline__ float bf2f(bf16 v) { return __uint_as_float(((unsigned)v) << 16); }
__device__ __forceinline__ float fast_exp(float x) { return __builtin_amdgcn_exp2f(x * 1.4426950408889634f); }
__device__ __forceinline__ float sigmoidf_(float x) { return __builtin_amdgcn_rcpf(1.0f + fast_exp(-x)); }
__device__ __forceinline__ float siluf_(float x) { return x * sigmoidf_(x); }

#ifndef DBG_SKIP
#define DBG_SKIP 0
#endif
constexpr int NWAVES = 8, NTHREADS = 512;
constexpr int BATCH = 16, SEQ = 2048, DM = 2048, MROWS = BATCH * SEQ;
constexpr int N0 = 7936, NB0 = 62;
constexpr int N1 = 8192, NB1 = 64;
constexpr int K1OUT = 1536;
constexpr float NORM_EPS = 1e-6f;
constexpr float ATT_SCALE = 0.08838834764831845f;
constexpr int CB_RQ = 0, CB_RK = 8, CB_RV = 16, CB_RZ = 24, CB_NQ = 32, CB_KC = 40, CB_VC = 42, CB_KS = 44, CB_VS = 46, CB_KW = 48, CB_VW = 50, CB_NG = 52, CB_NZ = 53;
constexpr int CB_CU = 0, CB_CG = 8, CB_CZ = 16, CB_DQ = 24, CB_DK = 36, CB_DV = 48, CB_DZ = 60;

constexpr size_t MiB = 1u << 20;
constexpr size_t WS_CTL = 0, CTL_ZERO_BYTES = 1 * MiB;
constexpr size_t WS_W0IN = 2 * MiB;
constexpr size_t WS_W0OUT = 34 * MiB;
constexpr size_t WS_W1IN = 42 * MiB;
constexpr size_t WS_W1OUT = 74 * MiB;
constexpr size_t WS_CW = 80 * MiB;
constexpr size_t WS_MISC = 82 * MiB;
constexpr size_t WS_KCMP = 84 * MiB;
constexpr size_t WS_CPR = 86 * MiB;
constexpr size_t WS_A = 96 * MiB;
constexpr size_t WS_MIX = 224 * MiB;
constexpr size_t WS_H = 352 * MiB;
constexpr size_t WS_END = 864 * MiB;
constexpr size_t HBLK = (size_t)MROWS * 128;
constexpr size_t ROPE_OFF = 4096;
#ifndef P0_REP_SKIP
#define P0_REP_SKIP 0
#endif
#ifndef CONV_FIN_IN_UNIT
#define CONV_FIN_IN_UNIT 1
#endif
#ifndef DEFER_W1
#define DEFER_W1 0
#endif
#ifndef FOLD_P2
#define FOLD_P2 1
#endif
#ifndef FX_FORCE
#define FX_FORCE 0
#endif
#ifndef FX_CONST
#define FX_CONST 0
#endif
#ifndef FX_NSA
#define FX_NSA 1
#endif
#ifndef FX_DIL
#define FX_DIL 1
#endif
constexpr size_t FXB_OFF = 1280 * 1024;
constexpr size_t WS_DPART = WS_A, WS_DLSE = WS_A + 96 * MiB;
constexpr size_t WS_CPR2 = WS_H + (size_t)62 * 8 * MiB;
constexpr int CW_BAR = 4096;
constexpr int CW_Q = 8192;

constexpr int RING_BYTES = 131072;
constexpr int XTRA_OFF = RING_BYTES;
constexpr int LDS_BYTES = 147456;
constexpr int LDSCTL_OFF = LDS_BYTES - 1024;

#define XB_TMO      128
#define XB_XCNT(j)  (256  + 64 * (j))
#define XB_XSUB(j)  (1280 + 64 * (j))
#define XB_XGEN(j)  (2304 + 64 * (j))
#define XB_TOP      3328
#define XB_TOPGEN   3392
#define XCD_BAR_WORDS 3456
#define XB_SPIN_CAP (1u << 18)

__device__ __forceinline__ unsigned xb_ld(unsigned* p)              { return __hip_atomic_load(p, __ATOMIC_RELAXED, __HIP_MEMORY_SCOPE_AGENT); }
__device__ __forceinline__ unsigned xb_add(unsigned* p, unsigned v) { return __hip_atomic_fetch_add(p, v, __ATOMIC_RELAXED, __HIP_MEMORY_SCOPE_AGENT); }
__device__ __forceinline__ unsigned xb_xcc_id() { return (unsigned)__builtin_amdgcn_s_getreg((3 << 11) | 20) & 0xFu; }
#define XB_SPIN(cond, bar) do { unsigned _sp = 0; while (cond) { __builtin_amdgcn_s_sleep(1); \
    if ((++_sp & 255u) == 0u) { if (xb_ld(&(bar)[XB_TMO])) break; if (_sp > XB_SPIN_CAP) { atomicAdd(&(bar)[XB_TMO], 1u); break; } } } } while (0)

struct XcdBarrier {
    unsigned* bar; unsigned x;
    volatile LAS unsigned* st;
};

__device__ __forceinline__ XcdBarrier xcd_barrier_post(unsigned* bar, volatile LAS unsigned* st) {
    XcdBarrier b; b.bar = bar; b.x = xb_xcc_id(); b.st = st;
    if (threadIdx.x == 0) (void)xb_add(&bar[XB_XCNT(b.x)], 1u);
    return b;
}
__device__ __forceinline__ void xcd_barrier_complete(unsigned* bar, unsigned x, unsigned& nloc, unsigned& nx) {
    const unsigned G = gridDim.x * gridDim.y * gridDim.z;
    unsigned sum, cnt, mine, sp = 0u;
    for (;;) {
        sum = 0u; cnt = 0u; mine = 0u;
#pragma unroll
        for (unsigned j = 0; j < 16; ++j) { const unsigned c = xb_ld(&bar[XB_XCNT(j)]); sum += c; cnt += (c > 0u) ? 1u : 0u; mine = (j == x) ? c : mine; }
        if (sum == G) break;
        __builtin_amdgcn_s_sleep(1);
        if ((++sp & 255u) == 0u) { if (xb_ld(&bar[XB_TMO])) break; if (sp > XB_SPIN_CAP) { atomicAdd(&bar[XB_TMO], 1u); break; } }
    }
    nloc = mine > 0u ? mine : 1u; nx = cnt > 0u ? cnt : 1u;
}

__device__ __forceinline__ void xcd_barrier(const XcdBarrier& b) {
    asm volatile("s_waitcnt vmcnt(0)" ::: "memory");
    __syncthreads();
    if (threadIdx.x == 0) {
        unsigned* bar = b.bar;
        __builtin_amdgcn_s_waitcnt(0);
        unsigned nloc = b.st[0], nx = b.st[1];
        if (nloc == 0u) { xcd_barrier_complete(bar, b.x, nloc, nx); b.st[0] = nloc; b.st[1] = nx; }
        const unsigned old = xb_add(&bar[XB_XSUB(b.x)], 1u);
        const unsigned gen = old / nloc;
        if (old + 1u == (gen + 1u) * nloc) {
            __builtin_amdgcn_fence(__ATOMIC_RELEASE, "agent");
            asm volatile("s_waitcnt vmcnt(0)" ::: "memory");
            const unsigned og = xb_add(&bar[XB_TOP], 1u);
            const unsigned tg = og / nx;
            if (og + 1u == (tg + 1u) * nx) xb_add(&bar[XB_TOPGEN], 1u);
            else XB_SPIN(xb_ld(&bar[XB_TOPGEN]) == tg, bar);
            __builtin_amdgcn_fence(__ATOMIC_ACQUIRE, "agent");
            xb_add(&bar[XB_XGEN(b.x)], 1u);
            asm volatile("s_waitcnt vmcnt(0)" ::: "memory");
        } else {
            XB_SPIN(xb_ld(&bar[XB_XGEN(b.x)]) == gen, bar);
            __builtin_amdgcn_fence(__ATOMIC_ACQUIRE, "agent");
            asm volatile("s_waitcnt vmcnt(0)" ::: "memory");
        }
    }
    __syncthreads();
}


struct Frame {
    LAS unsigned char* lds;
    volatile LAS unsigned* MISC;
    gu32* ctl;
    int tid, lane, wave, G;
    unsigned char* ws;
    const float* in[22];
    float* out;
};
__device__ __forceinline__ float wave_sum(float v) {
#pragma unroll
    for (int o = 1; o < 64; o <<= 1) v += __shfl_xor(v, o);
    return v;
}
__device__ __forceinline__ int wq_first(Frame& F, int q) {
    __syncthreads();
    if (F.tid == 0) F.MISC[16] = __hip_atomic_fetch_add(F.ctl + CW_Q + 64 * q, 1u, RLX_AGENT);
    __syncthreads();
    return (int)F.MISC[16];
}
__device__ __forceinline__ unsigned wq_issue(Frame& F, int q) {
    unsigned r = 0u;
    if (F.tid == 0) r = __hip_atomic_fetch_add(F.ctl + CW_Q + 64 * q, 1u, RLX_AGENT);
    return r;
}
__device__ __forceinline__ int wq_take(Frame& F, unsigned r) {
    __syncthreads();
    if (F.tid == 0) F.MISC[16] = r;
    __syncthreads();
    return (int)F.MISC[16];
}
__device__ __forceinline__ bf16* hblk(Frame& F, int cb) { return (bf16*)(F.ws + WS_H) + (size_t)cb * HBLK; }

namespace att {
constexpr int SHM = 16384;
constexpr int OFF_V = 0, OFF_K = 2 * SHM, OFF_WS = 4 * SHM, OFF_KG = 4 * SHM + 8192 + 24576;
constexpr float THR = 8.f;
#define KSWZ(row, colB) ((row) * 256 + ((colB) ^ (((row) & 7) << 4)))
__device__ __forceinline__ int v_st(int k, int c) { const int kk = (k & ~0xC) | ((k & 4) << 1) | ((k & 8) >> 1); return ((kk >> 3) * 4 + (c >> 5)) * 512 + ((kk & 7) * 32 + (c & 31)) * 2; }
__device__ __forceinline__ int v_rd_base(int lane) { return ((lane & 3) << 3) | (((lane >> 2) & 3) << 6) | (((lane >> 4) & 1) << 5) | (((lane >> 5) & 1) << 8); }
constexpr int v_rd_off(int d0, int ks, int half) { return d0 * 512 + ks * 4096 + half * 2048; }
__device__ __forceinline__ int crow(int r, int hi) { return (r & 3) + 8 * (r >> 2) + 4 * hi; }
__device__ __forceinline__ float xhi_f(float v, int hi) { auto rr = __builtin_amdgcn_permlane32_swap(__float_as_uint(v), __float_as_uint(v), false, false); return __uint_as_float(hi ? rr[0] : rr[1]); }
__device__ __forceinline__ unsigned xhi_u(unsigned v, int hi) { auto rr = __builtin_amdgcn_permlane32_swap(v, v, false, false); return hi ? rr[0] : rr[1]; }
__device__ __forceinline__ void mask_tile(f32x16& p0, f32x16& p1, int dq, unsigned W) {
    const float NEG = -__builtin_inff();
#pragma unroll
    for (int r = 0; r < 16; ++r) {
        const int c = (r & 3) + 8 * (r >> 2);
        if ((unsigned)(dq - c) >= W) p0[r] = NEG;
        if ((unsigned)(dq - c - 32) >= W) p1[r] = NEG;
    }
}
__device__ __forceinline__ void partialSM(f32x16& p0, f32x16& p1, float& m_reg, float& mn, float& alpha) {
    float pmax = p0[0];
#pragma unroll
    for (int r = 1; r < 16; ++r) pmax = fmaxf(pmax, p0[r]);
#pragma unroll
    for (int r = 0; r < 16; ++r) pmax = fmaxf(pmax, p1[r]);
    { auto rr = __builtin_amdgcn_permlane32_swap(__float_as_uint(pmax), __float_as_uint(pmax), false, false);
      pmax = fmaxf(__uint_as_float(rr[0]), __uint_as_float(rr[1])); }
    constexpr float C2 = 1.4426950408889634f * ATT_SCALE;
    if (__builtin_expect(__all((pmax - m_reg) * ATT_SCALE <= THR), 1)) { mn = m_reg; alpha = 1.f; }
    else { mn = fmaxf(m_reg, pmax); alpha = __builtin_amdgcn_exp2f((m_reg - mn) * C2); m_reg = mn; }
    const float mnL = -mn * C2;
#pragma unroll
    for (int r = 0; r < 16; ++r) p0[r] = fmaf(p0[r], C2, mnL);
#pragma unroll
    for (int r = 0; r < 16; ++r) p1[r] = fmaf(p1[r], C2, mnL);
#pragma unroll
    for (int r = 0; r < 16; ++r) p0[r] = __builtin_amdgcn_exp2f(p0[r]);
}
#define ATT_PK4(P, B_, OUT) do { unsigned a0 = cvtpk(P[B_+0], P[B_+1]), a1 = cvtpk(P[B_+2], P[B_+3]);                          \
        unsigned b0 = cvtpk(P[B_+4], P[B_+5]), b1 = cvtpk(P[B_+6], P[B_+7]);                                             \
        auto r0 = __builtin_amdgcn_permlane32_swap(a0, b0, false, false); auto r1 = __builtin_amdgcn_permlane32_swap(a1, b1, false, false); \
        v4u w = {r0[0], r1[0], r0[1], r1[1]}; OUT = *reinterpret_cast<bf16x8*>(&w); } while (0)
__device__ __forceinline__ void pack_p(const f32x16& p0, const f32x16& p1, bf16x8& pa0, bf16x8& pa1, bf16x8& pa2, bf16x8& pa3) {
    ATT_PK4(p0, 0, pa0); ATT_PK4(p0, 8, pa1); ATT_PK4(p1, 0, pa2); ATT_PK4(p1, 8, pa3);
}
__device__ __forceinline__ void finishSM(f32x16& p0, f32x16& p1, float alpha, float& l_reg, bf16x8& pa0, bf16x8& pa1, bf16x8& pa2, bf16x8& pa3) {
#pragma unroll
    for (int r = 0; r < 16; ++r) p1[r] = __builtin_amdgcn_exp2f(p1[r]);
    float ps = 0;
#pragma unroll
    for (int r = 0; r < 16; ++r) ps += p0[r];
#pragma unroll
    for (int r = 0; r < 16; ++r) ps += p1[r];
    { auto rr = __builtin_amdgcn_permlane32_swap(__float_as_uint(ps), __float_as_uint(ps), false, false);
      ps = __uint_as_float(rr[0]) + __uint_as_float(rr[1]); }
    l_reg = l_reg * alpha + ps;
    pack_p(p0, p1, pa0, pa1, pa2, pa3);
}
template <int KB>
__device__ __forceinline__ void qkt(f32x16& p0, f32x16& p1, const LAS char* lds, int r32, int hi, const bf16x8 (&qr)[8]) {
    p0 = f32x16{}; p1 = f32x16{};
    const LAS char* kb[4];
#pragma unroll
    for (int dd = 0; dd < 4; ++dd) kb[dd] = lds + OFF_K + KB * SHM + KSWZ(r32, (dd * 16 + hi * 8) * 2);
    bf16x8 f[2][4];
#define QK_LD(g, s) do { const LAS char* a0_ = kb[(2 * (g)) & 3] + ((2 * (g)) >> 2) * 128; const LAS char* a1_ = kb[(2 * (g) + 1) & 3] + ((2 * (g) + 1) >> 2) * 128; \
        f[s][0] = *reinterpret_cast<const LAS bf16x8*>(a0_); f[s][1] = *reinterpret_cast<const LAS bf16x8*>(a0_ + 32 * 256); \
        f[s][2] = *reinterpret_cast<const LAS bf16x8*>(a1_); f[s][3] = *reinterpret_cast<const LAS bf16x8*>(a1_ + 32 * 256); } while (0)
#define QK_MM(g, s) do { p0 = __builtin_amdgcn_mfma_f32_32x32x16_bf16(f[s][0], qr[2 * (g)], p0, 0, 0, 0); p1 = __builtin_amdgcn_mfma_f32_32x32x16_bf16(f[s][1], qr[2 * (g)], p1, 0, 0, 0); \
        p0 = __builtin_amdgcn_mfma_f32_32x32x16_bf16(f[s][2], qr[2 * (g) + 1], p0, 0, 0, 0); p1 = __builtin_amdgcn_mfma_f32_32x32x16_bf16(f[s][3], qr[2 * (g) + 1], p1, 0, 0, 0); } while (0)
    QK_LD(0, 0); SBAR();
    QK_LD(1, 1); SBAR(); QK_MM(0, 0); SBAR();
    QK_LD(2, 0); SBAR(); QK_MM(1, 1); SBAR();
    QK_LD(3, 1); SBAR(); QK_MM(2, 0); SBAR();
    QK_MM(3, 1); SBAR();
#undef QK_LD
#undef QK_MM
}
template <int VB>
__device__ __forceinline__ void pv_tile(f32x16 (&o)[4], int vb0, bf16x8 pa0, bf16x8 pa1, bf16x8 pa2, bf16x8 pa3) {
#define TRRD(dst, off) asm volatile("ds_read_b64_tr_b16 %0, %1 offset:%2" : "=&v"(dst) : "v"(vb0), "i"(off) : "memory")
#define PV_D0(d0) do { s16x4 l0, l1, l2, l3, h0, h1, h2, h3; constexpr int b_ = VB * SHM + v_rd_off(d0, 0, 0); \
        TRRD(l0, b_); TRRD(h0, b_ + 2048); TRRD(l1, b_ + 4096); TRRD(h1, b_ + 6144); TRRD(l2, b_ + 8192); TRRD(h2, b_ + 10240); TRRD(l3, b_ + 12288); TRRD(h3, b_ + 14336); \
        asm volatile("s_waitcnt lgkmcnt(0)" ::: "memory"); SBAR();   \
        o[d0] = __builtin_amdgcn_mfma_f32_32x32x16_bf16(pa0, (bf16x8){l0[0], l0[1], l0[2], l0[3], h0[0], h0[1], h0[2], h0[3]}, o[d0], 0, 0, 0);   \
        o[d0] = __builtin_amdgcn_mfma_f32_32x32x16_bf16(pa1, (bf16x8){l1[0], l1[1], l1[2], l1[3], h1[0], h1[1], h1[2], h1[3]}, o[d0], 0, 0, 0);   \
        o[d0] = __builtin_amdgcn_mfma_f32_32x32x16_bf16(pa2, (bf16x8){l2[0], l2[1], l2[2], l2[3], h2[0], h2[1], h2[2], h2[3]}, o[d0], 0, 0, 0);   \
        o[d0] = __builtin_amdgcn_mfma_f32_32x32x16_bf16(pa3, (bf16x8){l3[0], l3[1], l3[2], l3[3], h3[0], h3[1], h3[2], h3[3]}, o[d0], 0, 0, 0); } while (0)
    PV_D0(0); PV_D0(1); PV_D0(2); PV_D0(3);
#undef PV_D0
#undef TRRD
}
__device__ __forceinline__ void row_bcast(float v, LAS float* wsf, int r32, int hi, float (&f)[16]) {
    asm volatile("" ::: "memory");
    if (hi == 0) wsf[r32] = v;
    asm volatile("s_waitcnt lgkmcnt(0)" ::: "memory");
#pragma unroll
    for (int r = 0; r < 16; ++r) f[r] = wsf[crow(r, hi)];
    asm volatile("s_waitcnt lgkmcnt(0)" ::: "memory");
}
template <int N> __device__ __forceinline__ float dpp_ror(float v) { return __builtin_bit_cast(float, __builtin_amdgcn_update_dpp(0, __builtin_bit_cast(int, v), 0x120 + N, 0xf, 0xf, false)); }
__device__ __forceinline__ float row16_sum(float v) { v += dpp_ror<8>(v); v += dpp_ror<4>(v); v += dpp_ror<2>(v); v += dpp_ror<1>(v); return v; }
__device__ __forceinline__ void norm_row8(bf16x8& k, const LAS float* g8) {
    v4u w = *reinterpret_cast<v4u*>(&k);
    float x[8] = {bflo(w.x), bfhi(w.x), bflo(w.y), bfhi(w.y), bflo(w.z), bfhi(w.z), bflo(w.w), bfhi(w.w)};
    float ss = 0.f;
#pragma unroll
    for (int e = 0; e < 8; ++e) ss += x[e] * x[e];
    ss = row16_sum(ss);
    const float rstd = __builtin_amdgcn_rsqf(ss * (1.f / 128.f) + NORM_EPS);
    const f32x4 g0 = *(const LAS f32x4*)g8, g1 = *(const LAS f32x4*)(g8 + 4);
    w.x = cvtpk(x[0] * rstd * g0.x, x[1] * rstd * g0.y); w.y = cvtpk(x[2] * rstd * g0.z, x[3] * rstd * g0.w);
    w.z = cvtpk(x[4] * rstd * g1.x, x[5] * rstd * g1.y); w.w = cvtpk(x[6] * rstd * g1.z, x[7] * rstd * g1.w);
    k = *reinterpret_cast<bf16x8*>(&w);
}
__device__ __forceinline__ void norm_q(bf16x8 (&qr)[8], const float* g, int hi) {
    float ss = 0.f;
#pragma unroll
    for (int d0 = 0; d0 < 8; ++d0) { const v4u w = *reinterpret_cast<const v4u*>(&qr[d0]);
        const float a0 = bflo(w.x), a1 = bfhi(w.x), a2 = bflo(w.y), a3 = bfhi(w.y), a4 = bflo(w.z), a5 = bfhi(w.z), a6 = bflo(w.w), a7 = bfhi(w.w);
        ss += (a0 * a0 + a1 * a1) + (a2 * a2 + a3 * a3) + (a4 * a4 + a5 * a5) + (a6 * a6 + a7 * a7); }
    ss += xhi_f(ss, hi);
    const float rstd = __builtin_amdgcn_rsqf(ss * (1.f / 128.f) + NORM_EPS);
#pragma unroll
    for (int d0 = 0; d0 < 8; ++d0) { v4u w = *reinterpret_cast<v4u*>(&qr[d0]);
        const f32x4 g0 = *(const f32x4*)(g + d0 * 16 + hi * 8), g1 = *(const f32x4*)(g + d0 * 16 + hi * 8 + 4);
        w.x = cvtpk(bflo(w.x) * rstd * g0.x, bfhi(w.x) * rstd * g0.y); w.y = cvtpk(bflo(w.y) * rstd * g0.z, bfhi(w.y) * rstd * g0.w);
        w.z = cvtpk(bflo(w.z) * rstd * g1.x, bfhi(w.z) * rstd * g1.y); w.w = cvtpk(bflo(w.w) * rstd * g1.z, bfhi(w.w) * rstd * g1.w);
        qr[d0] = *reinterpret_cast<bf16x8*>(&w); }
}
__device__ __forceinline__ void settle_q(bf16x8 (&qr)[8]) {
#pragma unroll
    for (int d0 = 0; d0 < 8; ++d0) { v4u w = *reinterpret_cast<v4u*>(&qr[d0]);
        asm volatile("v_mov_b32 %0, %0\n\tv_mov_b32 %1, %1\n\tv_mov_b32 %2, %2\n\tv_mov_b32 %3, %3" : "+v"(w.x), "+v"(w.y), "+v"(w.z), "+v"(w.w));
        qr[d0] = *reinterpret_cast<bf16x8*>(&w); }
}
struct Stage { bf16x8 k0, k1, v0, v1; };
template <class Pol, class TI>
__device__ __forceinline__ void stage_load(const Pol& P, const TI& ti, Stage& S, int sr, int sc) {
    S.k0 = *reinterpret_cast<const bf16x8*>(P.krow(ti, sr) + sc); S.k1 = *reinterpret_cast<const bf16x8*>(P.krow(ti, 32 + sr) + sc);
    S.v0 = *reinterpret_cast<const bf16x8*>(P.vrow(ti, sr) + sc); S.v1 = *reinterpret_cast<const bf16x8*>(P.vrow(ti, 32 + sr) + sc);
}
__device__ __forceinline__ void stage_write(LAS char* lds, int buf, const Stage& S, int kws, int vst0, int vst1) {
    *(LAS bf16x8*)(lds + OFF_K + buf * SHM + kws) = S.k0; *(LAS bf16x8*)(lds + OFF_K + buf * SHM + kws + 32 * 256) = S.k1;
    *(LAS bf16x8*)(lds + OFF_V + buf * SHM + vst0) = S.v0; *(LAS bf16x8*)(lds + OFF_V + buf * SHM + vst1) = S.v1;
}
template <int BUF, int VAR, class Pol, class TI>
__device__ __forceinline__ void tile_compute(const Pol& P, const TI& ti, LAS char* lds, int vb0, LAS float* wsf, int wid, int r32, int hi,
                                             const bf16x8 (&qr)[8], f32x16 (&o)[4], float& m_reg, float& l_reg) {
    f32x16 p0, p1; bf16x8 pa0, pa1, pa2, pa3;
    if (VAR & 1) { p0 = f32x16{}; p1 = f32x16{}; p0[0] = (float)r32; } else qkt<BUF>(p0, p1, lds, r32, hi, qr);
    if constexpr (Pol::SOFTMAX) {
        P.mask(p0, p1, ti, wid, r32, hi);
        float mn, alpha;
        partialSM(p0, p1, m_reg, mn, alpha);
        if (__any(alpha < 1.f)) {
            float f[16]; row_bcast(alpha, wsf, r32, hi, f);
#pragma unroll
            for (int d = 0; d < 4; ++d)
#pragma unroll
                for (int r = 0; r < 16; ++r) o[d][r] *= f[r];
        }
        finishSM(p0, p1, alpha, l_reg, pa0, pa1, pa2, pa3);
    } else {
        P.weights(p0, p1, ti, wid, r32, hi);
        pack_p(p0, p1, pa0, pa1, pa2, pa3);
    }
    SBAR();
    if (VAR & 2) { o[0][0] += __builtin_bit_cast(float, (int)pa0[0]) + __builtin_bit_cast(float, (int)pa1[0]) + __builtin_bit_cast(float, (int)pa2[0]) + __builtin_bit_cast(float, (int)pa3[0]); } else pv_tile<BUF>(o, vb0, pa0, pa1, pa2, pa3);
}
template <class Pol>
__device__ __forceinline__ void stage_prefetch(const Pol& P, Stage& S0, Stage& S1, int tid) {
    const int sr = tid >> 4, sc = (tid & 15) * 8;
    { const auto ti = P.tile(0); stage_load(P, ti, S0, sr, sc); }
    if (P.ntiles() > 1) { const auto t1 = P.tile(1); stage_load(P, t1, S1, sr, sc); }
}
template <class Pol, int VAR, bool PRE>
__device__ __forceinline__ void att_pass_core(const Pol& P, LAS char* lds, const bf16x8 (&qr)[8], f32x16 (&o)[4], float& m_reg, float& l_reg, int tid, Stage& S0, Stage& S1) {
    const int wid = __builtin_amdgcn_readfirstlane(tid >> 6), lane = tid & 63, r32 = lane & 31, hi = lane >> 5;
    const int sr = tid >> 4, sc = (tid & 15) * 8;
    const int kws = KSWZ(sr, sc * 2), vst0 = v_st(sr, sc), vst1 = v_st(32 + sr, sc);
    const int vb0 = (int)(unsigned)(uintptr_t)(lds + OFF_V) + v_rd_base(lane);
    LAS float* wsf = (LAS float*)(lds + OFF_WS) + wid * 256;
    const int NT = P.ntiles();
    const LAS float* kg = (const LAS float*)(lds + OFF_KG) + sc;
    if constexpr (Pol::KNORM) { int tk = tid; asm volatile("" : "+v"(tk)); if (tk < 128) ((LAS float*)(lds + OFF_KG))[tk] = P.kgain[tk]; }
    { if constexpr (!PRE) { const auto ti = P.tile(0); stage_load(P, ti, S0, sr, sc);
      if (NT > 1) { const auto t1 = P.tile(1); stage_load(P, t1, S1, sr, sc); } }
      if constexpr (Pol::KNORM) { __syncthreads(); norm_row8(S0.k0, kg); norm_row8(S0.k1, kg); }
      stage_write(lds, 0, S0, kws, vst0, vst1);
      if (NT > 2) { const auto t2 = P.tile(2); stage_load(P, t2, S0, sr, sc); } }
    __syncthreads();
    for (int t = 0; t < NT; t += 2) {
        { const auto ti = P.tile(t);
          SBAR();
          if (P.active(ti, wid)) tile_compute<0, VAR>(P, ti, lds, vb0, wsf, wid, r32, hi, qr, o, m_reg, l_reg);
          SBAR();
          if (t + 1 < NT) { if constexpr (Pol::KNORM) { norm_row8(S1.k0, kg); norm_row8(S1.k1, kg); } if (!(VAR & 8)) stage_write(lds, 1, S1, kws, vst0, vst1);
              if (!(VAR & 4) && t + 3 < NT) { const auto tn = P.tile(t + 3); stage_load(P, tn, S1, sr, sc); } }
          if (!(VAR & 16)) __syncthreads(); }
        if (t + 1 >= NT) break;
        { const auto ti = P.tile(t + 1);
          SBAR();
          if (P.active(ti, wid)) tile_compute<1, VAR>(P, ti, lds, vb0, wsf, wid, r32, hi, qr, o, m_reg, l_reg);
          SBAR();
          if (t + 2 < NT) { if constexpr (Pol::KNORM) { norm_row8(S0.k0, kg); norm_row8(S0.k1, kg); } if (!(VAR & 8)) stage_write(lds, 0, S0, kws, vst0, vst1);
              if (!(VAR & 4) && t + 4 < NT) { const auto tn = P.tile(t + 4); stage_load(P, tn, S0, sr, sc); } }
          if (!(VAR & 16)) __syncthreads(); }
    }
}
template <class Pol, int VAR = 0>
__device__ __forceinline__ void att_pass(const Pol& P, LAS char* lds, const bf16x8 (&qr)[8], f32x16 (&o)[4], float& m_reg, float& l_reg, int tid) {
    Stage S0, S1; att_pass_core<Pol, VAR, false>(P, lds, qr, o, m_reg, l_reg, tid, S0, S1);
}
template <class Pol, int VAR = 0>
__device__ __forceinline__ void att_pass_pre(const Pol& P, LAS char* lds, const bf16x8 (&qr)[8], f32x16 (&o)[4], float& m_reg, float& l_reg, int tid, Stage& S0, Stage& S1) {
    att_pass_core<Pol, VAR, true>(P, lds, qr, o, m_reg, l_reg, tid, S0, S1);
}
#ifndef ATT2_KDEPTH
#define ATT2_KDEPTH 1
#endif
template <int KB>
__device__ __forceinline__ void qkt_asm(f32x16& p0, f32x16& p1, const int (&ka)[4], const bf16x8 (&qr)[8]) {
    p0 = f32x16{}; p1 = f32x16{};
    bf16x8 f[2][4];
#define QA_RD(dst, dd, off) asm volatile("ds_read_b128 %0, %1 offset:%2" : "=&v"(dst) : "v"(ka[dd]), "i"(off) : "memory")
#define QA_LD(g, s) do { QA_RD(f[s][0], (2 * (g)) & 3, KB * SHM + ((2 * (g)) >> 2) * 128); QA_RD(f[s][1], (2 * (g)) & 3, KB * SHM + ((2 * (g)) >> 2) * 128 + 8192); \
        QA_RD(f[s][2], (2 * (g) + 1) & 3, KB * SHM + ((2 * (g) + 1) >> 2) * 128); QA_RD(f[s][3], (2 * (g) + 1) & 3, KB * SHM + ((2 * (g) + 1) >> 2) * 128 + 8192); } while (0)
#define QA_MM(g, s) do { p0 = __builtin_amdgcn_mfma_f32_32x32x16_bf16(f[s][0], qr[2 * (g)], p0, 0, 0, 0); p1 = __builtin_amdgcn_mfma_f32_32x32x16_bf16(f[s][1], qr[2 * (g)], p1, 0, 0, 0); \
        p0 = __builtin_amdgcn_mfma_f32_32x32x16_bf16(f[s][2], qr[2 * (g) + 1], p0, 0, 0, 0); p1 = __builtin_amdgcn_mfma_f32_32x32x16_bf16(f[s][3], qr[2 * (g) + 1], p1, 0, 0, 0); } while (0)
#define QA_W(n) asm volatile("s_waitcnt lgkmcnt(" #n ")" ::: "memory")
#if ATT2_KDEPTH == 2
    QA_LD(0, 0); QA_LD(1, 1); QA_W(4); SBAR(); QA_MM(0, 0); SBAR();
    QA_LD(2, 0); QA_W(4); SBAR(); QA_MM(1, 1); SBAR();
    QA_LD(3, 1); QA_W(4); SBAR(); QA_MM(2, 0); SBAR();
    QA_W(0); SBAR(); QA_MM(3, 1); SBAR();
#else
    QA_LD(0, 0); QA_W(0); SBAR(); QA_MM(0, 0); SBAR();
    QA_LD(1, 0); QA_W(0); SBAR(); QA_MM(1, 0); SBAR();
    QA_LD(2, 0); QA_W(0); SBAR(); QA_MM(2, 0); SBAR();
    QA_LD(3, 0); QA_W(0); SBAR(); QA_MM(3, 0); SBAR();
#endif
#undef QA_RD
#undef QA_LD
#undef QA_MM
#undef QA_W
}
template <int BUF, class Pol, class TI>
__device__ __forceinline__ void tile_x(const Pol& P, const TI& ti, const int (&ka)[4], int wid, int r32, int hi, const bf16x8 (&qr)[8], f32x16& p0, f32x16& p1, float& m_reg, float& alpha) {
    qkt_asm<BUF>(p0, p1, ka, qr);
    P.mask(p0, p1, ti, wid, r32, hi);
    float mn; partialSM(p0, p1, m_reg, mn, alpha);
}
template <int BUF>
__device__ __forceinline__ void tile_y(int vb0, LAS float* wsf, int r32, int hi, f32x16 (&o)[4], f32x16& p0, f32x16& p1, float alpha, float& l_reg) {
    if (__any(alpha < 1.f)) {
        float f[16]; row_bcast(alpha, wsf, r32, hi, f);
#pragma unroll
        for (int d = 0; d < 4; ++d)
#pragma unroll
            for (int r = 0; r < 16; ++r) o[d][r] *= f[r];
    }
    bf16x8 pa0, pa1, pa2, pa3;
    finishSM(p0, p1, alpha, l_reg, pa0, pa1, pa2, pa3);
    SBAR();
    pv_tile<BUF>(o, vb0, pa0, pa1, pa2, pa3);
}
template <class Pol>
__device__ __forceinline__ void att_pass2(const Pol& P, LAS char* lds, const bf16x8 (&qr)[8], f32x16 (&o)[4], float& m_reg, float& l_reg, int tid) {
    const int wid = __builtin_amdgcn_readfirstlane(tid >> 6), lane = tid & 63, r32 = lane & 31, hi = lane >> 5;
    const int sr = tid >> 4, sc = (tid & 15) * 8;
    int ka[4];
#pragma unroll
    for (int dd = 0; dd < 4; ++dd) ka[dd] = (int)(unsigned)(uintptr_t)(lds + OFF_K) + KSWZ(r32, (dd * 16 + hi * 8) * 2);
    const int kws = KSWZ(sr, sc * 2), vst0 = v_st(sr, sc), vst1 = v_st(32 + sr, sc);
    const int vb0 = (int)(unsigned)(uintptr_t)(lds + OFF_V) + v_rd_base(lane);
    LAS float* wsf = (LAS float*)(lds + OFF_WS) + wid * 256;
    const bool grpB = wid >= 4;
    const int NT = P.ntiles();
    Stage S;
    const LAS float* kg = (const LAS float*)(lds + OFF_KG) + sc;
    if constexpr (Pol::KNORM) { int tk = tid; asm volatile("" : "+v"(tk)); if (tk < 128) ((LAS float*)(lds + OFF_KG))[tk] = P.kgain[tk]; }
    { const auto ti = P.tile(0); stage_load(P, ti, S, sr, sc);
      if constexpr (Pol::KNORM) { __syncthreads(); norm_row8(S.k0, kg); norm_row8(S.k1, kg); }
      stage_write(lds, 0, S, kws, vst0, vst1);
      if (NT > 1) { const auto t1 = P.tile(1); stage_load(P, t1, S, sr, sc); } }
    __syncthreads();
#define ATT2_STAGE(s_, WB) do { \
        if ((s_) + 1 < NT) { if constexpr (Pol::KNORM) { norm_row8(S.k0, kg); norm_row8(S.k1, kg); } stage_write(lds, WB, S, kws, vst0, vst1); \
            if ((s_) + 2 < NT) { const auto tn = P.tile((s_) + 2); stage_load(P, tn, S, sr, sc); } } } while (0)
#define ATT2_BODY(s_, B_, WB) do { const auto ti = P.tile(s_); f32x16 p0, p1; float alpha = 1.f; const bool act = P.active(ti, wid); \
        if (grpB) ATT2_STAGE(s_, WB); \
        SBAR(); if (act) tile_x<B_>(P, ti, ka, wid, r32, hi, qr, p0, p1, m_reg, alpha); SBAR(); \
        __syncthreads(); \
        SBAR(); if (act) tile_y<B_>(vb0, wsf, r32, hi, o, p0, p1, alpha, l_reg); SBAR(); \
        if (!grpB) ATT2_STAGE(s_, WB); \
        __syncthreads(); } while (0)
    if (grpB) __syncthreads();
    for (int s = 0; s < NT; s += 2) { ATT2_BODY(s, 0, 1); if (s + 1 >= NT) break; ATT2_BODY(s + 1, 1, 0); }
    if (!grpB) __syncthreads();
#undef ATT2_BODY
#undef ATT2_STAGE
}
__device__ __forceinline__ void fx_softmax(f32x16& p0, f32x16& p1, float shiftC2, bf16x8& pa0, bf16x8& pa1, bf16x8& pa2, bf16x8& pa3) {
    constexpr float C2 = 1.4426950408889634f * ATT_SCALE;
#pragma unroll
    for (int r = 0; r < 16; ++r) { p0[r] = __builtin_amdgcn_exp2f(fmaf(p0[r], C2, -shiftC2)); p1[r] = __builtin_amdgcn_exp2f(fmaf(p1[r], C2, -shiftC2)); }
    pack_p(p0, p1, pa0, pa1, pa2, pa3);
}
__device__ __forceinline__ float gain_maxabs(const float* g, int lane) {
    float v = fmaxf(fabsf(g[lane]), fabsf(g[lane + 64]));
#pragma unroll
    for (int off = 1; off < 64; off <<= 1) v = fmaxf(v, __shfl_xor(v, off));
    return __builtin_bit_cast(float, __builtin_amdgcn_readfirstlane(__builtin_bit_cast(int, v)));
}
constexpr float FX_BOUND = 11.313708499f * 1.01f;
constexpr float FX_MAX = 40.f, LOG2E = 1.4426950408889634f;
__device__ __forceinline__ void fx_rowsum(f32x16& lacc, bf16x8 pa0, bf16x8 pa1, bf16x8 pa2, bf16x8 pa3) {
    const bf16x8 ones = (bf16x8){0x3F80, 0x3F80, 0x3F80, 0x3F80, 0x3F80, 0x3F80, 0x3F80, 0x3F80};
    lacc = __builtin_amdgcn_mfma_f32_32x32x16_bf16(pa0, ones, lacc, 0, 0, 0); lacc = __builtin_amdgcn_mfma_f32_32x32x16_bf16(pa1, ones, lacc, 0, 0, 0);
    lacc = __builtin_amdgcn_mfma_f32_32x32x16_bf16(pa2, ones, lacc, 0, 0, 0); lacc = __builtin_amdgcn_mfma_f32_32x32x16_bf16(pa3, ones, lacc, 0, 0, 0);
}
template <int BUF, class Pol, class TI>
__device__ __forceinline__ void tile_compute_fx(const Pol& P, const TI& ti, LAS char* lds, int vb0, int wid, int r32, int hi, const bf16x8 (&qr)[8], f32x16 (&o)[4], f32x16& lacc, float shiftC2) {
    f32x16 p0, p1; bf16x8 pa0, pa1, pa2, pa3;
    qkt<BUF>(p0, p1, lds, r32, hi, qr);
    P.mask(p0, p1, ti, wid, r32, hi);
    fx_softmax(p0, p1, shiftC2, pa0, pa1, pa2, pa3);
    SBAR();
    fx_rowsum(lacc, pa0, pa1, pa2, pa3);
    pv_tile<BUF>(o, vb0, pa0, pa1, pa2, pa3);
}
template <class Pol, bool PRE>
__device__ __forceinline__ void att_pass_fx_core(const Pol& P, LAS char* lds, const bf16x8 (&qr)[8], f32x16 (&o)[4], f32x16& lacc, float shiftC2, int tid, Stage& S0, Stage& S1) {
    const int wid = __builtin_amdgcn_readfirstlane(tid >> 6), lane = tid & 63, r32 = lane & 31, hi = lane >> 5;
    const int sr = tid >> 4, sc = (tid & 15) * 8;
    const int kws = KSWZ(sr, sc * 2), vst0 = v_st(sr, sc), vst1 = v_st(32 + sr, sc);
    const int vb0 = (int)(unsigned)(uintptr_t)(lds + OFF_V) + v_rd_base(lane);
    const int NT = P.ntiles();
    const LAS float* kg = (const LAS float*)(lds + OFF_KG) + sc;
    if constexpr (Pol::KNORM) { int tk = tid; asm volatile("" : "+v"(tk)); if (tk < 128) ((LAS float*)(lds + OFF_KG))[tk] = P.kgain[tk]; }
    { if constexpr (!PRE) { const auto ti = P.tile(0); stage_load(P, ti, S0, sr, sc);
      if (NT > 1) { const auto t1 = P.tile(1); stage_load(P, t1, S1, sr, sc); } }
      if constexpr (Pol::KNORM) { __syncthreads(); norm_row8(S0.k0, kg); norm_row8(S0.k1, kg); }
      stage_write(lds, 0, S0, kws, vst0, vst1);
      if (NT > 2) { const auto t2 = P.tile(2); stage_load(P, t2, S0, sr, sc); } }
    __syncthreads();
    for (int t = 0; t < NT; t += 2) {
        { const auto ti = P.tile(t);
          SBAR();
          if (P.active(ti, wid)) tile_compute_fx<0>(P, ti, lds, vb0, wid, r32, hi, qr, o, lacc, shiftC2);
          SBAR();
          if (t + 1 < NT) { if constexpr (Pol::KNORM) { norm_row8(S1.k0, kg); norm_row8(S1.k1, kg); } stage_write(lds, 1, S1, kws, vst0, vst1);
              if (t + 3 < NT) { const auto tn = P.tile(t + 3); stage_load(P, tn, S1, sr, sc); } }
          __syncthreads(); }
        if (t + 1 >= NT) break;
        { const auto ti = P.tile(t + 1);
          SBAR();
          if (P.active(ti, wid)) tile_compute_fx<1>(P, ti, lds, vb0, wid, r32, hi, qr, o, lacc, shiftC2);
          SBAR();
          if (t + 2 < NT) { if constexpr (Pol::KNORM) { norm_row8(S0.k0, kg); norm_row8(S0.k1, kg); } stage_write(lds, 0, S0, kws, vst0, vst1);
              if (t + 4 < NT) { const auto tn = P.tile(t + 4); stage_load(P, tn, S0, sr, sc); } }
          __syncthreads(); }
    }
}
template <class Pol>
__device__ __forceinline__ void att_pass_fx(const Pol& P, LAS char* lds, const bf16x8 (&qr)[8], f32x16 (&o)[4], f32x16& lacc, float shiftC2, int tid) {
    Stage S0, S1; att_pass_fx_core<Pol, false>(P, lds, qr, o, lacc, shiftC2, tid, S0, S1);
}
template <class Pol>
__device__ __forceinline__ void att_pass_fx_pre(const Pol& P, LAS char* lds, const bf16x8 (&qr)[8], f32x16 (&o)[4], f32x16& lacc, float shiftC2, int tid, Stage& S0, Stage& S1) {
    att_pass_fx_core<Pol, true>(P, lds, qr, o, lacc, shiftC2, tid, S0, S1);
}
constexpr int OFF_V3 = 0, OFF_K3 = 3 * SHM, OFF_WS3 = 6 * SHM;
template <int KB>
__device__ __forceinline__ void qkt3(f32x16& p0, f32x16& p1, const LAS char* lds, int r32, int hi, const bf16x8 (&qr)[8]) {
    p0 = f32x16{}; p1 = f32x16{};
    const LAS char* kb[4];
#pragma unroll
    for (int dd = 0; dd < 4; ++dd) kb[dd] = lds + OFF_K3 + KB * SHM + KSWZ(r32, (dd * 16 + hi * 8) * 2);
    bf16x8 f[2][4];
#define QK_LD(g, s) do { const LAS char* a0_ = kb[(2 * (g)) & 3] + ((2 * (g)) >> 2) * 128; const LAS char* a1_ = kb[(2 * (g) + 1) & 3] + ((2 * (g) + 1) >> 2) * 128; \
        f[s][0] = *reinterpret_cast<const LAS bf16x8*>(a0_); f[s][1] = *reinterpret_cast<const LAS bf16x8*>(a0_ + 32 * 256); \
        f[s][2] = *reinterpret_cast<const LAS bf16x8*>(a1_); f[s][3] = *reinterpret_cast<const LAS bf16x8*>(a1_ + 32 * 256); } while (0)
#define QK_MM(g, s) do { p0 = __builtin_amdgcn_mfma_f32_32x32x16_bf16(f[s][0], qr[2 * (g)], p0, 0, 0, 0); p1 = __builtin_amdgcn_mfma_f32_32x32x16_bf16(f[s][1], qr[2 * (g)], p1, 0, 0, 0); \
        p0 = __builtin_amdgcn_mfma_f32_32x32x16_bf16(f[s][2], qr[2 * (g) + 1], p0, 0, 0, 0); p1 = __builtin_amdgcn_mfma_f32_32x32x16_bf16(f[s][3], qr[2 * (g) + 1], p1, 0, 0, 0); } while (0)
    QK_LD(0, 0); SBAR();
    QK_LD(1, 1); SBAR(); QK_MM(0, 0); SBAR();
    QK_LD(2, 0); SBAR(); QK_MM(1, 1); SBAR();
    QK_LD(3, 1); SBAR(); QK_MM(2, 0); SBAR();
    QK_MM(3, 1); SBAR();
#undef QK_LD
#undef QK_MM
}
template <int BUF, class Pol, class TI>
__device__ __forceinline__ void tile_compute_fx3(const Pol& P, const TI& ti, LAS char* lds, int vb0, int wid, int r32, int hi, const bf16x8 (&qr)[8], f32x16 (&o)[4], f32x16& lacc, float shiftC2) {
    f32x16 p0, p1; bf16x8 pa0, pa1, pa2, pa3;
    qkt3<BUF>(p0, p1, lds, r32, hi, qr);
    float sh = shiftC2;
    if constexpr (Pol::LANEPRED) {
        if (ti.bit == P.cur) P.mask(p0, p1, ti, wid, r32, hi); else sh = ((P.sel >> ti.bit) & 1u) ? shiftC2 : __builtin_inff();
    } else P.mask(p0, p1, ti, wid, r32, hi);
    fx_softmax(p0, p1, sh, pa0, pa1, pa2, pa3);
    SBAR();
    fx_rowsum(lacc, pa0, pa1, pa2, pa3);
    pv_tile<BUF>(o, vb0, pa0, pa1, pa2, pa3);
}
__device__ __forceinline__ void fxd_offsets(int wid, int lane, unsigned (&koff)[2], unsigned (&voff)[2]) {
#pragma unroll
    for (int i = 0; i < 2; ++i) { const int q = wid * 128 + i * 64 + lane;
        { const int row = q >> 4, pos = q & 15; koff[i] = (unsigned)(row * 256 + ((pos ^ (row & 7)) << 4)); }
        { const int sidx = q >> 5, w = q & 31, kk = (sidx >> 2) * 8 + (w >> 2), c = (sidx & 3) * 32 + (w & 3) * 8; const int k = (kk & ~0xC) | ((kk & 4) << 1) | ((kk & 8) >> 1); voff[i] = (unsigned)(k * 256 + c * 2); } }
}
template <class Pol>
__device__ __forceinline__ void fxd_prefetch(const Pol& P, LAS char* lds, int tid) {
    const int wid = __builtin_amdgcn_readfirstlane(tid >> 6), lane = tid & 63;
    unsigned koff[2], voff[2]; fxd_offsets(wid, lane, koff, voff);
    const unsigned ldsw = (unsigned)wid * 2048u;
    const int NT = P.ntiles();
#pragma unroll
    for (int t = 0; t < 2; ++t) { if (t < NT) { const auto ti_ = P.tile(t); const char* kt_ = (const char*)P.krow(ti_, 0); const char* vt_ = (const char*)P.vrow(ti_, 0);
#pragma unroll
        for (int i = 0; i < 2; ++i) {
            __builtin_amdgcn_global_load_lds((const unsigned*)(kt_ + koff[i]), (LAS unsigned*)(lds + OFF_K3 + t * SHM + ldsw + i * 1024), 16, 0, 0);
            __builtin_amdgcn_global_load_lds((const unsigned*)(vt_ + voff[i]), (LAS unsigned*)(lds + OFF_V3 + t * SHM + ldsw + i * 1024), 16, 0, 0); } } }
}
template <class Pol, bool PRE = false>
__device__ __forceinline__ void att_pass_fxd(const Pol& P, LAS char* lds, const bf16x8 (&qr)[8], f32x16 (&o)[4], f32x16& lacc, float shiftC2, int tid) {
    const int wid = __builtin_amdgcn_readfirstlane(tid >> 6), lane = tid & 63, r32 = lane & 31, hi = lane >> 5;
    const int vb0 = (int)(unsigned)(uintptr_t)(lds + OFF_V3) + v_rd_base(lane);
    const int NT = P.ntiles();
    unsigned koff[2], voff[2]; fxd_offsets(wid, lane, koff, voff);
    const unsigned ldsw = (unsigned)wid * 2048u;
#define DMA_BAR() do { asm volatile("s_waitcnt lgkmcnt(0)" ::: "memory"); __builtin_amdgcn_s_barrier(); asm volatile("" ::: "memory"); } while (0)
#define DMA_TILE(t_, buf_) do { const auto ti_ = P.tile(t_); const char* kt_ = (const char*)P.krow(ti_, 0); const char* vt_ = (const char*)P.vrow(ti_, 0); \
        _Pragma("unroll") for (int i = 0; i < 2; ++i) { \
            __builtin_amdgcn_global_load_lds((const unsigned*)(kt_ + koff[i]), (LAS unsigned*)(lds + OFF_K3 + (buf_) * SHM + ldsw + i * 1024), 16, 0, 0); \
            __builtin_amdgcn_global_load_lds((const unsigned*)(vt_ + voff[i]), (LAS unsigned*)(lds + OFF_V3 + (buf_) * SHM + ldsw + i * 1024), 16, 0, 0); } } while (0)
    if constexpr (PRE) asm volatile("s_waitcnt vmcnt(0)" ::: "memory");
    else { DMA_TILE(0, 0);
        if (NT > 1) { DMA_TILE(1, 1); asm volatile("s_waitcnt vmcnt(4)" ::: "memory"); } else asm volatile("s_waitcnt vmcnt(0)" ::: "memory"); }
    DMA_BAR();
#define DMA_STEP(t_, B_, BN2_) do { const auto ti = P.tile(t_); \
        if ((t_) + 2 < NT) DMA_TILE((t_) + 2, BN2_);                        \
        SBAR(); \
        if (P.active(ti, wid)) tile_compute_fx3<B_>(P, ti, lds, vb0, wid, r32, hi, qr, o, lacc, shiftC2); \
        SBAR(); \
        if ((t_) + 2 < NT) asm volatile("s_waitcnt vmcnt(4)" ::: "memory"); else asm volatile("s_waitcnt vmcnt(0)" ::: "memory");     \
        DMA_BAR(); } while (0)
    for (int t = 0; t < NT; t += 3) {
        DMA_STEP(t, 0, 2);
        if (t + 1 >= NT) break;
        DMA_STEP(t + 1, 1, 0);
        if (t + 2 >= NT) break;
        DMA_STEP(t + 2, 2, 1);
    }
    __syncthreads();
#undef DMA_STEP
#undef DMA_TILE
#undef DMA_BAR
}
}

template <int MAP>
__device__ __forceinline__ int src_col(int n) {
    if (MAP == 0) return n;
    if (MAP == 2) {
        if (n >= 2048) return n;
        const int pn = n >> 8, q = (n >> 3) & 31, e = n & 7, c = 128 * pn + 4 * q + (e & 3);
        return e < 4 ? c : 1024 + c;
    }
    const int cb = n >> 7, c = n & 127;
    if (cb < 16) { const int q8 = c >> 3, e = c & 7; return cb * 128 + (e < 4 ? 4 * q8 + e : 64 + 4 * q8 + (e - 4)); }
    if (cb < 52) return n;
    if (cb == 52) return c < 24 ? 6656 + c : -1;
    if (cb < 61) return 6680 + (cb - 53) * 128 + c;
    return -1;
}
template <int MAP>
__device__ __forceinline__ void p0_transpose_item(const float* W, int K, int N, int ldw, const float* gk, bf16* WT, LAS float* scr, int item, int lane) {
    const int nblk = N / 32, kb = item / nblk, nb = item % nblk, k0 = 64 * kb, n0 = 32 * nb;
    const int sc = src_col<MAP>(n0 + (lane & 31));
    float vv[32];
#pragma unroll
    for (int i = 0; i < 32; ++i) { const int kk = 2 * i + (lane >> 5); vv[i] = (sc >= 0) ? __builtin_nontemporal_load(W + (size_t)(k0 + kk) * ldw + sc) : 0.f; }
    if (gk) {
        const float g0 = gk[k0 + (lane & 31) * 2 + (lane >> 5)];
#pragma unroll
        for (int i = 0; i < 32; ++i) vv[i] *= __shfl(g0, i + (lane & 32));
    }
#pragma unroll
    for (int i = 0; i < 32; ++i) { const int kk = 2 * i + (lane >> 5); scr[kk * 33 + (lane & 31)] = vv[i]; }
    LDS_WAIT(); asm volatile("" ::: "memory");
    const int c = lane & 7;
#pragma unroll
    for (int j = 0; j < 4; ++j) { const int n = (lane >> 3) + 8 * j; const LAS float* s = scr + (8 * c) * 33 + n;
        v4u o; o.x = cvtpk(s[0 * 33], s[1 * 33]); o.y = cvtpk(s[2 * 33], s[3 * 33]); o.z = cvtpk(s[4 * 33], s[5 * 33]); o.w = cvtpk(s[6 * 33], s[7 * 33]);
        *(v4u*)(WT + (size_t)(n0 + n) * K + k0 + 8 * c) = o; }
    LDS_WAIT(); asm volatile("" ::: "memory");
}
__device__ __forceinline__ void rms_row_to_bf16(const float* xrow, bf16* orow, int lane) {
    const f32x4* xr = (const f32x4*)xrow + lane;
    f32x4 v[8]; float s = 0.f;
#pragma unroll
    for (int j = 0; j < 8; ++j) { v[j] = xr[64 * j]; s += (v[j].x * v[j].x + v[j].y * v[j].y) + (v[j].z * v[j].z + v[j].w * v[j].w); }
    const float rstd = __builtin_amdgcn_rsqf(wave_sum(s) * (1.f / DM) + NORM_EPS);
    v2u* o8 = (v2u*)orow + lane;
#pragma unroll
    for (int j = 0; j < 8; ++j) { v2u w; w.x = cvtpk(v[j].x * rstd, v[j].y * rstd); w.y = cvtpk(v[j].z * rstd, v[j].w * rstd); o8[64 * j] = w; }
}
__device__ __forceinline__ void rms_row2_to_bf16(const float* xrow, bf16* orow, int lane) {
    const f32x4* xr = (const f32x4*)xrow + lane;
    f32x4 v[16]; float s0 = 0.f, s1 = 0.f;
#pragma unroll
    for (int j = 0; j < 16; ++j) v[j] = __builtin_nontemporal_load(xr + 64 * j);
#pragma unroll
    for (int j = 0; j < 8; ++j) { s0 += (v[j].x * v[j].x + v[j].y * v[j].y) + (v[j].z * v[j].z + v[j].w * v[j].w); s1 += (v[8 + j].x * v[8 + j].x + v[8 + j].y * v[8 + j].y) + (v[8 + j].z * v[8 + j].z + v[8 + j].w * v[8 + j].w); }
    const float r0 = __builtin_amdgcn_rsqf(wave_sum(s0) * (1.f / DM) + NORM_EPS), r1 = __builtin_amdgcn_rsqf(wave_sum(s1) * (1.f / DM) + NORM_EPS);
    v2u* o8 = (v2u*)orow + lane;
#pragma unroll
    for (int j = 0; j < 16; ++j) { const float r = j < 8 ? r0 : r1; v2u w; w.x = cvtpk(v[j].x * r, v[j].y * r); w.y = cvtpk(v[j].z * r, v[j].w * r); o8[64 * j] = w; }
}
constexpr int P0_IA = (DM / 64) * (N0 / 32);
constexpr int P0_IB = (2048 / 64) * (DM / 32);
constexpr int P0_IC = (DM / 64) * (N1 / 32);
constexpr int P0_ID = (K1OUT / 64) * (DM / 32);
constexpr int P0_IE = (2048 / 64) * (128 / 32);
constexpr int P0_NITEMS = P0_IA + P0_IB + P0_IC + P0_ID + 4 * P0_IE;
constexpr int P0_DEFER = 5120;
__device__ __forceinline__ void p0_weight_items(Frame& F, int first, int last, int stride) {
    LAS float* scr = (LAS float*)(F.lds + F.wave * 16384);
    bf16* W0IN = (bf16*)(F.ws + WS_W0IN); bf16* W0OUT = (bf16*)(F.ws + WS_W0OUT); bf16* W1IN = (bf16*)(F.ws + WS_W1IN); bf16* W1OUT = (bf16*)(F.ws + WS_W1OUT); bf16* CW = (bf16*)(F.ws + WS_CW);
    for (int it = first; it < last; it += stride) {
        int r = it;
        if (r < P0_IA) { p0_transpose_item<1>(F.in[2], DM, N0, 7704, F.in[1], W0IN, scr, r, F.lane); continue; } r -= P0_IA;
        if (r < P0_IB) { p0_transpose_item<0>(F.in[3], 2048, DM, DM, nullptr, W0OUT, scr, r, F.lane); continue; } r -= P0_IB;
        if (r < 4 * P0_IE) { const int q = r / P0_IE, rr = r % P0_IE, kv = q >> 1, half = q & 1;
            p0_transpose_item<0>(F.in[kv ? 11 : 9] + (size_t)half * 2048 * 128, 2048, 128, 128, nullptr, CW + (size_t)kv * 256 * 2048 + (size_t)half * 128 * 2048, scr, rr, F.lane); continue; } r -= 4 * P0_IE;
        if (r < P0_IC) { p0_transpose_item<2>(F.in[14], DM, N1, N1, F.in[13], W1IN, scr, r, F.lane); continue; } r -= P0_IC;
        p0_transpose_item<0>(F.in[15], K1OUT, DM, DM, nullptr, W1OUT, scr, r, F.lane);
    }
}
template <int SKIP = 0>
__device__ __forceinline__ void p0_prologue(Frame& F, int defer = 0) {
    const int gw = blockIdx.x * NWAVES + F.wave, NGW = F.G * NWAVES;
    if (!(SKIP & 1)) p0_weight_items(F, gw, P0_NITEMS - defer, NGW);
    bf16* XN = (bf16*)(F.ws + WS_A);
    if (!(SKIP & 2)) for (int m = 2 * gw; m < MROWS; m += 2 * NGW) rms_row2_to_bf16(F.in[0] + (size_t)m * DM, XN + (size_t)m * DM, F.lane);
    float* rope = (float*)(F.ws + WS_MISC + ROPE_OFF);
    for (int e = blockIdx.x * NTHREADS + F.tid; e < SEQ * 64; e += F.G * NTHREADS) {
        const int s = e >> 6, i = e & 63;
        double iv = 1.0; for (int k = 0; k < i; ++k) iv *= 0.8659643233600653;
        const float ang = (float)s * (float)iv;
        const double x = (double)ang; const double q = __builtin_rint(x * 0.6366197723675814); const double r = __builtin_fma(-q, 1.5707963267948966, x) - q * 6.123233995736766e-17;
        const double r2 = r * r;
        double sp = -7.647163731819816e-13; sp = sp * r2 + 1.6059043836821613e-10; sp = sp * r2 - 2.505210838544172e-08; sp = sp * r2 + 2.7557319223985893e-06; sp = sp * r2 - 1.984126984126984e-04; sp = sp * r2 + 8.333333333333333e-03; sp = sp * r2 - 1.6666666666666666e-01;
        const double sn = r + r * r2 * sp;
        double cp = 4.779477332387385e-14; cp = cp * r2 - 1.1470745597729725e-11; cp = cp * r2 + 2.08767569878681e-09; cp = cp * r2 - 2.755731922398589e-07; cp = cp * r2 + 2.48015873015873e-05; cp = cp * r2 - 1.388888888888889e-03; cp = cp * r2 + 4.1666666666666664e-02; cp = cp * r2 - 0.5;
        const double cs = 1.0 + r2 * cp;
        const int qi = ((int)q) & 3;
        const double sv = (qi == 0) ? sn : (qi == 1) ? cs : (qi == 2) ? -sn : -cs;
        const double cv = (qi == 0) ? cs : (qi == 1) ? -sn : (qi == 2) ? -cs : sn;
        rope[(size_t)s * 128 + i] = (float)cv; rope[(size_t)s * 128 + 64 + i] = (float)sv;
    }
    if (blockIdx.x == 0 && F.wave == 0) {
        const float a = att::gain_maxabs(F.in[5], F.lane), ks = att::gain_maxabs(F.in[6] + 128, F.lane), kw = att::gain_maxabs(F.in[6] + 256, F.lane);
        const float dq = att::gain_maxabs(F.in[20], F.lane), dk = att::gain_maxabs(F.in[21], F.lane);
        float* fxb = (float*)(F.ws + WS_MISC + FXB_OFF);
        const float kc = att::gain_maxabs(F.in[6], F.lane);
        if (F.lane == 0) { fxb[0] = att::FX_BOUND * a * ks; fxb[1] = att::FX_BOUND * a * kw; fxb[2] = att::FX_BOUND * dq * dk; fxb[3] = att::FX_BOUND * a * kc; }
    }
    { float* cbp = (float*)(F.ws + WS_MISC + 1536 * 1024);
      for (int it = gw; it < 64; it += NGW) { const int kv = it >> 5, pt = it & 31;
          const float* pos = F.in[kv ? 8 : 7] + pt * 128; const float* w1 = F.in[kv ? 11 : 9] + (size_t)pt * 128 * 128;
          float s0 = 0.f, s1 = 0.f;
#pragma unroll 8
          for (int kk = 0; kk < 128; ++kk) { const float pv = pos[kk]; s0 += pv * w1[(size_t)kk * 128 + F.lane]; s1 += pv * w1[(size_t)kk * 128 + 64 + F.lane]; }
          cbp[(size_t)it * 128 + F.lane] = s0; cbp[(size_t)it * 128 + 64 + F.lane] = s1; } }
}

template <int MODE>
__device__ __forceinline__ void rowop_item(bf16* blk, int row0, const float* g, const float* rope, int tid, float lgs = 0.f, float fmul = 1.f) {
    const int c = tid & 15, rr = tid >> 4;
#pragma unroll 2
    for (int p = 0; p < 8; ++p) {
        const int row = row0 + p * 32 + rr;
        v4u* ptr = (v4u*)(blk + (size_t)row * 128 + c * 8);
        const v4u w = *ptr;
        float x[8] = {bflo(w.x), bfhi(w.x), bflo(w.y), bfhi(w.y), bflo(w.z), bfhi(w.z), bflo(w.w), bfhi(w.w)};
        float y[8];
        if (MODE == 0) {
            v4u pw; pw.x = __shfl_xor(w.x, 8); pw.y = __shfl_xor(w.y, 8); pw.z = __shfl_xor(w.z, 8); pw.w = __shfl_xor(w.w, 8);
            const float px[8] = {bflo(pw.x), bfhi(pw.x), bflo(pw.y), bfhi(pw.y), bflo(pw.z), bfhi(pw.z), bflo(pw.w), bfhi(pw.w)};
            const int s = row & (SEQ - 1), i0 = (c & 7) * 8;
            const f32x4 c0 = *(const f32x4*)(rope + (size_t)s * 128 + i0), c1 = *(const f32x4*)(rope + (size_t)s * 128 + i0 + 4);
            const f32x4 s0 = *(const f32x4*)(rope + (size_t)s * 128 + 64 + i0), s1 = *(const f32x4*)(rope + (size_t)s * 128 + 64 + i0 + 4);
            const float cs[8] = {c0.x, c0.y, c0.z, c0.w, c1.x, c1.y, c1.z, c1.w}, sn[8] = {s0.x, s0.y, s0.z, s0.w, s1.x, s1.y, s1.z, s1.w};
            const float sg = (c < 8) ? -1.f : 1.f;
            const float fr = __builtin_amdgcn_exp2f((float)s * lgs) * fmul;
#pragma unroll
            for (int k = 0; k < 8; ++k) y[k] = (x[k] * cs[k] + sg * px[k] * sn[k]) * fr;
        } else {
            float ss = 0.f;
#pragma unroll
            for (int k = 0; k < 8; ++k) ss += x[k] * x[k];
            ss += __shfl_xor(ss, 1); ss += __shfl_xor(ss, 2); ss += __shfl_xor(ss, 4); ss += __shfl_xor(ss, 8);
            const float rstd = __builtin_amdgcn_rsqf(ss * (1.f / 128.f) + NORM_EPS);
            const f32x4 g0 = *(const f32x4*)(g + c * 8), g1 = *(const f32x4*)(g + c * 8 + 4);
            const float gg[8] = {g0.x, g0.y, g0.z, g0.w, g1.x, g1.y, g1.z, g1.w};
#pragma unroll
            for (int k = 0; k < 8; ++k) y[k] = x[k] * rstd * gg[k];
        }
        v4u o; o.x = cvtpk(y[0], y[1]); o.y = cvtpk(y[2], y[3]); o.z = cvtpk(y[4], y[5]); o.w = cvtpk(y[6], y[7]);
        *ptr = o;
    }
}

__device__ __forceinline__ void cmp_tail_unit(Frame& F, int unit) {
    const int kv = unit >> 5, b = (unit >> 1) & 15, g = unit & 1;
    int tid = F.tid; asm volatile("" : "+v"(tid));
    LAS float* Ws = (LAS float*)F.lds;
    LAS float* Gt = (LAS float*)(F.lds + 65536);
    const float* cpr = (const float*)(F.ws + WS_CPR) + (size_t)kv * 4096 * 256;
    const float* cpr2 = (const float*)(F.ws + WS_CPR2) + (size_t)kv * 4096 * 256;
    LAS float* bias = (LAS float*)(F.lds + 65536 + 66048);
    if (tid < 128) { const float* cbp = (const float*)(F.ws + WS_MISC + 1536 * 1024) + (size_t)kv * 32 * 128 + tid; float sb = 0.f;
#pragma unroll 8
        for (int pt = 0; pt < 32; ++pt) sb += cbp[pt * 128];
        bias[tid] = sb; }
    __syncthreads();
    const float* w2 = F.in[kv ? 12 : 10];
    const int rbase = g * 2048 + b * 128;
    for (int idx = tid; idx < 128 * 128; idx += NTHREADS) {
        const int n = idx >> 7, j = idx & 127;
        Ws[idx] = w2[idx];
        float v = 0.f;
        if (n < 127) {
            const float pre = (cpr[(size_t)(rbase + n) * 256 + j] + cpr2[(size_t)(rbase + n) * 256 + j]) + (cpr[(size_t)(rbase + n + 1) * 256 + 128 + j] + cpr2[(size_t)(rbase + n + 1) * 256 + 128 + j]) + bias[j];
            const float u = 0.7978845608028654f * (pre + 0.044715f * pre * pre * pre);
            const float th = 1.0f - 2.0f * __builtin_amdgcn_rcpf(fast_exp(2.0f * u) + 1.0f);
            v = 0.5f * pre * (1.0f + th);
        }
        Gt[j * 129 + n] = v;
    }
    __syncthreads();
    const int n = tid >> 2, cg = tid & 3;
    float acc[32];
#pragma unroll
    for (int c = 0; c < 32; ++c) acc[c] = 0.f;
    for (int j = 0; j < 128; ++j) {
        const float a = Gt[j * 129 + n];
        const LAS f32x4* wr = (const LAS f32x4*)(Ws + j * 128 + cg * 32);
#pragma unroll
        for (int q = 0; q < 8; ++q) { const f32x4 w = wr[q]; acc[4 * q] += a * w.x; acc[4 * q + 1] += a * w.y; acc[4 * q + 2] += a * w.z; acc[4 * q + 3] += a * w.w; }
    }
    if (kv == 0) {
        float ss = 0.f;
#pragma unroll
        for (int c = 0; c < 32; ++c) ss += acc[c] * acc[c];
        ss += __shfl_xor(ss, 1); ss += __shfl_xor(ss, 2);
        const float rstd = __builtin_amdgcn_rsqf(ss * (1.f / 128.f) + NORM_EPS);
        const float* kg = F.in[6];
#pragma unroll
        for (int c = 0; c < 32; ++c) acc[c] *= rstd * kg[cg * 32 + c];
    }
    bf16* dst = (bf16*)(F.ws + WS_KCMP) + ((size_t)kv * 32 + (b * 2 + g)) * 128 * 128 + (size_t)n * 128 + cg * 32;
#pragma unroll
    for (int q = 0; q < 4; ++q) { v4u o;
        o.x = cvtpk(acc[8 * q], acc[8 * q + 1]); o.y = cvtpk(acc[8 * q + 2], acc[8 * q + 3]); o.z = cvtpk(acc[8 * q + 4], acc[8 * q + 5]); o.w = cvtpk(acc[8 * q + 6], acc[8 * q + 7]);
        if (n == 127) o = (v4u){0u, 0u, 0u, 0u};
        *(v4u*)(dst + 8 * q) = o; }
}

struct PolRet {
    static constexpr bool SOFTMAX = false, KNORM = false;
    const bf16 *Kb, *Vb; int t0; const float* kgain;
    struct TI { int kb; };
    __device__ __forceinline__ int ntiles() const { return 4; }
    __device__ __forceinline__ TI tile(int t) const { return TI{t0 + 64 * t}; }
    __device__ __forceinline__ const bf16* krow(const TI& ti, int i) const { return Kb + (size_t)(ti.kb + i) * 128; }
    __device__ __forceinline__ const bf16* vrow(const TI& ti, int i) const { return Vb + (size_t)(ti.kb + i) * 128; }
    __device__ __forceinline__ bool active(const TI& ti, int wid) const { return ti.kb <= t0 + 32 * wid + 31; }
    __device__ __forceinline__ void weights(f32x16& p0, f32x16& p1, const TI& ti, int wid, int r32, int hi) const {
        const int qlo = t0 + 32 * wid;
        if (ti.kb + 63 > qlo) {
            const int dq = qlo + r32 - ti.kb - 4 * hi;
#pragma unroll
            for (int r = 0; r < 16; ++r) { const int c = (r & 3) + 8 * (r >> 2);
                p0[r] = (dq - c >= 0) ? p0[r] : 0.f; p1[r] = (dq - c - 32 >= 0) ? p1[r] : 0.f; }
        }
    }
};
constexpr size_t WS_TST = WS_A + 64 * MiB;
__device__ __forceinline__ void ret_state_unit(Frame& F, int unit) {
    int tid = F.tid; asm volatile("" : "+v"(tid));
    const int wid = F.wave, lane = tid & 63, r32 = lane & 31, hi = lane >> 5;
    const int b = unit >> 3, h = unit & 7;
    const size_t rowb = (size_t)b * SEQ;
    const bf16* Kb = hblk(F, CB_RK + h) + rowb * 128; const bf16* Vb = hblk(F, CB_RV + h) + rowb * 128;
    bf16* tst = (bf16*)(F.ws + WS_TST) + (size_t)unit * 7 * 16384;
    LAS char* lds = (LAS char*)F.lds;
    const int sr = tid >> 4, sc = (tid & 15) * 8, vst0 = att::v_st(sr, sc), vst1 = att::v_st(32 + sr, sc);
    const int a = wid >> 1, c0 = 2 * (wid & 1);
    const int vbK = (int)(unsigned)(uintptr_t)(lds + att::OFF_K) + att::v_rd_base(lane) + a * 512;
    const int vbV = (int)(unsigned)(uintptr_t)(lds + att::OFF_V) + att::v_rd_base(lane) + c0 * 512;
    f32x16 acc0 = {}, acc1 = {};
    bf16x8 k0, k1, v0, v1;
#define RS_LOAD(t_) do { k0 = *reinterpret_cast<const bf16x8*>(Kb + (size_t)(64 * (t_) + sr) * 128 + sc); k1 = *reinterpret_cast<const bf16x8*>(Kb + (size_t)(64 * (t_) + 32 + sr) * 128 + sc); \
        v0 = *reinterpret_cast<const bf16x8*>(Vb + (size_t)(64 * (t_) + sr) * 128 + sc); v1 = *reinterpret_cast<const bf16x8*>(Vb + (size_t)(64 * (t_) + 32 + sr) * 128 + sc); } while (0)
#define RS_WRITE(buf_) do { *(LAS bf16x8*)(lds + att::OFF_K + (buf_) * att::SHM + vst0) = k0; *(LAS bf16x8*)(lds + att::OFF_K + (buf_) * att::SHM + vst1) = k1; \
        *(LAS bf16x8*)(lds + att::OFF_V + (buf_) * att::SHM + vst0) = v0; *(LAS bf16x8*)(lds + att::OFF_V + (buf_) * att::SHM + vst1) = v1; } while (0)
#define RS_TR(dst, base, off) asm volatile("ds_read_b64_tr_b16 %0, %1 offset:%2" : "=&v"(dst) : "v"(base), "i"(off) : "memory")
#define RS_COMPUTE(BUF) do { _Pragma("unroll") for (int ks = 0; ks < 4; ++ks) { s16x4 al, ah, bl0, bh0, bl1, bh1; \
            if (ks == 0) { RS_TR(al, vbK, BUF * att::SHM + 0); RS_TR(ah, vbK, BUF * att::SHM + 2048); RS_TR(bl0, vbV, BUF * att::SHM + 0); RS_TR(bh0, vbV, BUF * att::SHM + 2048); RS_TR(bl1, vbV, BUF * att::SHM + 512); RS_TR(bh1, vbV, BUF * att::SHM + 512 + 2048); } \
            if (ks == 1) { RS_TR(al, vbK, BUF * att::SHM + 4096); RS_TR(ah, vbK, BUF * att::SHM + 4096 + 2048); RS_TR(bl0, vbV, BUF * att::SHM + 4096); RS_TR(bh0, vbV, BUF * att::SHM + 4096 + 2048); RS_TR(bl1, vbV, BUF * att::SHM + 4096 + 512); RS_TR(bh1, vbV, BUF * att::SHM + 4096 + 512 + 2048); } \
            if (ks == 2) { RS_TR(al, vbK, BUF * att::SHM + 8192); RS_TR(ah, vbK, BUF * att::SHM + 8192 + 2048); RS_TR(bl0, vbV, BUF * att::SHM + 8192); RS_TR(bh0, vbV, BUF * att::SHM + 8192 + 2048); RS_TR(bl1, vbV, BUF * att::SHM + 8192 + 512); RS_TR(bh1, vbV, BUF * att::SHM + 8192 + 512 + 2048); } \
            if (ks == 3) { RS_TR(al, vbK, BUF * att::SHM + 12288); RS_TR(ah, vbK, BUF * att::SHM + 12288 + 2048); RS_TR(bl0, vbV, BUF * att::SHM + 12288); RS_TR(bh0, vbV, BUF * att::SHM + 12288 + 2048); RS_TR(bl1, vbV, BUF * att::SHM + 12288 + 512); RS_TR(bh1, vbV, BUF * att::SHM + 12288 + 512 + 2048); } \
            asm volatile("s_waitcnt lgkmcnt(0)" ::: "memory"); SBAR(); \
            const bf16x8 A_ = (bf16x8){al[0], al[1], al[2], al[3], ah[0], ah[1], ah[2], ah[3]}; \
            acc0 = __builtin_amdgcn_mfma_f32_32x32x16_bf16(A_, (bf16x8){bl0[0], bl0[1], bl0[2], bl0[3], bh0[0], bh0[1], bh0[2], bh0[3]}, acc0, 0, 0, 0); \
            acc1 = __builtin_amdgcn_mfma_f32_32x32x16_bf16(A_, (bf16x8){bl1[0], bl1[1], bl1[2], bl1[3], bh1[0], bh1[1], bh1[2], bh1[3]}, acc1, 0, 0, 0); } } while (0)
#define RS_STORE(t_) do { if (((t_) & 3) == 3) { bf16* tp = tst + (size_t)((t_) >> 2) * 16384; \
            _Pragma("unroll") for (int r = 0; r < 16; ++r) { const int row = 32 * a + att::crow(r, hi); \
                const float x0 = acc0[r], x0n = __shfl_xor(x0, 1), x1 = acc1[r], x1n = __shfl_xor(x1, 1); \
                if ((r32 & 1) == 0) { *(unsigned*)(tp + (size_t)row * 128 + 32 * c0 + r32) = cvtpk(x0, x0n); *(unsigned*)(tp + (size_t)row * 128 + 32 * (c0 + 1) + r32) = cvtpk(x1, x1n); } } } } while (0)
    RS_LOAD(0); RS_WRITE(0);
    __syncthreads();
#pragma unroll 1
    for (int t = 0; t < 28; t += 2) {
        RS_LOAD(t + 1);
        SBAR(); RS_COMPUTE(0); SBAR();
        RS_WRITE(1); RS_STORE(t);
        __syncthreads();
        if (t + 2 < 28) RS_LOAD(t + 2);
        SBAR(); RS_COMPUTE(1); SBAR();
        if (t + 2 < 28) RS_WRITE(0);
        RS_STORE(t + 1);
        __syncthreads();
    }
#undef RS_LOAD
#undef RS_WRITE
#undef RS_TR
#undef RS_COMPUTE
#undef RS_STORE
}
template <int VAR>
__device__ __forceinline__ void retention_unit(Frame& F, int unit) {
    const int qb = 7 - (unit >> 7), bh = unit & 127, b = bh >> 3, h = bh & 7;
    int tid = F.tid; asm volatile("" : "+v"(tid));
    const int wid = F.wave, lane = tid & 63, r32 = lane & 31, hi = lane >> 5;
    const int t0 = qb * 256;
    const size_t rowb = (size_t)b * SEQ;
    const bf16* Qb = hblk(F, CB_RQ + h) + rowb * 128;
    bf16x8 qr[8];
    { const bf16* qp = Qb + (size_t)(t0 + wid * 32 + r32) * 128 + hi * 8;
#pragma unroll
      for (int d0 = 0; d0 < 8; ++d0) qr[d0] = *reinterpret_cast<const bf16x8*>(qp + d0 * 16); }
    PolRet P{hblk(F, CB_RK + h) + rowb * 128, hblk(F, CB_RV + h) + rowb * 128, t0, nullptr};
    att::Stage S0, S1; att::stage_prefetch(P, S0, S1, tid);
    att::settle_q(qr);
    f32x16 o[4] = {}; float m_reg = 0.f, l_reg = 0.f;
    if (qb > 0) {
        const bf16* tp = (const bf16*)(F.ws + WS_TST) + ((size_t)bh * 7 + (qb - 1)) * 16384;
        const int sr = tid >> 4, sc = (tid & 15) * 8, vst0 = att::v_st(sr, sc), vst1 = att::v_st(32 + sr, sc);
        LAS char* lds = (LAS char*)F.lds;
        { const bf16x8 a0 = *reinterpret_cast<const bf16x8*>(tp + (size_t)sr * 128 + sc), a1 = *reinterpret_cast<const bf16x8*>(tp + (size_t)(32 + sr) * 128 + sc);
          const bf16x8 b0 = *reinterpret_cast<const bf16x8*>(tp + (size_t)(64 + sr) * 128 + sc), b1 = *reinterpret_cast<const bf16x8*>(tp + (size_t)(96 + sr) * 128 + sc);
          *(LAS bf16x8*)(lds + att::OFF_V + vst0) = a0; *(LAS bf16x8*)(lds + att::OFF_V + vst1) = a1;
          *(LAS bf16x8*)(lds + att::OFF_V + att::SHM + vst0) = b0; *(LAS bf16x8*)(lds + att::OFF_V + att::SHM + vst1) = b1; }
        __syncthreads();
        const int vb0 = (int)(unsigned)(uintptr_t)(lds + att::OFF_V) + att::v_rd_base(lane);
        att::pv_tile<0>(o, vb0, qr[0], qr[1], qr[2], qr[3]);
        att::pv_tile<1>(o, vb0, qr[4], qr[5], qr[6], qr[7]);
        __syncthreads();
    }
    att::att_pass_pre<PolRet, VAR>(P, (LAS char*)F.lds, qr, o, m_reg, l_reg, tid, S0, S1);
    if (VAR != 0) { if (o[0][0] + o[1][1] + o[2][2] + o[3][3] == 12345.678f) F.MISC[20] = 1u; return; }
    float ss[16];
#pragma unroll
    for (int r = 0; r < 16; ++r) { float s = 0.f;
#pragma unroll
        for (int d = 0; d < 4; ++d) s += o[d][r] * o[d][r];
        s += __shfl_xor(s, 1); s += __shfl_xor(s, 2); s += __shfl_xor(s, 4); s += __shfl_xor(s, 8); s += __shfl_xor(s, 16);
        ss[r] = __builtin_amdgcn_rsqf(s * (1.f / 128.f) + NORM_EPS); }
    const float* rg = F.in[4] + h * 128;
    const bf16* Zb = hblk(F, CB_RZ + h) + rowb * 128;
    bf16* mix = (bf16*)(F.ws + WS_MIX);
    int rl = r32, hl = hi; asm volatile("" : "+v"(rl), "+v"(hl));
    float gd[4];
#pragma unroll
    for (int d = 0; d < 4; ++d) gd[d] = rg[d * 32 + rl];
    LAS float* st = (LAS float*)(F.lds + wid * 16384);
#pragma unroll
    for (int r = 0; r < 16; ++r)
#pragma unroll
        for (int d = 0; d < 4; ++d) st[att::crow(r, hl) * 128 + d * 32 + rl] = o[d][r] * ss[r] * gd[d];
    asm volatile("s_waitcnt lgkmcnt(0)" ::: "memory");
    int ll = lane; asm volatile("" : "+v"(ll));
    const int c8 = (ll & 15) * 8, rq = ll >> 4;
    v4u zz[8];
#pragma unroll
    for (int p = 0; p < 8; ++p) zz[p] = *(const v4u*)(Zb + (size_t)(t0 + wid * 32 + 4 * p + rq) * 128 + c8);
#pragma unroll
    for (int p = 0; p < 8; ++p) { const int row = 4 * p + rq;
        const f32x4 a = *(const LAS f32x4*)(st + row * 128 + c8), bq = *(const LAS f32x4*)(st + row * 128 + c8 + 4);
        v4u w; w.x = cvtpk(a.x * bflo(zz[p].x), a.y * bfhi(zz[p].x)); w.y = cvtpk(a.z * bflo(zz[p].y), a.w * bfhi(zz[p].y));
        w.z = cvtpk(bq.x * bflo(zz[p].z), bq.y * bfhi(zz[p].z)); w.w = cvtpk(bq.z * bflo(zz[p].w), bq.w * bfhi(zz[p].w));
        *(v4u*)(mix + (rowb + t0 + wid * 32 + row) * DM + h * 128 + c8) = w; }
}

struct PolWin {
    static constexpr bool SOFTMAX = true, KNORM = false, LANEPRED = false;
    const bf16 *Kb, *Vb; int t0, tile0, nt; const float* kgain;
    struct TI { int kb; };
    __device__ __forceinline__ int ntiles() const { return nt; }
    __device__ __forceinline__ TI tile(int t) const { return TI{64 * (tile0 + t)}; }
    __device__ __forceinline__ const bf16* krow(const TI& ti, int i) const { return Kb + (size_t)(ti.kb + i) * 128; }
    __device__ __forceinline__ const bf16* vrow(const TI& ti, int i) const { return Vb + (size_t)(ti.kb + i) * 128; }
    __device__ __forceinline__ bool active(const TI& ti, int wid) const { const int slo = t0 + 8 * wid; return ti.kb <= slo + 7 && ti.kb + 63 >= slo - 511; }
    __device__ __forceinline__ void mask(f32x16& p0, f32x16& p1, const TI& ti, int wid, int r32, int hi) const {
        const int slo = t0 + 8 * wid;
        if (ti.kb + 63 > slo || ti.kb < slo + 7 - 511) att::mask_tile(p0, p1, slo + (r32 >> 2) - ti.kb - 4 * hi, 512u);
    }
};
struct PolSel {
    static constexpr bool SOFTMAX = true, KNORM = false, LANEPRED = true;
    const bf16 *Kb, *Vb; int t0, cur; unsigned umask, wmask, sel; const float* kgain;
    struct TI { int kb, bit; };
    __device__ __forceinline__ int ntiles() const { return __builtin_popcount(umask); }
    __device__ __forceinline__ TI tile(int t) const { unsigned m = umask; for (int k = 0; k < t; ++k) m &= m - 1u; const int bit = __builtin_ctz(m); return TI{64 * bit, bit}; }
    __device__ __forceinline__ const bf16* krow(const TI& ti, int i) const { return Kb + (size_t)(ti.kb + i) * 128; }
    __device__ __forceinline__ const bf16* vrow(const TI& ti, int i) const { return Vb + (size_t)(ti.kb + i) * 128; }
    __device__ __forceinline__ bool active(const TI& ti, int wid) const { return (wmask >> ti.bit) & 1u; }
    __device__ __forceinline__ void mask(f32x16& p0, f32x16& p1, const TI& ti, int wid, int r32, int hi) const {
        const bool on = (sel >> ti.bit) & 1u;
        if (ti.bit == cur) {
            const int dq = on ? (t0 + 8 * wid + (r32 >> 2) - ti.kb - 4 * hi) : -100000;
            att::mask_tile(p0, p1, dq, 0x7fffffffu);
        } else if (!__all(on)) {
            const float NEG = -__builtin_inff();
#pragma unroll
            for (int r = 0; r < 16; ++r) { p0[r] = on ? p0[r] : NEG; p1[r] = on ? p1[r] : NEG; }
        }
    }
};
template <int VAR>
__device__ __forceinline__ void nsa_unit(Frame& F, int unit) {
    const int j = 31 - (unit >> 5), bg = unit & 31, b = bg >> 1, g = bg & 1;
    int tid = F.tid; asm volatile("" : "+v"(tid));
    const int wid = F.wave, lane = tid & 63, r32 = lane & 31, hi = lane >> 5;
    const int t0 = 64 * j, cur = j;
    const size_t rowb = (size_t)b * SEQ;
    const int tok = t0 + 8 * wid + (r32 >> 2), hd = g * 4 + (r32 & 3);
    LAS char* lds = (LAS char*)F.lds;
    LAS float* wsf = (LAS float*)(lds + att::OFF_WS) + wid * 256;
    LAS float* wsf3 = (LAS float*)(lds + att::OFF_WS3) + wid * 256;
    float* slab = (float*)(F.ws + WS_A) + (size_t)blockIdx.x * 65536;
#define NSA_LOADQ(qr_, zz_) do { const bf16* qp_ = hblk(F, CB_NQ + hd) + (rowb + tok + (size_t)(zz_)) * 128 + hi * 8; \
        _Pragma("unroll") for (int d0 = 0; d0 < 8; ++d0) qr_[d0] = *reinterpret_cast<const bf16x8*>(qp_ + d0 * 16); att::norm_q(qr_, F.in[5], hi); } while (0)
#define NSA_GATE(br_, zz_) sigmoidf_(bf2f(hblk(F, CB_NG)[(rowb + tok + (size_t)(zz_)) * 128 + (br_) * 8 + hd]))
    const int sr = tid >> 4, sc = (tid & 15) * 8;
    const int kws = KSWZ(sr, sc * 2), vst0 = att::v_st(sr, sc), vst1 = att::v_st(32 + sr, sc);
    const int vb0 = (int)(unsigned)(uintptr_t)(lds + att::OFF_V) + att::v_rd_base(lane);
    unsigned sel;
    sel = 0xffffffffu;
    if (!((DBG_SKIP | VAR) & 8)) {
        bf16x8 qr[8]; NSA_LOADQ(qr, 0); const float g0 = NSA_GATE(0, 0);
        const bf16* kc = (const bf16*)(F.ws + WS_KCMP) + (size_t)(b * 2 + g) * 128 * 128;
        const bf16* vc = kc + (size_t)32 * 128 * 128;
        const bool two = t0 >= 992;
#pragma unroll
        for (int T = 0; T < 2; ++T) { if (T == 1 && !two) break; att::Stage S;
            S.k0 = *reinterpret_cast<const bf16x8*>(kc + (size_t)(64 * T + sr) * 128 + sc); S.k1 = *reinterpret_cast<const bf16x8*>(kc + (size_t)(64 * T + 32 + sr) * 128 + sc);
            S.v0 = *reinterpret_cast<const bf16x8*>(vc + (size_t)(64 * T + sr) * 128 + sc); S.v1 = *reinterpret_cast<const bf16x8*>(vc + (size_t)(64 * T + 32 + sr) * 128 + sc);
            att::stage_write(lds, T, S, kws, vst0, vst1); }
        __syncthreads();
        const int nmax = (tok - 31) >> 4;
        const bool anyv = nmax >= 0;
        constexpr float C2 = 1.4426950408889634f * ATT_SCALE;
        const float bn0 = ((const float*)(F.ws + WS_MISC + FXB_OFF))[3];
        float mb;
        if (FX_NSA && bn0 <= att::FX_MAX) mb = anyv ? -bn0 * att::LOG2E : 0.f;
        else {
        float mx;
        { f32x16 p0, p1;
          att::qkt<0>(p0, p1, lds, r32, hi, qr); att::mask_tile(p0, p1, nmax - 4 * hi, 0x7fffffffu);
          mx = p0[0];
#pragma unroll
          for (int r = 0; r < 16; ++r) { mx = fmaxf(mx, p0[r]); mx = fmaxf(mx, p1[r]); }
          SBAR();
          if (two) { att::qkt<1>(p0, p1, lds, r32, hi, qr); att::mask_tile(p0, p1, nmax - 64 - 4 * hi, 0x7fffffffu);
#pragma unroll
              for (int r = 0; r < 16; ++r) { mx = fmaxf(mx, p0[r]); mx = fmaxf(mx, p1[r]); } }
          mx = fmaxf(mx, att::xhi_f(mx, hi)); }
        mb = anyv ? -mx * C2 : 0.f; }
        float sum = 0.f; float im[16], ls[16];
        f32x16 o[4] = {};
        SBAR();
        { f32x16 p0, p1; bf16x8 pa0, pa1, pa2, pa3;
          att::qkt<0>(p0, p1, lds, r32, hi, qr); att::mask_tile(p0, p1, nmax - 4 * hi, 0x7fffffffu);
#pragma unroll
          for (int r = 0; r < 16; ++r) { p0[r] = __builtin_amdgcn_exp2f(fmaf(p0[r], C2, mb)); p1[r] = __builtin_amdgcn_exp2f(fmaf(p1[r], C2, mb)); sum += p0[r] + p1[r]; }
#pragma unroll
          for (int q = 0; q < 4; ++q) { im[q] = (p0[4 * q] + p0[4 * q + 1]) + (p0[4 * q + 2] + p0[4 * q + 3]); ls[q] = p0[4 * q + 3];
              im[4 + q] = (p1[4 * q] + p1[4 * q + 1]) + (p1[4 * q + 2] + p1[4 * q + 3]); ls[4 + q] = p1[4 * q + 3]; }
          att::pack_p(p0, p1, pa0, pa1, pa2, pa3); SBAR(); att::pv_tile<0>(o, vb0, pa0, pa1, pa2, pa3); }
        SBAR();
        if (two) { f32x16 p0, p1; bf16x8 pa0, pa1, pa2, pa3;
          att::qkt<1>(p0, p1, lds, r32, hi, qr); att::mask_tile(p0, p1, nmax - 64 - 4 * hi, 0x7fffffffu);
#pragma unroll
          for (int r = 0; r < 16; ++r) { p0[r] = __builtin_amdgcn_exp2f(fmaf(p0[r], C2, mb)); p1[r] = __builtin_amdgcn_exp2f(fmaf(p1[r], C2, mb)); sum += p0[r] + p1[r]; }
#pragma unroll
          for (int q = 0; q < 4; ++q) { im[8 + q] = (p0[4 * q] + p0[4 * q + 1]) + (p0[4 * q + 2] + p0[4 * q + 3]); ls[8 + q] = p0[4 * q + 3];
              im[12 + q] = (p1[4 * q] + p1[4 * q + 1]) + (p1[4 * q + 2] + p1[4 * q + 3]); ls[12 + q] = p1[4 * q + 3]; }
          att::pack_p(p0, p1, pa0, pa1, pa2, pa3); SBAR(); att::pv_tile<1>(o, vb0, pa0, pa1, pa2, pa3); }
        else {
#pragma unroll
            for (int u = 8; u < 16; ++u) { im[u] = 0.f; ls[u] = 0.f; } }
        SBAR();
        sum += att::xhi_f(sum, hi);
        const float inv = (anyv && sum > 0.f) ? __builtin_amdgcn_rcpf(sum) : 0.f;
        { float f[16]; att::row_bcast(g0 * inv, wsf, r32, hi, f);
          int rl = r32, hl = hi; asm volatile("" : "+v"(rl), "+v"(hl));
#pragma unroll
          for (int r = 0; r < 16; ++r)
#pragma unroll
              for (int d = 0; d < 4; ++d) slab[(size_t)(wid * 32 + att::crow(r, hl)) * 128 + d * 32 + rl] = o[d][r] * f[r]; }
        SBAR();
        if (!((DBG_SKIP | VAR) & 1) && cur >= 16) {
            LAS float* Gs = (LAS float*)(lds + 73728 + wid * 3072); LAS float* Ls = Gs + 256; LAS float* Vs = Gs + 512;
            const int tl = r32 >> 2;
#pragma unroll
            for (int u = 0; u < 16; ++u) { float a = im[u] * inv, c = ls[u] * inv;
                a += __shfl_xor(a, 1); a += __shfl_xor(a, 2); c += __shfl_xor(c, 1); c += __shfl_xor(c, 2);
                if ((r32 & 3) == 0) { Gs[tl * 32 + 2 * u + hi] = a; Ls[tl * 32 + 2 * u + hi] = c; } }
            asm volatile("s_waitcnt lgkmcnt(0)" ::: "memory");
            int k4 = 4 * (2 * (r32 & 3) + hi); asm volatile("" : "+v"(k4));
            float my[4];
#pragma unroll
            for (int i = 0; i < 4; ++i) { const int jj = k4 + i; const float prev = jj > 0 ? Ls[tl * 32 + (jj > 0 ? jj - 1 : 0)] : 0.f;
                const float v = Gs[tl * 32 + jj] + prev; const bool forced = (jj == 0) || (jj == cur) || (jj == cur - 1);
                my[i] = forced ? 1e30f : (jj > cur ? -1e30f : v); }
            *(LAS f32x4*)(Vs + tl * 32 + k4) = (f32x4){my[0], my[1], my[2], my[3]};
            asm volatile("s_waitcnt lgkmcnt(0)" ::: "memory");
            int cnt[4] = {0, 0, 0, 0};
#pragma unroll
            for (int q = 0; q < 8; ++q) { const f32x4 c = *(const LAS f32x4*)(Vs + tl * 32 + 4 * q);
#pragma unroll
                for (int i = 0; i < 4; ++i) { const int jm = k4 + i;
                    cnt[i] += (int)(c.x > my[i]) | ((int)(c.x == my[i]) & (int)(4 * q + 0 < jm)); cnt[i] += (int)(c.y > my[i]) | ((int)(c.y == my[i]) & (int)(4 * q + 1 < jm));
                    cnt[i] += (int)(c.z > my[i]) | ((int)(c.z == my[i]) & (int)(4 * q + 2 < jm)); cnt[i] += (int)(c.w > my[i]) | ((int)(c.w == my[i]) & (int)(4 * q + 3 < jm)); } }
            unsigned bits = 0u;
#pragma unroll
            for (int i = 0; i < 4; ++i) if (cnt[i] < 16) bits |= 1u << (k4 + i);
            bits |= __shfl_xor(bits, 1); bits |= __shfl_xor(bits, 2); bits |= att::xhi_u(bits, hi);
            sel = bits & ((2u << cur) - 1u);
        } else {
            sel = (2u << cur) - 1u;
        }
        __syncthreads();
    }
    asm volatile("" : "+v"(sel));
    bool winpre = false;
    if (!((DBG_SKIP | VAR) & 2)) {
        unsigned wm = sel;
#pragma unroll
        for (int off = 1; off < 64; off <<= 1) wm |= __shfl_xor(wm, off);
        wm = __builtin_amdgcn_readfirstlane(wm);
        LAS unsigned* xs = (LAS unsigned*)(F.lds + XTRA_OFF);
        if (lane == 0) xs[wid] = wm;
        __syncthreads();
        unsigned um = 0u;
#pragma unroll
        for (int w = 0; w < 8; ++w) um |= xs[w];
        um = __builtin_amdgcn_readfirstlane(um);
        int z2 = 0; asm volatile("" : "+s"(z2));
        const size_t rb2 = rowb + (size_t)z2;
        PolSel P{hblk(F, CB_KS + g) + rb2 * 128, hblk(F, CB_VS + g) + rb2 * 128, t0, cur, um, wm, sel, F.in[6] + 128};
        const float bn = ((const float*)(F.ws + WS_MISC + FXB_OFF))[0];
        const bool fx2 = FX_NSA && bn <= att::FX_MAX;
        if (fx2) { int tp_ = tid; asm volatile("" : "+v"(tp_)); att::fxd_prefetch(P, lds, tp_); }
        bf16x8 qr[8]; NSA_LOADQ(qr, z2);
        f32x16 o[4] = {}; float f[16];
        if (fx2) {
            f32x16 lacc = {};
            { int tp_ = tid; asm volatile("" : "+v"(tp_)); att::att_pass_fxd<PolSel, true>(P, lds, qr, o, lacc, bn * att::LOG2E, tp_); }
            if (!((DBG_SKIP | VAR) & 4) && FX_NSA && ((const float*)(F.ws + WS_MISC + FXB_OFF))[1] <= att::FX_MAX) {
                const int tile0w = j > 8 ? j - 8 : 0;
                PolWin Pw{hblk(F, CB_KW + g) + rb2 * 128, hblk(F, CB_VW + g) + rb2 * 128, t0, tile0w, j - tile0w + 1, F.in[6] + 256};
                int tp_ = tid; asm volatile("" : "+v"(tp_)); att::fxd_prefetch(Pw, lds, tp_); winpre = true; }
            const float g1 = NSA_GATE(1, z2);
            att::row_bcast(g1, wsf3, r32, hi, f);
#pragma unroll
            for (int r = 0; r < 16; ++r) f[r] *= __builtin_amdgcn_rcpf(lacc[r]);
        } else {
            float m_reg = -1e30f, l_reg = 0.f;
            { int tp_ = tid; asm volatile("" : "+v"(tp_)); att::att_pass(P, lds, qr, o, m_reg, l_reg, tp_); }
            const float g1 = NSA_GATE(1, z2);
            att::row_bcast(g1 * __builtin_amdgcn_rcpf(l_reg), wsf, r32, hi, f);
        }
        int rl = r32, hl = hi; asm volatile("" : "+v"(rl), "+v"(hl));
#pragma unroll
        for (int r = 0; r < 16; ++r)
#pragma unroll
            for (int d = 0; d < 4; ++d) slab[32768 + (size_t)(wid * 32 + att::crow(r, hl)) * 128 + d * 32 + rl] = o[d][r] * f[r];
    }
    if (!((DBG_SKIP | VAR) & 4)) {
        const int tile0 = j > 8 ? j - 8 : 0;
        int z3 = 0; asm volatile("" : "+s"(z3));
        const size_t rb3 = rowb + (size_t)z3;
        bf16x8 qr[8]; NSA_LOADQ(qr, z3);
        PolWin P{hblk(F, CB_KW + g) + rb3 * 128, hblk(F, CB_VW + g) + rb3 * 128, t0, tile0, j - tile0 + 1, F.in[6] + 256};
        f32x16 o[4] = {}; float f[16];
        const float bn = ((const float*)(F.ws + WS_MISC + FXB_OFF))[1];
        if (FX_NSA && bn <= att::FX_MAX) {
            f32x16 lacc = {};
            if (!winpre) { int tp_ = tid; asm volatile("" : "+v"(tp_)); att::fxd_prefetch(P, lds, tp_); }
            { int tp_ = tid; asm volatile("" : "+v"(tp_)); att::att_pass_fxd<PolWin, true>(P, lds, qr, o, lacc, bn * att::LOG2E, tp_); }
            const float g2 = NSA_GATE(2, z3);
            att::row_bcast(g2, wsf3, r32, hi, f);
#pragma unroll
            for (int r = 0; r < 16; ++r) f[r] *= __builtin_amdgcn_rcpf(lacc[r]);
        } else {
            float m_reg = -1e30f, l_reg = 0.f;
            { int tp_ = tid; asm volatile("" : "+v"(tp_)); att::att_pass(P, lds, qr, o, m_reg, l_reg, tp_); }
            const float g2 = NSA_GATE(2, z3);
            att::row_bcast(g2 * __builtin_amdgcn_rcpf(l_reg), wsf, r32, hi, f);
        }
        bf16* mix = (bf16*)(F.ws + WS_MIX);
        int rl = r32, hl = hi; asm volatile("" : "+v"(rl), "+v"(hl));
        LAS float* st = (LAS float*)(F.lds + wid * 16384);
        __syncthreads();
#pragma unroll
        for (int r = 0; r < 16; ++r)
#pragma unroll
            for (int d = 0; d < 4; ++d) st[att::crow(r, hl) * 128 + d * 32 + rl] = o[d][r] * f[r];
        asm volatile("s_waitcnt lgkmcnt(0)" ::: "memory");
        int ll = lane; asm volatile("" : "+v"(ll));
        const int c8 = (ll & 15) * 8, rq = ll >> 4;
#pragma unroll
        for (int half = 0; half < 4; ++half) {
            asm volatile("" ::: "memory");
            f32x4 s0[2][2], s1[2][2]; v4u zz[2];
#pragma unroll
            for (int p = 0; p < 2; ++p) { const int row = 4 * (2 * half + p) + rq; const int tk = t0 + 8 * wid + (row >> 2), hh = g * 4 + (row & 3);
                const float* sp = slab + (size_t)(wid * 32 + row) * 128 + c8;
                s0[p][0] = *(const f32x4*)sp; s0[p][1] = *(const f32x4*)(sp + 4); s1[p][0] = *(const f32x4*)(sp + 32768); s1[p][1] = *(const f32x4*)(sp + 32768 + 4);
                zz[p] = *(const v4u*)(hblk(F, CB_NZ + hh) + (rb3 + tk) * 128 + c8); }
#pragma unroll
            for (int p = 0; p < 2; ++p) { const int row = 4 * (2 * half + p) + rq; const int tk = t0 + 8 * wid + (row >> 2), hh = g * 4 + (row & 3);
                const f32x4 a = *(const LAS f32x4*)(st + row * 128 + c8) + s0[p][0] + s1[p][0], bq = *(const LAS f32x4*)(st + row * 128 + c8 + 4) + s0[p][1] + s1[p][1];
                v4u w; w.x = cvtpk(a.x * bflo(zz[p].x), a.y * bfhi(zz[p].x)); w.y = cvtpk(a.z * bflo(zz[p].y), a.w * bfhi(zz[p].y));
                w.z = cvtpk(bq.x * bflo(zz[p].z), bq.y * bfhi(zz[p].z)); w.w = cvtpk(bq.z * bflo(zz[p].w), bq.w * bfhi(zz[p].w));
                if (VAR == 0) *(v4u*)(mix + (rb3 + tk) * DM + 1024 + hh * 128 + c8) = w; else if (w.x == 0x12345678u) F.MISC[21] = 1u; }
        }
    }
#undef NSA_LOADQ
#undef NSA_GATE
}

__device__ __forceinline__ float wave_sum_dpp(float v) {
    v = att::row16_sum(v);
    const float a = __builtin_bit_cast(float, __builtin_amdgcn_readlane(__builtin_bit_cast(int, v), 0)), b = __builtin_bit_cast(float, __builtin_amdgcn_readlane(__builtin_bit_cast(int, v), 16));
    const float c = __builtin_bit_cast(float, __builtin_amdgcn_readlane(__builtin_bit_cast(int, v), 32)), d = __builtin_bit_cast(float, __builtin_amdgcn_readlane(__builtin_bit_cast(int, v), 48));
    return (a + b) + (c + d);
}
constexpr int CFR = 2;
__device__ __forceinline__ void conv_finalize_rows(Frame& F, size_t m0, int n, int lane) {
    bf16* mix = (bf16*)(F.ws + WS_MIX);
    float g[16], bb[16];
#pragma unroll
    for (int q = 0; q < 4; ++q) { const f32x4 a = *(const f32x4*)(F.in[18] + 16 * lane + 4 * q), c = *(const f32x4*)(F.in[19] + 16 * lane + 4 * q);
        g[4 * q] = a.x; g[4 * q + 1] = a.y; g[4 * q + 2] = a.z; g[4 * q + 3] = a.w; bb[4 * q] = c.x; bb[4 * q + 1] = c.y; bb[4 * q + 2] = c.z; bb[4 * q + 3] = c.w; }
    const bf16* czb = hblk(F, CB_CZ + (lane >> 3)) + (lane & 7) * 16;
#pragma unroll 1
    for (int r0 = 0; r0 < n; r0 += CFR) {
        v4u yq[CFR][2], zq[CFR][2];
#pragma unroll
        for (int j = 0; j < CFR; ++j) { const size_t m = m0 + r0 + j; const v4u* yp = (const v4u*)(mix + m * K1OUT + 16 * lane);
            yq[j][0] = yp[0]; yq[j][1] = yp[1]; zq[j][0] = *(const v4u*)(czb + m * 128); zq[j][1] = *(const v4u*)(czb + m * 128 + 8); }
#pragma unroll
        for (int j = 0; j < CFR; ++j) { const size_t m = m0 + r0 + j; const v4u y0 = yq[j][0], y1 = yq[j][1], z0 = zq[j][0], z1 = zq[j][1];
            float y[16] = {bflo(y0.x), bfhi(y0.x), bflo(y0.y), bfhi(y0.y), bflo(y0.z), bfhi(y0.z), bflo(y0.w), bfhi(y0.w), bflo(y1.x), bfhi(y1.x), bflo(y1.y), bfhi(y1.y), bflo(y1.z), bfhi(y1.z), bflo(y1.w), bfhi(y1.w)};
            const float z[16] = {bflo(z0.x), bfhi(z0.x), bflo(z0.y), bfhi(z0.y), bflo(z0.z), bfhi(z0.z), bflo(z0.w), bfhi(z0.w), bflo(z1.x), bfhi(z1.x), bflo(z1.y), bfhi(z1.y), bflo(z1.z), bfhi(z1.z), bflo(z1.w), bfhi(z1.w)};
            float s = 0.f;
#pragma unroll
            for (int e = 0; e < 16; ++e) s += y[e];
            const float mu = wave_sum_dpp(s) * (1.f / 1024.f);
            float q = 0.f;
#pragma unroll
            for (int e = 0; e < 16; ++e) { y[e] -= mu; q += y[e] * y[e]; }
            const float rstd = __builtin_amdgcn_rsqf(wave_sum_dpp(q) * (1.f / 1024.f) + NORM_EPS);
            float o[16];
#pragma unroll
            for (int e = 0; e < 16; ++e) o[e] = siluf_(y[e] * rstd * g[e] + bb[e]) * z[e];
            v4u w0, w1;
            w0.x = cvtpk(o[0], o[1]); w0.y = cvtpk(o[2], o[3]); w0.z = cvtpk(o[4], o[5]); w0.w = cvtpk(o[6], o[7]);
            w1.x = cvtpk(o[8], o[9]); w1.y = cvtpk(o[10], o[11]); w1.z = cvtpk(o[12], o[13]); w1.w = cvtpk(o[14], o[15]);
            v4u* yo = (v4u*)(mix + m * K1OUT + 16 * lane); yo[0] = w0; yo[1] = w1; }
    }
}
__device__ __forceinline__ void conv_dma_rows(Frame& F, LAS unsigned char* at, size_t rowb, int T0, int tok0, int nrows, int wid, int lane) {
    for (int r = wid; r < nrows; r += NWAVES) { const int s = tok0 + r; LAS unsigned char* dst = at + ((s - T0 + 32) & 63) * 2048;
#pragma unroll
        for (int h = 0; h < 2; ++h) { const int chunk = h * 64 + lane;
            __builtin_amdgcn_global_load_lds((const unsigned*)(hblk(F, chunk >> 4) + (rowb + s) * 128 + (chunk & 15) * 8), (LAS unsigned*)(dst + h * 1024), 16, 0, 0); } }
}
template <int VAR>
__device__ __forceinline__ void conv_unit(Frame& F, int unit) {
    const int b = unit >> 4, T0 = (unit & 15) * 128;
    int tid = F.tid; asm volatile("" : "+v"(tid));
    const int wid = F.wave, lane = tid & 63;
    const size_t rowb = (size_t)b * SEQ;
    LAS unsigned char* at = F.lds;
    int c0 = 2 * tid; asm volatile("" : "+v"(c0));
    if (T0 == 0) { for (int idx = tid; idx < 30 * 128; idx += NTHREADS) *(LAS v4u*)(at + (((idx >> 7) - 30 + 32) & 63) * 2048 + (idx & 127) * 16) = (v4u){0u, 0u, 0u, 0u}; }
    else conv_dma_rows(F, at, rowb, T0, T0 - 30, 30, wid, lane);
    conv_dma_rows(F, at, rowb, T0, T0, 16, wid, lane);
    f32x2 ww[31];
    { const float* dw = F.in[16];
#pragma unroll
      for (int k = 0; k < 31; ++k) ww[k] = *(const f32x2*)(dw + (size_t)k * 1024 + c0); }
    const f32x2 bias = *(const f32x2*)(F.in[17] + c0);
    bf16* mix = (bf16*)(F.ws + WS_MIX);
#pragma unroll 1
    for (int st = 0; st < 8; ++st) {
        const int t0 = T0 + 16 * st;
        if (st == 0) asm volatile("s_waitcnt vmcnt(0) lgkmcnt(0)" ::: "memory");
        else asm volatile("s_waitcnt vmcnt(16) lgkmcnt(0)" ::: "memory");
        __syncthreads();
        if (st < 7) conv_dma_rows(F, at, rowb, T0, t0 + 16, 16, wid, lane);
        f32x2 yy[16];
#pragma unroll
        for (int i = 0; i < 16; ++i) yy[i] = bias;
        const int rb = 16 * st + 2;
#pragma unroll
        for (int jr = 0; jr < ((VAR & 2) ? 0 : 46); ++jr) {
            const unsigned w = *(const LAS unsigned*)(at + ((rb + jr) & 63) * 2048 + c0 * 2); const f32x2 a = (f32x2){bflo(w), bfhi(w)};
#pragma unroll
            for (int i = 0; i < 16; ++i) { const int k = jr - i; if (k >= 0 && k <= 30) yy[i] = __builtin_elementwise_fma(a, ww[k], yy[i]); }
        }
#pragma unroll
        for (int i = 0; i < 16; ++i) { if (VAR == 0) *(unsigned*)(mix + (rowb + t0 + i) * K1OUT + c0) = cvtpk(yy[i].x, yy[i].y);
            else if (yy[i].x == 12345.678f) at[0] = 1; }
    }
    asm volatile("s_waitcnt vmcnt(0)" ::: "memory");
    __syncthreads();
    if (VAR == 0 && CONV_FIN_IN_UNIT) { int l2 = tid & 63; asm volatile("" : "+v"(l2)); conv_finalize_rows(F, rowb + T0 + 16 * wid, 16, l2); }
}
__device__ __forceinline__ void conv_finalize(Frame& F) {
    const int gw = blockIdx.x * NWAVES + F.wave, NGW = F.G * NWAVES, lane = F.lane;
    bf16* mix = (bf16*)(F.ws + WS_MIX);
    float g[16], bb[16];
#pragma unroll
    for (int q = 0; q < 4; ++q) { const f32x4 a = *(const f32x4*)(F.in[18] + 16 * lane + 4 * q), c = *(const f32x4*)(F.in[19] + 16 * lane + 4 * q);
        g[4 * q] = a.x; g[4 * q + 1] = a.y; g[4 * q + 2] = a.z; g[4 * q + 3] = a.w; bb[4 * q] = c.x; bb[4 * q + 1] = c.y; bb[4 * q + 2] = c.z; bb[4 * q + 3] = c.w; }
    const bf16* czb = hblk(F, CB_CZ + (lane >> 3)) + (lane & 7) * 16;
    for (int m = gw; m < MROWS; m += NGW) {
        v4u* yp = (v4u*)(mix + (size_t)m * K1OUT + 16 * lane);
        const v4u y0 = yp[0], y1 = yp[1]; const v4u z0 = *(const v4u*)(czb + (size_t)m * 128), z1 = *(const v4u*)(czb + (size_t)m * 128 + 8);
        float y[16] = {bflo(y0.x), bfhi(y0.x), bflo(y0.y), bfhi(y0.y), bflo(y0.z), bfhi(y0.z), bflo(y0.w), bfhi(y0.w), bflo(y1.x), bfhi(y1.x), bflo(y1.y), bfhi(y1.y), bflo(y1.z), bfhi(y1.z), bflo(y1.w), bfhi(y1.w)};
        const float z[16] = {bflo(z0.x), bfhi(z0.x), bflo(z0.y), bfhi(z0.y), bflo(z0.z), bfhi(z0.z), bflo(z0.w), bfhi(z0.w), bflo(z1.x), bfhi(z1.x), bflo(z1.y), bfhi(z1.y), bflo(z1.z), bfhi(z1.z), bflo(z1.w), bfhi(z1.w)};
        float s = 0.f;
#pragma unroll
        for (int e = 0; e < 16; ++e) s += y[e];
        const float mu = wave_sum_dpp(s) * (1.f / 1024.f);
        float q = 0.f;
#pragma unroll
        for (int e = 0; e < 16; ++e) { y[e] -= mu; q += y[e] * y[e]; }
        const float rstd = __builtin_amdgcn_rsqf(wave_sum_dpp(q) * (1.f / 1024.f) + NORM_EPS);
        float o[16];
#pragma unroll
        for (int e = 0; e < 16; ++e) o[e] = siluf_(y[e] * rstd * g[e] + bb[e]) * z[e];
        v4u w0, w1;
        w0.x = cvtpk(o[0], o[1]); w0.y = cvtpk(o[2], o[3]); w0.z = cvtpk(o[4], o[5]); w0.w = cvtpk(o[6], o[7]);
        w1.x = cvtpk(o[8], o[9]); w1.y = cvtpk(o[10], o[11]); w1.z = cvtpk(o[12], o[13]); w1.w = cvtpk(o[14], o[15]);
        yp[0] = w0; yp[1] = w1;
    }
}

struct PolDil {
    static constexpr bool SOFTMAX = true, KNORM = true, LANEPRED = false;
    const bf16 *Kb, *Vb; int mul, addA, addB, tile0, ntc, q0; bool two; const float* kgain;
    struct TI { int kb, cls; };
    __device__ __forceinline__ int ntiles() const { return two ? 2 * ntc : ntc; }
    __device__ __forceinline__ TI tile(int t) const { const int cls = (two && t >= ntc) ? 1 : 0; return TI{64 * (tile0 + t - cls * ntc), cls}; }
    __device__ __forceinline__ const bf16* krow(const TI& ti, int i) const { return Kb + (size_t)(mul * (ti.kb + i) + (ti.cls ? addB : addA)) * 128; }
    __device__ __forceinline__ const bf16* vrow(const TI& ti, int i) const { return Vb + (size_t)(mul * (ti.kb + i) + (ti.cls ? addB : addA)) * 128; }
    __device__ __forceinline__ int qlo(int wid) const { return q0 + 32 * (two ? (wid & 3) : wid); }
    __device__ __forceinline__ bool active(const TI& ti, int wid) const { const int ql = qlo(wid); return (!two || (wid >> 2) == ti.cls) && ti.kb <= ql + 31 && ti.kb + 63 >= ql - 128; }
    __device__ __forceinline__ void mask(f32x16& p0, f32x16& p1, const TI& ti, int wid, int r32, int hi) const {
        const int ql = qlo(wid);
        if (ti.kb + 63 > ql || ti.kb < ql + 31 - 128) att::mask_tile(p0, p1, ql + r32 - ti.kb - 4 * hi, 129u);
    }
};
template <bool FX>
__device__ __forceinline__ void dil_unit(Frame& F, int unit) {
    const int typ = unit >> 9, u = unit & 511;
    int tid = F.tid; asm volatile("" : "+v"(tid));
    const int wid = F.wave, lane = tid & 63, r32 = lane & 31, hi = lane >> 5;
    int b, slot, mul, addA, addB = 0, q0, tile0, ntc; bool two = false;
    if (typ == 0) { b = u >> 5; slot = (u >> 3) & 3; const int qb = u & 7; mul = 1; addA = 0; q0 = 256 * qb; tile0 = qb ? 4 * qb - 2 : 0; ntc = 4 * qb + 4 - tile0; }
    else if (typ == 1) { b = u >> 5; slot = (u >> 3) & 3; const int c4 = (u >> 1) & 3, qb = u & 1; mul = 4; addA = c4; q0 = 256 * qb; tile0 = qb ? 2 : 0; ntc = 4 * qb + 4 - tile0; }
    else { b = u >> 5; slot = (u >> 3) & 3; const int pr = u & 7; mul = 16; addA = 2 * pr; addB = 2 * pr + 1; q0 = 0; tile0 = 0; ntc = 2; two = true; }
    const int head = typ * 4 + slot;
    const size_t rowb = (size_t)b * SEQ;
    PolDil P{hblk(F, CB_DK + head) + rowb * 128, hblk(F, CB_DV + head) + rowb * 128, mul, addA, addB, tile0, ntc, q0, two, F.in[21]};
    const int qpos = P.qlo(wid) + r32, cls = two ? (wid >> 2) : 0;
    const int tok = mul * qpos + (cls ? addB : addA);
    bf16x8 qr[8];
    { const bf16* qp = hblk(F, CB_DQ + head) + (rowb + tok) * 128 + hi * 8;
#pragma unroll
      for (int d0 = 0; d0 < 8; ++d0) qr[d0] = *reinterpret_cast<const bf16x8*>(qp + d0 * 16); }
    att::Stage S0, S1;
    if constexpr (FX) att::stage_prefetch(P, S0, S1, tid);
    att::norm_q(qr, F.in[20], hi);
    f32x16 o[4] = {}; float f[16];
    float* lse = (float*)(F.ws + WS_DLSE) + (size_t)typ * MROWS * 4;
    const int qbase = P.qlo(wid);
    const float bn = ((const float*)(F.ws + WS_MISC + FXB_OFF))[2];
    if constexpr (FX) {
        f32x16 lacc = {};
        att::att_pass_fx_pre(P, (LAS char*)F.lds, qr, o, lacc, bn * att::LOG2E, tid, S0, S1);
        int rl0 = r32, hl0 = hi; asm volatile("" : "+v"(rl0), "+v"(hl0));
#pragma unroll
        for (int r = 0; r < 16; ++r) { f[r] = __builtin_amdgcn_rcpf(lacc[r]);
            if (rl0 == 0) lse[(rowb + mul * (qbase + att::crow(r, hl0)) + (cls ? addB : addA)) * 4 + slot] = bn + __builtin_amdgcn_logf(lacc[r]) * 0.6931471805599453f; }
    } else {
        float m_reg = -1e30f, l_reg = 0.f;
        att::att_pass(P, (LAS char*)F.lds, qr, o, m_reg, l_reg, tid);
        LAS float* wsf = (LAS float*)(F.lds + att::OFF_WS) + wid * 256;
        att::row_bcast(__builtin_amdgcn_rcpf(l_reg), wsf, r32, hi, f);
        if (hi == 0) lse[(rowb + tok) * 4 + slot] = m_reg * ATT_SCALE + __builtin_amdgcn_logf(l_reg) * 0.6931471805599453f;
    }
    bf16* part = (bf16*)(F.ws + WS_DPART) + (size_t)typ * MROWS * 512;
    int rl = r32, hl = hi; asm volatile("" : "+v"(rl), "+v"(hl));
#pragma unroll
    for (int r = 0; r < 16; ++r) { const int tk = mul * (qbase + att::crow(r, hl)) + (cls ? addB : addA);
#pragma unroll
        for (int d = 0; d < 4; ++d) { const float v = o[d][r] * f[r]; const float vn = __shfl_xor(v, 1);
            if ((rl & 1) == 0) *(unsigned*)(part + (rowb + tk) * 512 + slot * 128 + d * 32 + rl) = cvtpk(v, vn); } }
}
__device__ __forceinline__ void dil_combine(Frame& F) {
    const bf16* part = (const bf16*)(F.ws + WS_DPART); const float* lse = (const float*)(F.ws + WS_DLSE);
    bf16* mix = (bf16*)(F.ws + WS_MIX);
    const size_t NE = (size_t)MROWS * 64, ST = (size_t)F.G * NTHREADS;
    for (size_t e0 = (size_t)blockIdx.x * NTHREADS + F.tid; e0 < NE; e0 += 2 * ST) {
        float l0[2], l1[2], l2[2]; v4u a[2], bq[2], cq[2], z[2]; bool ok[2];
#pragma unroll
        for (int u = 0; u < 2; ++u) { const size_t e = e0 + u * ST; ok[u] = e < NE; const size_t ee = ok[u] ? e : e0;
            const size_t m = ee >> 6; const int ch = (int)(ee & 63), slot = ch >> 4, c = (ch & 15) * 8;
            l0[u] = lse[m * 4 + slot]; l1[u] = lse[(size_t)MROWS * 4 + m * 4 + slot]; l2[u] = lse[(size_t)2 * MROWS * 4 + m * 4 + slot];
            a[u] = *(const v4u*)(part + m * 512 + slot * 128 + c); bq[u] = *(const v4u*)(part + (size_t)MROWS * 512 + m * 512 + slot * 128 + c); cq[u] = *(const v4u*)(part + (size_t)2 * MROWS * 512 + m * 512 + slot * 128 + c);
            z[u] = *(const v4u*)(hblk(F, CB_DZ + slot) + m * 128 + c); }
#pragma unroll
        for (int u = 0; u < 2; ++u) { const size_t e = e0 + u * ST; if (!ok[u]) continue;
            const size_t m = e >> 6; const int ch = (int)(e & 63), slot = ch >> 4, c = (ch & 15) * 8;
            const float mx = fmaxf(l0[u], fmaxf(l1[u], l2[u]));
            float w0 = fast_exp(l0[u] - mx), w1 = fast_exp(l1[u] - mx), w2 = fast_exp(l2[u] - mx);
            const float inv = 1.0f / (w0 + w1 + w2); w0 *= inv; w1 *= inv; w2 *= inv;
            v4u o;
#define DC_(X) cvtpk((w0 * bflo(a[u].X) + w1 * bflo(bq[u].X) + w2 * bflo(cq[u].X)) * bflo(z[u].X), (w0 * bfhi(a[u].X) + w1 * bfhi(bq[u].X) + w2 * bfhi(cq[u].X)) * bfhi(z[u].X))
            o.x = DC_(x); o.y = DC_(y); o.z = DC_(z); o.w = DC_(w);
#undef DC_
            *(v4u*)(mix + m * K1OUT + 1024 + slot * 128 + c) = o; }
    }
}

constexpr int N_PHASES = 12;
struct Args { const float* in[22]; float* out; unsigned char* ws; int ph_lo, ph_hi; };
__global__ void __launch_bounds__(NTHREADS, 2) hybrid_fwd(Args args) {
    extern __shared__ __attribute__((aligned(16))) unsigned char lds_raw[];
    Frame F;
    F.lds = (LAS unsigned char*)lds_raw;
    F.MISC = (volatile LAS unsigned*)(F.lds + LDSCTL_OFF);
    F.tid = threadIdx.x; F.lane = F.tid & 63; F.wave = __builtin_amdgcn_readfirstlane(F.tid >> 6);
    F.G = gridDim.x; F.ws = args.ws; F.ctl = (gu32*)(args.ws + WS_CTL); F.out = args.out;
#pragma unroll
    for (int i = 0; i < 22; ++i) F.in[i] = args.in[i];
    for (int u = F.tid; u < 256; u += NTHREADS) ((LAS unsigned*)(F.lds + LDSCTL_OFF))[u] = 0u;
    __syncthreads();
    XcdBarrier bar = xcd_barrier_post((unsigned*)(F.ctl + CW_BAR), F.MISC + 8);
    const int lo = args.ph_lo, hi = args.ph_hi;
#ifndef PH_MASK
#define PH_MASK 0xFFF
#endif
#define INR(k) (lo <= (k) && (k) < hi)
#define IN(k) (((PH_MASK >> (k)) & 1) && INR(k))
#ifndef REPEAT_MASK
#define REPEAT_MASK 0
#endif
#ifndef REP8_SKIP
#define REP8_SKIP 0
#endif
#ifndef CONV_VAR
#define CONV_VAR 0
#endif
#ifndef RET_VAR
#define RET_VAR 0
#endif
#ifndef NSA_VAR
#define NSA_VAR 0
#endif
#define NREP(k) (((REPEAT_MASK >> (k)) & 1) ? 2 : 1)
#define SEAM(k) do { if (INR(k) && INR((k) + 1)) xcd_barrier(bar); } while (0)
    bf16* XN = (bf16*)(F.ws + WS_A);
    bf16* MIX = (bf16*)(F.ws + WS_MIX);

    const bool fold = FOLD_P2 && F.G == 256 && lo <= 0 && hi > 2;
    if (IN(0)) { p0_prologue(F, (fold && DEFER_W1) ? P0_DEFER : 0); }
#if (REPEAT_MASK >> 0) & 1
    xcd_barrier(bar); if (IN(0)) { p0_prologue<P0_REP_SKIP>(F); }
#endif
    SEAM(0);
    if (IN(1)) {
        gu32* kv_done = F.ctl + CW_Q + 64 * 22;
        pg8::Gemm g{XN, (const bf16*)(F.ws + WS_W0IN), MROWS, N0, DM}; pg8::NotifyOrder S; S.init(MROWS, N0, F.G, (int)blockIdx.x);
        S.cnt = (unsigned*)kv_done; S.mask = fold ? ((1u << 20) | (1u << 21) | (1u << 22) | (1u << 24)) : 0u;
        pg8::EpiH E{hblk(F, 0), HBLK, CB_RZ, CB_RZ + 8, CB_NZ, CB_NZ + 8, (const float*)(F.ws + WS_MISC + ROPE_OFF), 16};
        pg8::gemm_phase<pg8::EpiH, pg8::NotifyOrder, true, true>(F.lds, g, S, E);
        if (fold && blockIdx.x >= 128) {
            if (F.tid < 64) {
                unsigned sp = 0;
                while ((unsigned)__builtin_amdgcn_readfirstlane(__hip_atomic_load(kv_done, RLX_AGENT)) < 512u) { __builtin_amdgcn_s_sleep(2); if (++sp > (1u << 22)) break; }
                __builtin_amdgcn_fence(__ATOMIC_ACQUIRE, "agent");
                asm volatile("s_waitcnt vmcnt(0)" ::: "memory");
            }
            __syncthreads();
            if (blockIdx.x < 192) {
                const int ix = (int)blockIdx.x - 128, kv = ix >> 5, kh = (ix >> 4) & 1;
                pg8::Gemm g2{hblk(F, kv ? CB_VC : CB_KC) + kh * 1024, (const bf16*)(F.ws + WS_CW) + (size_t)kv * 256 * 2048 + kh * 1024, 4096, 256, 2048, 16}; pg8::StaticOrder S2; S2.init(4096, 256, 16, ix & 15);
                pg8::EpiF32 E2{(float*)(F.ws + (kh ? WS_CPR2 : WS_CPR)) + (size_t)kv * 4096 * 256, 256};
                pg8::gemm_phase<pg8::EpiF32, pg8::StaticOrder, false, true>(F.lds, g2, S2, E2);
            }
            for (int it = wq_first(F, 0); it < 4 * 128;) {
                const unsigned nx = wq_issue(F, 0);
                const int bi = it >> 7, row0 = (it & 127) * 256;
                if (bi < 2) rowop_item<1>(hblk(F, CB_KS + bi), row0, F.in[6] + 128, nullptr, F.tid);
                else rowop_item<1>(hblk(F, CB_KW + bi - 2), row0, F.in[6] + 256, nullptr, F.tid);
                it = wq_take(F, nx);
            }
            if (DEFER_W1) p0_weight_items(F, P0_NITEMS - P0_DEFER + ((int)blockIdx.x - 128) * NWAVES + F.wave, P0_NITEMS, 128 * NWAVES);
        }
    }
#if (REPEAT_MASK >> 1) & 1
    xcd_barrier(bar);
    if (IN(1)) {
        pg8::Gemm g{XN, (const bf16*)(F.ws + WS_W0IN), MROWS, N0, DM}; pg8::StaticOrder S; S.init(MROWS, N0, F.G, (int)blockIdx.x);
        pg8::EpiH E{hblk(F, 0), HBLK, CB_RZ, CB_RZ + 8, CB_NZ, CB_NZ + 8, (const float*)(F.ws + WS_MISC + ROPE_OFF), 16};
        pg8::gemm_phase<pg8::EpiH, pg8::StaticOrder, true, true>(F.lds, g, S, E);
    }
#endif
    SEAM(1);
    if (IN(2) && !fold) {
        if (blockIdx.x < 64 && F.G >= 64) {
            const int kv = blockIdx.x >> 5, kh = (blockIdx.x >> 4) & 1;
            pg8::Gemm g{hblk(F, kv ? CB_VC : CB_KC) + kh * 1024, (const bf16*)(F.ws + WS_CW) + (size_t)kv * 256 * 2048 + kh * 1024, 4096, 256, 2048, 16}; pg8::StaticOrder S; S.init(4096, 256, 16, (int)(blockIdx.x & 15));
            pg8::EpiF32 E{(float*)(F.ws + (kh ? WS_CPR2 : WS_CPR)) + (size_t)kv * 4096 * 256, 256};
            pg8::gemm_phase<pg8::EpiF32, pg8::StaticOrder, false, true>(F.lds, g, S, E);
        }
        const float* rope = (const float*)(F.ws + WS_MISC + ROPE_OFF);
        constexpr int NITEM = 4 * 128;
        for (int it = wq_first(F, 0); it < NITEM;) {
            const unsigned nx = wq_issue(F, 0);
            const int bi = it >> 7, row0 = (it & 127) * 256;
            if (bi < 2) rowop_item<1>(hblk(F, CB_KS + bi), row0, F.in[6] + 128, nullptr, F.tid);
            else rowop_item<1>(hblk(F, CB_KW + bi - 2), row0, F.in[6] + 256, nullptr, F.tid);
            it = wq_take(F, nx);
        }
        if (F.G < 64) {
            for (int kv = 0; kv < 2; ++kv) {
                pg8::Gemm g{hblk(F, kv ? CB_VC : CB_KC), (const bf16*)(F.ws + WS_CW) + (size_t)kv * 256 * 2048, 4096, 256, 2048}; pg8::StaticOrder S; S.init(4096, 256, F.G, (int)blockIdx.x);
                pg8::EpiF32 E{(float*)(F.ws + WS_CPR) + (size_t)kv * 4096 * 256, 256};
                for (size_t e = (size_t)blockIdx.x * NTHREADS + F.tid; e < (size_t)4096 * 256; e += (size_t)F.G * NTHREADS) ((float*)(F.ws + WS_CPR2))[(size_t)kv * 4096 * 256 + e] = 0.f;
                __syncthreads();
                pg8::gemm_phase<pg8::EpiF32, pg8::StaticOrder, false, true>(F.lds, g, S, E);
            }
        }
    }
    if (!fold) SEAM(2);
    if (IN(3)) {
        gu32* cmp_done = F.ctl + CW_Q + 64 * 20; gu32* st_done = F.ctl + CW_Q + 64 * 21;
        bool cmp_ok = false, st_ok = false;
        for (int it = wq_first(F, 1); it < 64 + 128 + 1024 + 1024;) {
            const unsigned nx = wq_issue(F, 1);
            if (it < 64) {
                cmp_tail_unit(F, it);
                __threadfence();
                __syncthreads();
                if (F.tid == 0) __hip_atomic_fetch_add(cmp_done, 1u, RLX_AGENT);
            } else if (it < 64 + 128) {
                ret_state_unit(F, it - 64);
                __threadfence();
                __syncthreads();
                if (F.tid == 0) __hip_atomic_fetch_add(st_done, 1u, RLX_AGENT);
            } else if (it < 64 + 128 + 1024) {
                if (!cmp_ok) {
                    if (F.tid < 64) {
                        unsigned sp = 0;
                        while ((unsigned)__builtin_amdgcn_readfirstlane(__hip_atomic_load(cmp_done, RLX_AGENT)) < 64u) { __builtin_amdgcn_s_sleep(2); if (++sp > (1u << 22)) break; }
                        __builtin_amdgcn_fence(__ATOMIC_ACQUIRE, "agent");
                        asm volatile("s_waitcnt vmcnt(0)" ::: "memory");
                    }
                    __syncthreads();
                    cmp_ok = true;
                }
                nsa_unit<0>(F, it - 64 - 128);
            } else {
                if (!st_ok) {
                    if (F.tid < 64) {
                        unsigned sp = 0;
                        while ((unsigned)__builtin_amdgcn_readfirstlane(__hip_atomic_load(st_done, RLX_AGENT)) < 128u) { __builtin_amdgcn_s_sleep(2); if (++sp > (1u << 22)) break; }
                        __builtin_amdgcn_fence(__ATOMIC_ACQUIRE, "agent");
                        asm volatile("s_waitcnt vmcnt(0)" ::: "memory");
                    }
                    __syncthreads();
                    st_ok = true;
                }
                retention_unit<0>(F, it - 64 - 128 - 1024);
            }
            it = wq_take(F, nx);
        }
    }
    SEAM(3);
    if (IN(5)) {
        pg8::Gemm g{MIX, (const bf16*)(F.ws + WS_W0OUT), MROWS, DM, 2048}; pg8::StaticOrder S; S.init(MROWS, DM, F.G, (int)blockIdx.x);
        pg8::EpiRes2 E{F.in[0], F.out, XN, (float*)(F.ws + WS_CTL + 512 * 1024), DM};
        pg8::gemm_phase<pg8::EpiRes2, pg8::StaticOrder, true, true>(F.lds, g, S, E);
    }
    SEAM(5);
    if (IN(7)) {
        pg8::Gemm g{XN, (const bf16*)(F.ws + WS_W1IN), MROWS, N1, DM}; pg8::StaticOrder S; S.init(MROWS, N1, F.G, (int)blockIdx.x);
        pg8::EpiHS E{hblk(F, 0), HBLK, (const float*)(F.ws + WS_CTL + 512 * 1024), 1.f / DM, NORM_EPS, 8, CB_CZ, CB_CZ + 8, CB_DZ, CB_DZ + 4};
        pg8::gemm_phase<pg8::EpiHS, pg8::StaticOrder, true, true>(F.lds, g, S, E);
    }
    SEAM(7);
    if (IN(8)) {
        if (FX_DIL && ((const float*)(F.ws + WS_MISC + FXB_OFF))[2] <= att::FX_MAX) {
            for (int it = wq_first(F, 3); it < 1536 + 256;) {
                const unsigned nx = wq_issue(F, 3);
                if (it < 256) { if (!(DBG_SKIP & 16)) conv_unit<0>(F, it); } else if (!(DBG_SKIP & 32)) dil_unit<true>(F, it - 256);
                it = wq_take(F, nx);
            }
        } else {
            for (int it = wq_first(F, 3); it < 1536 + 256;) {
                const unsigned nx = wq_issue(F, 3);
                if (it < 256) { if (!(DBG_SKIP & 16)) conv_unit<0>(F, it); } else if (!(DBG_SKIP & 32)) dil_unit<false>(F, it - 256);
                it = wq_take(F, nx);
            }
        }
    }
#if (REPEAT_MASK >> 8) & 1
    xcd_barrier(bar);
    if (IN(8)) {
        for (int it = wq_first(F, 11); it < 1536 + 256;) {
            const unsigned nx = wq_issue(F, 11);
            if (it < 256) { if (!(REP8_SKIP & 1)) conv_unit<CONV_VAR>(F, it); } else if (!(REP8_SKIP & 2)) dil_unit<true>(F, it - 256);
            it = wq_take(F, nx);
        }
    }
#endif
    SEAM(8);
    if (IN(10)) { dil_combine(F); if (!CONV_FIN_IN_UNIT) conv_finalize(F); }
#if (REPEAT_MASK >> 10) & 1
    xcd_barrier(bar); if (IN(10)) { dil_combine(F); }
#endif
    SEAM(10);
    if (IN(11)) {
        pg8::Gemm g{MIX, (const bf16*)(F.ws + WS_W1OUT), MROWS, DM, K1OUT}; pg8::StaticOrder S; S.init(MROWS, DM, F.G, (int)blockIdx.x);
        pg8::EpiRes E{F.out, F.out, DM};
        pg8::gemm_phase<pg8::EpiRes, pg8::StaticOrder, true, true>(F.lds, g, S, E);
    }
#undef IN
#undef INR
#undef SEAM
}

#ifndef MK_CUTS
#define MK_CUTS 0
#endif
extern "C" void kernel_launch(void* const* d_in, const int* in_sizes, int n_in, void* d_out, int out_size, void* d_ws, size_t ws_size, hipStream_t stream) {
    static int grid = 0;
    if (grid == 0) {
        if (n_in != 22 || out_size != MROWS * DM || ws_size < WS_END) { fprintf(stderr, "kernel_launch: unexpected shapes (n_in %d, out %d, ws %zu)\n", n_in, out_size, ws_size); grid = -1; return; }
        int dev = 0, cus = 0, per_cu = 0;
        if (hipGetDevice(&dev) != hipSuccess || hipDeviceGetAttribute(&cus, hipDeviceAttributeMultiprocessorCount, dev) != hipSuccess) { grid = -1; return; }
        if (hipFuncSetAttribute((const void*)hybrid_fwd, hipFuncAttributeMaxDynamicSharedMemorySize, LDS_BYTES) != hipSuccess) { fprintf(stderr, "kernel_launch: hipFuncSetAttribute failed\n"); grid = -1; return; }
        if (hipOccupancyMaxActiveBlocksPerMultiprocessor(&per_cu, (const void*)hybrid_fwd, NTHREADS, LDS_BYTES) != hipSuccess || per_cu < 1)
            fprintf(stderr, "kernel_launch: note: occupancy query reports %d workgroups per CU\n", per_cu);
        (void)hipGetLastError();
        grid = cus;
        if (grid > 256) grid = 256;
    }
    if (grid < 0) return;
    if (hipMemsetAsync((char*)d_ws + WS_CTL, 0, CTL_ZERO_BYTES, stream) != hipSuccess) return;
    Args a{};
    for (int i = 0; i < 22; ++i) a.in[i] = (const float*)d_in[i];
    a.out = (float*)d_out; a.ws = (unsigned char*)d_ws;
#if MK_CUTS
    for (int p = 0; p < N_PHASES; ++p) { a.ph_lo = p; a.ph_hi = p + 1; hipLaunchKernelGGL(hybrid_fwd, dim3(grid), dim3(NTHREADS), LDS_BYTES, stream, a); }
#else
    a.ph_lo = 0; a.ph_hi = N_PHASES;
    hipLaunchKernelGGL(hybrid_fwd, dim3(grid), dim3(NTHREADS), LDS_BYTES, stream, a);
#endif
}
```

```cpp
#include <hip/hip_runtime.h>
#include <cstdio>
#include <cstdint>
namespace pg8 {
#define PG8_LAS __attribute__((address_space(3)))
typedef unsigned short bf16_t;
typedef short bf16x8 __attribute__((ext_vector_type(8)));
typedef float f32x4 __attribute__((ext_vector_type(4)));
typedef unsigned u32x4 __attribute__((ext_vector_type(4)));
constexpr int BM = 256, BK = 64, HALF = 128, HTB = HALF * BK * 2  , STAGE_BYTES = 8 * HTB, NXCD = 8, WGM = 8;

__host__ __device__ __forceinline__ int lds_byte(int r, int c) { const int st = (r >> 4) * 2 + (c >> 5), rr = r & 15, cc = c & 31, ob = rr * 64 + cc * 2; return st * 1024 + (ob ^ (((ob >> 9) & 1) << 5)); }
__host__ __device__ __forceinline__ void stage_rc(int b, int& R, int& C) { const int st = b / 1024, sb = b % 1024, swz = sb ^ (((sb >> 9) & 1) << 5); R = (st >> 1) * 16 + swz / 64; C = (st & 1) * 32 + (swz % 64) / 2; }
__host__ __device__ __forceinline__ int perm32(int rho) { const int n = rho >> 4, i = rho & 15; return 8 * (i >> 2) + 4 * n + (i & 3); }

struct Unit { int pm, pn; };
struct Gemm { const bf16_t* A; const bf16_t* Bt; int M, N, K; int ktn = 0; };

struct StaticOrder {
    int nM, nN, nwg, G, c;
    __host__ __device__ void init(int M, int N, int G_, int c_) { nM = M / BM; nN = N / BM; nwg = nM * nN; G = G_; c = c_; }
    __host__ __device__ bool next(int i, Unit& u) const {
        const long L = (long)i * G + c; if (L >= nwg) return false;
        int wgid = (int)L; { const int q = nwg / NXCD, r = nwg % NXCD, xcd = wgid % NXCD, off = wgid / NXCD; wgid = (xcd < r ? xcd * (q + 1) : r * (q + 1) + (xcd - r) * q) + off; }
        const int nig = WGM * nN, gid = wgid / nig, fm = gid * WGM, gsz = (nM - fm) < WGM ? (nM - fm) : WGM;
        u.pm = fm + ((wgid % nig) % gsz); u.pn = (wgid % nig) / gsz; return true;
    }
    __device__ __forceinline__ void a_ready(const Unit&) const {}
    __device__ __forceinline__ void done(const Unit&) const {}
};
struct NotifyOrder : StaticOrder {
    unsigned* cnt; unsigned mask;
    __device__ __forceinline__ void done(const Unit& u) const {
        if ((mask >> u.pn) & 1u) {
            asm volatile("s_waitcnt vmcnt(0)" ::: "memory");
            __builtin_amdgcn_s_barrier();
            if (threadIdx.x == 0) { __threadfence(); __hip_atomic_fetch_add(cnt, 1u, __ATOMIC_RELAXED, __HIP_MEMORY_SCOPE_AGENT); }
        }
    }
};
typedef float cvt_f2_t __attribute__((ext_vector_type(2)));
typedef __bf16 cvt_b2_t __attribute__((ext_vector_type(2)));
__device__ __forceinline__ unsigned cvt_pk_bf16(float lo, float hi) { const cvt_f2_t v = {lo, hi}; return __builtin_bit_cast(unsigned, __builtin_convertvector(v, cvt_b2_t)); }

__device__ __forceinline__ float epi_silu(float x) { return x * __builtin_amdgcn_rcpf(1.0f + __builtin_amdgcn_exp2f(x * -1.4426950408889634f)); }
struct EpiH {
    static constexpr bool PERM = true, AFTER_DRAIN = false;
    bf16_t* O; size_t blk_stride; int sa0, sa1, sb0, sb1;
    const float* rope; int nrot;
    __device__ __forceinline__ void operator()(const f32x4 (&acc)[2][2][4][2], const Unit& u, int wr, int wc, int fr, int fq) const {
        const int row0 = u.pm * BM + wr * 64 + fr; const int col0 = wc * 32 + 8 * fq;
#pragma unroll
        for (int bj = 0; bj < 2; ++bj) { const int cb = u.pn * 2 + bj; const bool sl = (cb >= sa0 && cb < sa1) || (cb >= sb0 && cb < sb1);
            if (cb < nrot) {
                const int hh = cb & 7;
                constexpr float LG[8] = {-0.04580368961312479f, -0.02272007650008353f, -0.011315313227834146f, -0.005646563141142063f, -0.0028205190623786626f, -0.0014095702546713536f, -0.0007046129765893727f, -0.0003522634716290214f};
                float lg = LG[0];
#pragma unroll
                for (int k = 1; k < 8; ++k) lg = (hh == k) ? LG[k] : lg;
                const float lgs = cb < 8 ? lg : -lg, fm = cb < 8 ? 0.08838834764831845f : 1.f;
#pragma unroll
                for (int ai = 0; ai < 2; ++ai)
#pragma unroll
                    for (int m = 0; m < 4; ++m) { const int row = row0 + ai * HALF + m * 16, sp = row & 2047;
                        const f32x4 cs = *(const f32x4*)(rope + (size_t)sp * 128 + 16 * wc + 4 * fq), sn = *(const f32x4*)(rope + (size_t)sp * 128 + 64 + 16 * wc + 4 * fq);
                        const float fr_ = __builtin_amdgcn_exp2f((float)sp * lgs) * fm;
                        const f32x4 t1 = acc[ai][bj][m][0], t2 = acc[ai][bj][m][1];
                        const f32x4 o1 = (t1 * cs - t2 * sn) * fr_, o2 = (t2 * cs + t1 * sn) * fr_;
                        bf16_t* rowp = O + (size_t)cb * blk_stride + (size_t)row * 128 + col0;
                        u32x4 w; w.x = cvt_pk_bf16(o1[0], o1[1]); w.y = cvt_pk_bf16(o1[2], o1[3]); w.z = cvt_pk_bf16(o2[0], o2[1]); w.w = cvt_pk_bf16(o2[2], o2[3]);
                        __builtin_nontemporal_store(w, (u32x4*)rowp); }
                continue;
            }
#pragma unroll
            for (int ai = 0; ai < 2; ++ai)
#pragma unroll
                for (int m = 0; m < 4; ++m) { f32x4 v0 = acc[ai][bj][m][0], v1 = acc[ai][bj][m][1];
                    if (sl) { v0 = (f32x4){epi_silu(v0[0]), epi_silu(v0[1]), epi_silu(v0[2]), epi_silu(v0[3])}; v1 = (f32x4){epi_silu(v1[0]), epi_silu(v1[1]), epi_silu(v1[2]), epi_silu(v1[3])}; }
                    bf16_t* rowp = O + (size_t)cb * blk_stride + (size_t)(row0 + ai * HALF + m * 16) * 128 + col0;
                    u32x4 w; w.x = cvt_pk_bf16(v0[0], v0[1]); w.y = cvt_pk_bf16(v0[2], v0[3]); w.z = cvt_pk_bf16(v1[0], v1[1]); w.w = cvt_pk_bf16(v1[2], v1[3]);
                    __builtin_nontemporal_store(w, (u32x4*)rowp); } }
    }
};
struct EpiF32 {
    static constexpr bool PERM = false, AFTER_DRAIN = false;
    float* C; int ldc;
    __device__ __forceinline__ void operator()(const f32x4 (&acc)[2][2][4][2], const Unit& u, int wr, int wc, int fr, int fq) const {
        const int row0 = u.pm * BM + wr * 64 + fr, col0 = u.pn * BM + wc * 32 + 4 * fq;
#pragma unroll
        for (int ai = 0; ai < 2; ++ai)
#pragma unroll
            for (int m = 0; m < 4; ++m) { float* rowp = C + (size_t)(row0 + ai * HALF + m * 16) * ldc + col0;
#pragma unroll
                for (int bj = 0; bj < 2; ++bj)
#pragma unroll
                    for (int n = 0; n < 2; ++n) *(f32x4*)(rowp + bj * HALF + n * 16) = acc[ai][bj][m][n]; }
    }
};
struct EpiRes {
    static constexpr bool PERM = true, AFTER_DRAIN = false;
    const float* base; float* out; int ldc;
    __device__ __forceinline__ void operator()(const f32x4 (&acc)[2][2][4][2], const Unit& u, int wr, int wc, int fr, int fq) const {
        const int row0 = u.pm * BM + wr * 64 + fr, col0 = u.pn * BM + wc * 32 + 8 * fq;
#pragma unroll
        for (int ai = 0; ai < 2; ++ai) {
            f32x4 bs[4][2][2];
#pragma unroll
            for (int m = 0; m < 4; ++m) { const size_t off = (size_t)(row0 + ai * HALF + m * 16) * ldc + col0;
#pragma unroll
                for (int bj = 0; bj < 2; ++bj)
#pragma unroll
                    for (int n = 0; n < 2; ++n) bs[m][bj][n] = *(const f32x4*)(base + off + bj * HALF + n * 4); }
#pragma unroll
            for (int m = 0; m < 4; ++m) { const size_t off = (size_t)(row0 + ai * HALF + m * 16) * ldc + col0;
#pragma unroll
                for (int bj = 0; bj < 2; ++bj)
#pragma unroll
                    for (int n = 0; n < 2; ++n) __builtin_nontemporal_store(bs[m][bj][n] + acc[ai][bj][m][n], (f32x4*)(out + off + bj * HALF + n * 4)); }
            asm volatile("" ::: "memory"); }
    }
};
struct EpiRes2 {
    static constexpr bool PERM = true, AFTER_DRAIN = false;
    const float* base; float* out; bf16_t* xn; float* ss; int ldc;
    __device__ __forceinline__ void operator()(const f32x4 (&acc)[2][2][4][2], const Unit& u, int wr, int wc, int fr, int fq) const {
        const int row0 = u.pm * BM + wr * 64 + fr, col0 = u.pn * BM + wc * 32 + 8 * fq;
#pragma unroll
        for (int ai = 0; ai < 2; ++ai) {
            f32x4 bs[4][2][2];
#pragma unroll
            for (int m = 0; m < 4; ++m) { const size_t off = (size_t)(row0 + ai * HALF + m * 16) * ldc + col0;
#pragma unroll
                for (int bj = 0; bj < 2; ++bj)
#pragma unroll
                    for (int n = 0; n < 2; ++n) bs[m][bj][n] = __builtin_nontemporal_load((const f32x4*)(base + off + bj * HALF + n * 4)); }
#pragma unroll
            for (int m = 0; m < 4; ++m) { const int row = row0 + ai * HALF + m * 16; const size_t off = (size_t)row * ldc + col0;
                float sq = 0.f;
#pragma unroll
                for (int bj = 0; bj < 2; ++bj) { const f32x4 v0 = bs[m][bj][0] + acc[ai][bj][m][0], v1 = bs[m][bj][1] + acc[ai][bj][m][1];
                    __builtin_nontemporal_store(v0, (f32x4*)(out + off + bj * HALF)); __builtin_nontemporal_store(v1, (f32x4*)(out + off + bj * HALF + 4));
                    u32x4 w; w.x = cvt_pk_bf16(v0[0], v0[1]); w.y = cvt_pk_bf16(v0[2], v0[3]); w.z = cvt_pk_bf16(v1[0], v1[1]); w.w = cvt_pk_bf16(v1[2], v1[3]);
                    *(u32x4*)(xn + off + bj * HALF) = w;
                    sq += (v0[0] * v0[0] + v0[1] * v0[1]) + (v0[2] * v0[2] + v0[3] * v0[3]) + (v1[0] * v1[0] + v1[1] * v1[1]) + (v1[2] * v1[2] + v1[3] * v1[3]); }
                sq += __shfl_xor(sq, 16); sq += __shfl_xor(sq, 32);
                if (fq == 0) __hip_atomic_fetch_add(ss + row, sq, __ATOMIC_RELAXED, __HIP_MEMORY_SCOPE_AGENT); }
            asm volatile("" ::: "memory"); }
    }
};
struct EpiHS {
    static constexpr bool PERM = true, AFTER_DRAIN = false;
    bf16_t* O; size_t blk_stride; const float* ss; float invk, eps; int nglu, sa0, sa1, sb0, sb1;
    __device__ __forceinline__ void operator()(const f32x4 (&acc)[2][2][4][2], const Unit& u, int wr, int wc, int fr, int fq) const {
        const int row0 = u.pm * BM + wr * 64 + fr; const int col0 = wc * 32 + 8 * fq;
        float rs[2][4];
#pragma unroll
        for (int ai = 0; ai < 2; ++ai)
#pragma unroll
            for (int m = 0; m < 4; ++m) rs[ai][m] = __builtin_amdgcn_rsqf(ss[row0 + ai * HALF + m * 16] * invk + eps);
        const bool glu = u.pn < nglu;
#pragma unroll
        for (int bj = 0; bj < 2; ++bj) { const int cb = u.pn * 2 + bj; const bool sl = (cb >= sa0 && cb < sa1) || (cb >= sb0 && cb < sb1);
#pragma unroll
            for (int ai = 0; ai < 2; ++ai)
#pragma unroll
                for (int m = 0; m < 4; ++m) { const int row = row0 + ai * HALF + m * 16; f32x4 v0 = acc[ai][bj][m][0] * rs[ai][m], v1 = acc[ai][bj][m][1] * rs[ai][m];
                    if (glu) {
                        const float a0 = v0[0] * __builtin_amdgcn_rcpf(1.0f + __builtin_amdgcn_exp2f(v1[0] * -1.4426950408889634f)), a1 = v0[1] * __builtin_amdgcn_rcpf(1.0f + __builtin_amdgcn_exp2f(v1[1] * -1.4426950408889634f));
                        const float a2 = v0[2] * __builtin_amdgcn_rcpf(1.0f + __builtin_amdgcn_exp2f(v1[2] * -1.4426950408889634f)), a3 = v0[3] * __builtin_amdgcn_rcpf(1.0f + __builtin_amdgcn_exp2f(v1[3] * -1.4426950408889634f));
                        typedef unsigned u32x2 __attribute__((ext_vector_type(2)));
                        u32x2 w; w.x = cvt_pk_bf16(a0, a1); w.y = cvt_pk_bf16(a2, a3);
                        *(u32x2*)(O + (size_t)u.pn * blk_stride + (size_t)row * 128 + 64 * bj + 16 * wc + 4 * fq) = w;
                    } else {
                        if (sl) { v0 = (f32x4){epi_silu(v0[0]), epi_silu(v0[1]), epi_silu(v0[2]), epi_silu(v0[3])}; v1 = (f32x4){epi_silu(v1[0]), epi_silu(v1[1]), epi_silu(v1[2]), epi_silu(v1[3])}; }
                        bf16_t* rowp = O + (size_t)cb * blk_stride + (size_t)row * 128 + col0;
                        u32x4 w; w.x = cvt_pk_bf16(v0[0], v0[1]); w.y = cvt_pk_bf16(v0[2], v0[3]); w.z = cvt_pk_bf16(v1[0], v1[1]); w.w = cvt_pk_bf16(v1[2], v1[3]);
                        __builtin_nontemporal_store(w, (u32x4*)rowp); } } }
    }
};

template <class Epi, class Sched, bool ALIGN_EPI = false, bool SP2 = false>
__device__ __forceinline__ void gemm_phase(PG8_LAS unsigned char* lds, const Gemm g, const Sched& S, const Epi& E) {
    const int tid = threadIdx.x, wid = __builtin_amdgcn_readfirstlane(tid >> 6), lane = tid & 63, wr = wid >> 2, wc = wid & 3, fr = lane & 15, fq = lane >> 4;
    const int K = g.K, nt = g.ktn ? g.ktn : K / BK;
    unsigned voffA[2], voffB[2];
#pragma unroll
    for (int i = 0; i < 2; ++i) { int R, C; stage_rc(tid * 16 + i * 8192, R, C); const int Rb = Epi::PERM ? ((R & ~31) + perm32(R & 31)) : R;
        voffA[i] = (unsigned)(R * K + C) * 2u; voffB[i] = (unsigned)(Rb * K + C) * 2u; }
    const size_t kstep = (size_t)(BK * 2);
    const size_t hstep = (size_t)HALF * K * 2;
    const size_t tstep = 2 * hstep;
    const unsigned ldsw = (unsigned)wid * 1024u;
    const int aoff = lds_byte(wr * 64 + fr, fq * 8), boff = lds_byte(wc * 32 + fr, fq * 8);
#define PG8_SA(b, h) (((b) * 2 + (h)) * HTB)
#define PG8_SB(b, h) ((4 + (b) * 2 + (h)) * HTB)
#define PG8_STAGE(bufoff, gbase, voff) do { _Pragma("unroll") for (int _i = 0; _i < 2; ++_i) \
        __builtin_amdgcn_global_load_lds((const unsigned*)((const char*)(gbase) + (voff)[_i]), (PG8_LAS unsigned*)(lds + (bufoff) + ldsw + _i * 8192), 16, 0, 0); } while (0)
#define PG8_LDA(dst, b, h) do { _Pragma("unroll") for (int m = 0; m < 4; ++m) _Pragma("unroll") for (int k = 0; k < 2; ++k) dst[m][k] = *(const PG8_LAS bf16x8*)(lds + PG8_SA(b, h) + aoff + m * 2048 + k * 1024); } while (0)
#define PG8_LDB(dst, b, h) do { _Pragma("unroll") for (int n = 0; n < 2; ++n) _Pragma("unroll") for (int k = 0; k < 2; ++k) dst[n][k] = *(const PG8_LAS bf16x8*)(lds + PG8_SB(b, h) + boff + n * 2048 + k * 1024); } while (0)
#define PG8_MMA(ai, bj, At, Bt) do { __builtin_amdgcn_s_setprio(1); _Pragma("unroll") for (int m = 0; m < 4; ++m) _Pragma("unroll") for (int n = 0; n < 2; ++n) _Pragma("unroll") for (int k = 0; k < 2; ++k) \
        acc[ai][bj][m][n] = __builtin_amdgcn_mfma_f32_16x16x32_bf16(Bt[n][k], At[m][k], acc[ai][bj][m][n], 0, 0, 0); __builtin_amdgcn_s_setprio(0); } while (0)
#define PG8_WAIT_V(n) asm volatile("s_waitcnt vmcnt(" #n ")" ::: "memory")
#define PG8_WAIT_L(n) asm volatile("s_waitcnt lgkmcnt(" #n ")" ::: "memory")
#define PG8_BAR __builtin_amdgcn_s_barrier()
#define PG8_SCHED __builtin_amdgcn_sched_barrier(0)
    Unit cur, nxt; int ui = 0;
    if (!S.next(0, cur)) return;
    f32x4 acc[2][2][4][2];
#pragma unroll
    for (int a = 0; a < 2; ++a)
#pragma unroll
        for (int b = 0; b < 2; ++b)
#pragma unroll
            for (int m = 0; m < 4; ++m)
#pragma unroll
                for (int n = 0; n < 2; ++n) acc[a][b][m][n] = (f32x4){0.f, 0.f, 0.f, 0.f};
    bf16x8 At[4][2], B0[2][2], B1[2][2];
    const char* cA = (const char*)g.A + (size_t)cur.pm * tstep; const char* cB = (const char*)g.Bt + (size_t)cur.pn * tstep;
    S.a_ready(cur);
    if constexpr (SP2) {
        PG8_STAGE(PG8_SB(0, 0), cB, voffB); PG8_STAGE(PG8_SB(0, 1), cB + hstep, voffB); PG8_STAGE(PG8_SA(0, 0), cA, voffA); PG8_STAGE(PG8_SA(0, 1), cA + hstep, voffA);
        if (wr == 1) PG8_BAR;
        PG8_WAIT_V(2); PG8_BAR;
        PG8_STAGE(PG8_SB(1, 0), cB + kstep, voffB); PG8_STAGE(PG8_SA(1, 0), cA + kstep, voffA); PG8_STAGE(PG8_SB(1, 1), cB + hstep + kstep, voffB);
        PG8_WAIT_V(6); PG8_BAR;
    } else {
        PG8_STAGE(PG8_SB(0, 0), cB, voffB); PG8_STAGE(PG8_SA(0, 0), cA, voffA); PG8_STAGE(PG8_SB(0, 1), cB + hstep, voffB); PG8_STAGE(PG8_SA(0, 1), cA + hstep, voffA);
        if (wr == 1) PG8_BAR;
        PG8_WAIT_V(4); PG8_BAR;
        PG8_STAGE(PG8_SB(1, 0), cB + kstep, voffB); PG8_STAGE(PG8_SA(1, 0), cA + kstep, voffA); PG8_STAGE(PG8_SB(1, 1), cB + hstep + kstep, voffB);
        PG8_WAIT_V(6); PG8_BAR;
    }
    for (;;) {
        const bool has_next = S.next(ui + 1, nxt);
        const char* nA = has_next ? (const char*)g.A + (size_t)nxt.pm * tstep : cA; const char* nB = has_next ? (const char*)g.Bt + (size_t)nxt.pn * tstep : cB;
        for (int t = 0; t < nt; t += 2) {
            const bool last = (t == nt - 2);
            const char* a1 = cA + (size_t)(t + 1) * kstep;
            const char* a2 = last ? nA : cA + (size_t)(t + 2) * kstep; const char* b2 = last ? nB : cB + (size_t)(t + 2) * kstep;
            const char* a3 = a2 + kstep; const char* b3 = b2 + kstep;
            if (last && has_next) S.a_ready(nxt);
            if constexpr (SP2) {
            PG8_LDB(B0, 0, 0); PG8_LDB(B1, 0, 1); PG8_SCHED; PG8_LDA(At, 0, 0); PG8_STAGE(PG8_SA(1, 1), a1 + hstep, voffA);
            PG8_WAIT_V(8); PG8_WAIT_L(0); PG8_BAR; PG8_MMA(0, 0, At, B0); PG8_MMA(0, 1, At, B1); PG8_BAR; PG8_SCHED;
            PG8_LDA(At, 0, 1); PG8_STAGE(PG8_SB(0, 0), b2, voffB); PG8_STAGE(PG8_SB(0, 1), b2 + hstep, voffB); PG8_STAGE(PG8_SA(0, 0), a2, voffA);
            PG8_WAIT_V(8); PG8_WAIT_L(0); PG8_BAR; PG8_MMA(1, 0, At, B0); PG8_MMA(1, 1, At, B1); PG8_BAR; PG8_SCHED;
            PG8_LDB(B0, 1, 0); PG8_LDB(B1, 1, 1); PG8_SCHED; PG8_LDA(At, 1, 0); PG8_STAGE(PG8_SA(0, 1), a2 + hstep, voffA);
            PG8_WAIT_V(8); PG8_WAIT_L(0); PG8_BAR; PG8_MMA(0, 0, At, B0); PG8_MMA(0, 1, At, B1); PG8_BAR; PG8_SCHED;
            PG8_LDA(At, 1, 1); PG8_STAGE(PG8_SB(1, 0), b3, voffB); PG8_STAGE(PG8_SB(1, 1), b3 + hstep, voffB); PG8_STAGE(PG8_SA(1, 0), a3, voffA);
            PG8_WAIT_V(8); PG8_WAIT_L(0); PG8_BAR; PG8_MMA(1, 0, At, B0); PG8_MMA(1, 1, At, B1); PG8_BAR; PG8_SCHED;
            } else {
            PG8_LDB(B0, 0, 0); PG8_SCHED; PG8_LDA(At, 0, 0); PG8_STAGE(PG8_SA(1, 1), a1 + hstep, voffA);
            PG8_WAIT_L(8); PG8_BAR; PG8_WAIT_L(0); PG8_MMA(0, 0, At, B0); PG8_BAR; PG8_SCHED;
            PG8_LDB(B1, 0, 1); PG8_STAGE(PG8_SB(0, 0), b2, voffB);
            PG8_BAR; PG8_WAIT_L(0); PG8_MMA(0, 1, At, B1); PG8_BAR;
            PG8_LDA(At, 0, 1); PG8_STAGE(PG8_SA(0, 0), a2, voffA);
            PG8_BAR; PG8_WAIT_L(0); PG8_MMA(1, 0, At, B0); PG8_BAR; PG8_SCHED;
            PG8_STAGE(PG8_SB(0, 1), b2 + hstep, voffB);
            PG8_WAIT_V(6); PG8_BAR; PG8_MMA(1, 1, At, B1); PG8_BAR;
            PG8_LDB(B0, 1, 0); PG8_SCHED; PG8_LDA(At, 1, 0); PG8_STAGE(PG8_SA(0, 1), a2 + hstep, voffA);
            PG8_WAIT_L(8); PG8_BAR; PG8_WAIT_L(0); PG8_MMA(0, 0, At, B0); PG8_BAR; PG8_SCHED;
            PG8_LDB(B1, 1, 1); PG8_STAGE(PG8_SB(1, 0), b3, voffB);
            PG8_BAR; PG8_WAIT_L(0); PG8_MMA(0, 1, At, B1); PG8_BAR;
            PG8_LDA(At, 1, 1); PG8_STAGE(PG8_SA(1, 0), a3, voffA);
            PG8_BAR; PG8_WAIT_L(0); PG8_MMA(1, 0, At, B0); PG8_BAR; PG8_SCHED;
            PG8_STAGE(PG8_SB(1, 1), b3 + hstep, voffB);
            PG8_WAIT_V(6); PG8_BAR; PG8_MMA(1, 1, At, B1); PG8_BAR;
            }
        }
        if constexpr (ALIGN_EPI) { if (wr == 0) PG8_BAR; }
        if constexpr (!Epi::AFTER_DRAIN) { E(acc, cur, wr, wc, fr, fq); S.done(cur); }
        if (!has_next) break;
#pragma unroll
        for (int a = 0; a < 2; ++a)
#pragma unroll
            for (int b = 0; b < 2; ++b)
#pragma unroll
                for (int m = 0; m < 4; ++m)
#pragma unroll
                    for (int n = 0; n < 2; ++n) acc[a][b][m][n] = (f32x4){0.f, 0.f, 0.f, 0.f};
        cur = nxt; cA = nA; cB = nB; ++ui;
        if constexpr (ALIGN_EPI) { if (wr == 1) PG8_BAR; }
    }
    PG8_WAIT_V(0);
    if constexpr (!ALIGN_EPI) { if (wr == 0) PG8_BAR; }
    PG8_BAR;
    if constexpr (Epi::AFTER_DRAIN) { E.fused(acc, cur, wr, wc, fr, fq, lds, wid, lane); S.done(cur); }
#undef PG8_SA
#undef PG8_SB
#undef PG8_STAGE
#undef PG8_LDA
#undef PG8_LDB
#undef PG8_MMA
#undef PG8_WAIT_V
#undef PG8_WAIT_L
#undef PG8_BAR
#undef PG8_SCHED
}
}

#define GAS __attribute__((address_space(1)))
#define LAS __attribute__((address_space(3)))
typedef unsigned short bf16;
typedef unsigned v4u __attribute__((ext_vector_type(4)));
typedef unsigned v2u __attribute__((ext_vector_type(2)));
typedef float f32x4 __attribute__((ext_vector_type(4)));
typedef float f32x2 __attribute__((ext_vector_type(2)));
typedef float f32x16 __attribute__((ext_vector_type(16)));
typedef short bf16x8 __attribute__((ext_vector_type(8)));
typedef short s16x4 __attribute__((ext_vector_type(4)));
typedef GAS unsigned gu32;
#define RLX_AGENT __ATOMIC_RELAXED, __HIP_MEMORY_SCOPE_AGENT
#define LDS_WAIT() asm volatile("s_waitcnt lgkmcnt(0)" ::: "memory")
#define VM_WAIT() asm volatile("s_waitcnt vmcnt(0)" ::: "memory")
#define SBAR() __builtin_amdgcn_sched_barrier(0)
__device__ __forceinline__ unsigned cvtpk(float lo, float hi) { return pg8::cvt_pk_bf16(lo, hi); }
__device__ __forceinline__ float bflo(unsigned w) { return __uint_as_float(w << 16); }
__device__ __forceinline__ float bfhi(unsigned w) { return __uint_as_float(w & 0xffff0000u); }
__device__ __forceinline__ float bf2f(bf16 v) { return __uint_as_float(((unsigned)v) << 16); }
__device__ __forceinline__ float fast_exp(float x) { return __builtin_amdgcn_exp2f(x * 1.4426950408889634f); }
__device__ __forceinline__ float sigmoidf_(float x) { return __builtin_amdgcn_rcpf(1.0f + fast_exp(-x)); }
__device__ __forceinline__ float siluf_(float x) { return x * sigmoidf_(x); }

#ifndef DBG_SKIP
#define DBG_SKIP 0
#endif
constexpr int NWAVES = 8, NTHREADS = 512;
constexpr int BATCH = 16, SEQ = 2048, DM = 2048, MROWS = BATCH * SEQ;
constexpr int N0 = 7936, NB0 = 62;
constexpr int N1 = 8192, NB1 = 64;
constexpr int K1OUT = 1536;
constexpr float NORM_EPS = 1e-6f;
constexpr float ATT_SCALE = 0.08838834764831845f;
constexpr int CB_RQ = 0, CB_RK = 8, CB_RV = 16, CB_RZ = 24, CB_NQ = 32, CB_KC = 40, CB_VC = 42, CB_KS = 44, CB_VS = 46, CB_KW = 48, CB_VW = 50, CB_NG = 52, CB_NZ = 53;
constexpr int CB_CU = 0, CB_CG = 8, CB_CZ = 16, CB_DQ = 24, CB_DK = 36, CB_DV = 48, CB_DZ = 60;

constexpr size_t MiB = 1u << 20;
constexpr size_t WS_CTL = 0, CTL_ZERO_BYTES = 1 * MiB;
constexpr size_t WS_W0IN = 2 * MiB;
constexpr size_t WS_W0OUT = 34 * MiB;
constexpr size_t WS_W1IN = 42 * MiB;
constexpr size_t WS_W1OUT = 74 * MiB;
constexpr size_t WS_CW = 80 * MiB;
constexpr size_t WS_MISC = 82 * MiB;
constexpr size_t WS_KCMP = 84 * MiB;
constexpr size_t WS_CPR = 86 * MiB;
constexpr size_t WS_A = 96 * MiB;
constexpr size_t WS_MIX = 224 * MiB;
constexpr size_t WS_H = 352 * MiB;
constexpr size_t WS_END = 864 * MiB;
constexpr size_t HBLK = (size_t)MROWS * 128;
constexpr size_t ROPE_OFF = 4096;
#ifndef P0_REP_SKIP
#define P0_REP_SKIP 0
#endif
#ifndef CONV_FIN_IN_UNIT
#define CONV_FIN_IN_UNIT 1
#endif
#ifndef DEFER_P3
#define DEFER_P3 1
#endif
#ifndef DEFER_W1
#define DEFER_W1 0
#endif
#ifndef CT_IN_TAIL
#define CT_IN_TAIL 1
#endif
#ifndef DIL_KG_RES
#define DIL_KG_RES 1
#endif
#ifndef FOLD_P2
#define FOLD_P2 1
#endif
#ifndef FX_FORCE
#define FX_FORCE 0
#endif
#ifndef FX_CONST
#define FX_CONST 0
#endif
#ifndef FX_NSA
#define FX_NSA 1
#endif
#ifndef FX_DIL
#define FX_DIL 1
#endif
constexpr size_t FXB_OFF = 1280 * 1024;
constexpr size_t WS_DPART = WS_A, WS_DLSE = WS_A + 96 * MiB;
constexpr size_t WS_CPR2 = WS_H + (size_t)62 * 8 * MiB;
constexpr int CW_BAR = 4096;
constexpr int CW_Q = 8192;

constexpr int RING_BYTES = 131072;
constexpr int XTRA_OFF = RING_BYTES;
constexpr int LDS_BYTES = 147456;
constexpr int LDSCTL_OFF = LDS_BYTES - 1024;

#define XB_TMO      128
#define XB_XCNT(j)  (256  + 64 * (j))
#define XB_XSUB(j)  (1280 + 64 * (j))
#define XB_XGEN(j)  (2304 + 64 * (j))
#define XB_TOP      3328
#define XB_TOPGEN   3392
#define XCD_BAR_WORDS 3456
#define XB_SPIN_CAP (1u << 18)

__device__ __forceinline__ unsigned xb_ld(unsigned* p)              { return __hip_atomic_load(p, __ATOMIC_RELAXED, __HIP_MEMORY_SCOPE_AGENT); }
__device__ __forceinline__ unsigned xb_add(unsigned* p, unsigned v) { return __hip_atomic_fetch_add(p, v, __ATOMIC_RELAXED, __HIP_MEMORY_SCOPE_AGENT); }
__device__ __forceinline__ unsigned xb_xcc_id() { return (unsigned)__builtin_amdgcn_s_getreg((3 << 11) | 20) & 0xFu; }
#define XB_SPIN(cond, bar) do { unsigned _sp = 0; while (cond) { __builtin_amdgcn_s_sleep(1); \
    if ((++_sp & 255u) == 0u) { if (xb_ld(&(bar)[XB_TMO])) break; if (_sp > XB_SPIN_CAP) { atomicAdd(&(bar)[XB_TMO], 1u); break; } } } } while (0)

struct XcdBarrier {
    unsigned* bar; unsigned x;
    volatile LAS unsigned* st;
};

__device__ __forceinline__ XcdBarrier xcd_barrier_post(unsigned* bar, volatile LAS unsigned* st) {
    XcdBarrier b; b.bar = bar; b.x = xb_xcc_id(); b.st = st;
    if (threadIdx.x == 0) (void)xb_add(&bar[XB_XCNT(b.x)], 1u);
    return b;
}
__device__ __forceinline__ void xcd_barrier_complete(unsigned* bar, unsigned x, unsigned& nloc, unsigned& nx) {
    const unsigned G = gridDim.x * gridDim.y * gridDim.z;
    unsigned sum, cnt, mine, sp = 0u;
    for (;;) {
        sum = 0u; cnt = 0u; mine = 0u;
#pragma unroll
        for (unsigned j = 0; j < 16; ++j) { const unsigned c = xb_ld(&bar[XB_XCNT(j)]); sum += c; cnt += (c > 0u) ? 1u : 0u; mine = (j == x) ? c : mine; }
        if (sum == G) break;
        __builtin_amdgcn_s_sleep(1);
        if ((++sp & 255u) == 0u) { if (xb_ld(&bar[XB_TMO])) break; if (sp > XB_SPIN_CAP) { atomicAdd(&bar[XB_TMO], 1u); break; } }
    }
    nloc = mine > 0u ? mine : 1u; nx = cnt > 0u ? cnt : 1u;
}

__device__ __forceinline__ void xcd_barrier(const XcdBarrier& b) {
    asm volatile("s_waitcnt vmcnt(0)" ::: "memory");
    __syncthreads();
    if (threadIdx.x == 0) {
        unsigned* bar = b.bar;
        __builtin_amdgcn_s_waitcnt(0);
        unsigned nloc = b.st[0], nx = b.st[1];
        if (nloc == 0u) { xcd_barrier_complete(bar, b.x, nloc, nx); b.st[0] = nloc; b.st[1] = nx; }
        const unsigned old = xb_add(&bar[XB_XSUB(b.x)], 1u);
        const unsigned gen = old / nloc;
        if (old + 1u == (gen + 1u) * nloc) {
            __builtin_amdgcn_fence(__ATOMIC_RELEASE, "agent");
            asm volatile("s_waitcnt vmcnt(0)" ::: "memory");
            const unsigned og = xb_add(&bar[XB_TOP], 1u);
            const unsigned tg = og / nx;
            if (og + 1u == (tg + 1u) * nx) xb_add(&bar[XB_TOPGEN], 1u);
            else XB_SPIN(xb_ld(&bar[XB_TOPGEN]) == tg, bar);
            __builtin_amdgcn_fence(__ATOMIC_ACQUIRE, "agent");
            xb_add(&bar[XB_XGEN(b.x)], 1u);
            asm volatile("s_waitcnt vmcnt(0)" ::: "memory");
        } else {
            XB_SPIN(xb_ld(&bar[XB_XGEN(b.x)]) == gen, bar);
            __builtin_amdgcn_fence(__ATOMIC_ACQUIRE, "agent");
            asm volatile("s_waitcnt vmcnt(0)" ::: "memory");
        }
    }
    __syncthreads();
}


struct Frame {
    LAS unsigned char* lds;
    volatile LAS unsigned* MISC;
    gu32* ctl;
    int tid, lane, wave, G;
    unsigned char* ws;
    const float* in[22];
    float* out;
};
__device__ __forceinline__ float wave_sum(float v) {
#pragma unroll
    for (int o = 1; o < 64; o <<= 1) v += __shfl_xor(v, o);
    return v;
}
__device__ __forceinline__ int wq_first(Frame& F, int q) {
    __syncthreads();
    if (F.tid == 0) F.MISC[16] = __hip_atomic_fetch_add(F.ctl + CW_Q + 64 * q, 1u, RLX_AGENT);
    __syncthreads();
    return (int)F.MISC[16];
}
__device__ __forceinline__ unsigned wq_issue(Frame& F, int q) {
    unsigned r = 0u;
    if (F.tid == 0) r = __hip_atomic_fetch_add(F.ctl + CW_Q + 64 * q, 1u, RLX_AGENT);
    return r;
}
__device__ __forceinline__ int wq_take(Frame& F, unsigned r) {
    __syncthreads();
    if (F.tid == 0) F.MISC[16] = r;
    __syncthreads();
    return (int)F.MISC[16];
}
__device__ __forceinline__ bf16* hblk(Frame& F, int cb) { return (bf16*)(F.ws + WS_H) + (size_t)cb * HBLK; }

namespace att {
constexpr int SHM = 16384;
constexpr int OFF_V = 0, OFF_K = 2 * SHM, OFF_WS = 4 * SHM, OFF_KG = 4 * SHM + 8192 + 24576;
constexpr float THR = 8.f;
#define KSWZ(row, colB) ((row) * 256 + ((colB) ^ (((row) & 7) << 4)))
__device__ __forceinline__ int v_st(int k, int c) { const int kk = (k & ~0xC) | ((k & 4) << 1) | ((k & 8) >> 1); return ((kk >> 3) * 4 + (c >> 5)) * 512 + ((kk & 7) * 32 + (c & 31)) * 2; }
__device__ __forceinline__ int v_rd_base(int lane) { return ((lane & 3) << 3) | (((lane >> 2) & 3) << 6) | (((lane >> 4) & 1) << 5) | (((lane >> 5) & 1) << 8); }
constexpr int v_rd_off(int d0, int ks, int half) { return d0 * 512 + ks * 4096 + half * 2048; }
__device__ __forceinline__ int crow(int r, int hi) { return (r & 3) + 8 * (r >> 2) + 4 * hi; }
__device__ __forceinline__ float xhi_f(float v, int hi) { auto rr = __builtin_amdgcn_permlane32_swap(__float_as_uint(v), __float_as_uint(v), false, false); return __uint_as_float(hi ? rr[0] : rr[1]); }
__device__ __forceinline__ unsigned xhi_u(unsigned v, int hi) { auto rr = __builtin_amdgcn_permlane32_swap(v, v, false, false); return hi ? rr[0] : rr[1]; }
__device__ __forceinline__ void mask_tile(f32x16& p0, f32x16& p1, int dq, unsigned W) {
    const float NEG = -__builtin_inff();
#pragma unroll
    for (int r = 0; r < 16; ++r) {
        const int c = (r & 3) + 8 * (r >> 2);
        if ((unsigned)(dq - c) >= W) p0[r] = NEG;
        if ((unsigned)(dq - c - 32) >= W) p1[r] = NEG;
    }
}
__device__ __forceinline__ void partialSM(f32x16& p0, f32x16& p1, float& m_reg, float& mn, float& alpha) {
    float pmax = p0[0];
#pragma unroll
    for (int r = 1; r < 16; ++r) pmax = fmaxf(pmax, p0[r]);
#pragma unroll
    for (int r = 0; r < 16; ++r) pmax = fmaxf(pmax, p1[r]);
    { auto rr = __builtin_amdgcn_permlane32_swap(__float_as_uint(pmax), __float_as_uint(pmax), false, false);
      pmax = fmaxf(__uint_as_float(rr[0]), __uint_as_float(rr[1])); }
    constexpr float C2 = 1.4426950408889634f * ATT_SCALE;
    if (__builtin_expect(__all((pmax - m_reg) * ATT_SCALE <= THR), 1)) { mn = m_reg; alpha = 1.f; }
    else { mn = fmaxf(m_reg, pmax); alpha = __builtin_amdgcn_exp2f((m_reg - mn) * C2); m_reg = mn; }
    const float mnL = -mn * C2;
#pragma unroll
    for (int r = 0; r < 16; ++r) p0[r] = fmaf(p0[r], C2, mnL);
#pragma unroll
    for (int r = 0; r < 16; ++r) p1[r] = fmaf(p1[r], C2, mnL);
#pragma unroll
    for (int r = 0; r < 16; ++r) p0[r] = __builtin_amdgcn_exp2f(p0[r]);
}
#define ATT_PK4(P, B_, OUT) do { unsigned a0 = cvtpk(P[B_+0], P[B_+1]), a1 = cvtpk(P[B_+2], P[B_+3]);                          \
        unsigned b0 = cvtpk(P[B_+4], P[B_+5]), b1 = cvtpk(P[B_+6], P[B_+7]);                                             \
        auto r0 = __builtin_amdgcn_permlane32_swap(a0, b0, false, false); auto r1 = __builtin_amdgcn_permlane32_swap(a1, b1, false, false); \
        v4u w = {r0[0], r1[0], r0[1], r1[1]}; OUT = *reinterpret_cast<bf16x8*>(&w); } while (0)
__device__ __forceinline__ void pack_p(const f32x16& p0, const f32x16& p1, bf16x8& pa0, bf16x8& pa1, bf16x8& pa2, bf16x8& pa3) {
    ATT_PK4(p0, 0, pa0); ATT_PK4(p0, 8, pa1); ATT_PK4(p1, 0, pa2); ATT_PK4(p1, 8, pa3);
}
__device__ __forceinline__ void finishSM(f32x16& p0, f32x16& p1, float alpha, float& l_reg, bf16x8& pa0, bf16x8& pa1, bf16x8& pa2, bf16x8& pa3) {
#pragma unroll
    for (int r = 0; r < 16; ++r) p1[r] = __builtin_amdgcn_exp2f(p1[r]);
    float ps = 0;
#pragma unroll
    for (int r = 0; r < 16; ++r) ps += p0[r];
#pragma unroll
    for (int r = 0; r < 16; ++r) ps += p1[r];
    { auto rr = __builtin_amdgcn_permlane32_swap(__float_as_uint(ps), __float_as_uint(ps), false, false);
      ps = __uint_as_float(rr[0]) + __uint_as_float(rr[1]); }
    l_reg = l_reg * alpha + ps;
    pack_p(p0, p1, pa0, pa1, pa2, pa3);
}
template <int KB>
__device__ __forceinline__ void qkt(f32x16& p0, f32x16& p1, const LAS char* lds, int r32, int hi, const bf16x8 (&qr)[8]) {
    p0 = f32x16{}; p1 = f32x16{};
    const LAS char* kb[4];
#pragma unroll
    for (int dd = 0; dd < 4; ++dd) kb[dd] = lds + OFF_K + KB * SHM + KSWZ(r32, (dd * 16 + hi * 8) * 2);
    bf16x8 f[2][4];
#define QK_LD(g, s) do { const LAS char* a0_ = kb[(2 * (g)) & 3] + ((2 * (g)) >> 2) * 128; const LAS char* a1_ = kb[(2 * (g) + 1) & 3] + ((2 * (g) + 1) >> 2) * 128; \
        f[s][0] = *reinterpret_cast<const LAS bf16x8*>(a0_); f[s][1] = *reinterpret_cast<const LAS bf16x8*>(a0_ + 32 * 256); \
        f[s][2] = *reinterpret_cast<const LAS bf16x8*>(a1_); f[s][3] = *reinterpret_cast<const LAS bf16x8*>(a1_ + 32 * 256); } while (0)
#define QK_MM(g, s) do { p0 = __builtin_amdgcn_mfma_f32_32x32x16_bf16(f[s][0], qr[2 * (g)], p0, 0, 0, 0); p1 = __builtin_amdgcn_mfma_f32_32x32x16_bf16(f[s][1], qr[2 * (g)], p1, 0, 0, 0); \
        p0 = __builtin_amdgcn_mfma_f32_32x32x16_bf16(f[s][2], qr[2 * (g) + 1], p0, 0, 0, 0); p1 = __builtin_amdgcn_mfma_f32_32x32x16_bf16(f[s][3], qr[2 * (g) + 1], p1, 0, 0, 0); } while (0)
    QK_LD(0, 0); SBAR();
    QK_LD(1, 1); SBAR(); QK_MM(0, 0); SBAR();
    QK_LD(2, 0); SBAR(); QK_MM(1, 1); SBAR();
    QK_LD(3, 1); SBAR(); QK_MM(2, 0); SBAR();
    QK_MM(3, 1); SBAR();
#undef QK_LD
#undef QK_MM
}
template <int VB>
__device__ __forceinline__ void pv_tile(f32x16 (&o)[4], int vb0, bf16x8 pa0, bf16x8 pa1, bf16x8 pa2, bf16x8 pa3) {
#define TRRD(dst, off) asm volatile("ds_read_b64_tr_b16 %0, %1 offset:%2" : "=&v"(dst) : "v"(vb0), "i"(off) : "memory")
#define PV_D0(d0) do { s16x4 l0, l1, l2, l3, h0, h1, h2, h3; constexpr int b_ = VB * SHM + v_rd_off(d0, 0, 0); \
        TRRD(l0, b_); TRRD(h0, b_ + 2048); TRRD(l1, b_ + 4096); TRRD(h1, b_ + 6144); TRRD(l2, b_ + 8192); TRRD(h2, b_ + 10240); TRRD(l3, b_ + 12288); TRRD(h3, b_ + 14336); \
        asm volatile("s_waitcnt lgkmcnt(0)" ::: "memory"); SBAR();   \
        o[d0] = __builtin_amdgcn_mfma_f32_32x32x16_bf16(pa0, (bf16x8){l0[0], l0[1], l0[2], l0[3], h0[0], h0[1], h0[2], h0[3]}, o[d0], 0, 0, 0);   \
        o[d0] = __builtin_amdgcn_mfma_f32_32x32x16_bf16(pa1, (bf16x8){l1[0], l1[1], l1[2], l1[3], h1[0], h1[1], h1[2], h1[3]}, o[d0], 0, 0, 0);   \
        o[d0] = __builtin_amdgcn_mfma_f32_32x32x16_bf16(pa2, (bf16x8){l2[0], l2[1], l2[2], l2[3], h2[0], h2[1], h2[2], h2[3]}, o[d0], 0, 0, 0);   \
        o[d0] = __builtin_amdgcn_mfma_f32_32x32x16_bf16(pa3, (bf16x8){l3[0], l3[1], l3[2], l3[3], h3[0], h3[1], h3[2], h3[3]}, o[d0], 0, 0, 0); } while (0)
    PV_D0(0); PV_D0(1); PV_D0(2); PV_D0(3);
#undef PV_D0
#undef TRRD
}
__device__ __forceinline__ void row_bcast(float v, LAS float* wsf, int r32, int hi, float (&f)[16]) {
    asm volatile("" ::: "memory");
    if (hi == 0) wsf[r32] = v;
    asm volatile("s_waitcnt lgkmcnt(0)" ::: "memory");
#pragma unroll
    for (int r = 0; r < 16; ++r) f[r] = wsf[crow(r, hi)];
    asm volatile("s_waitcnt lgkmcnt(0)" ::: "memory");
}
template <int N> __device__ __forceinline__ float dpp_ror(float v) { return __builtin_bit_cast(float, __builtin_amdgcn_update_dpp(0, __builtin_bit_cast(int, v), 0x120 + N, 0xf, 0xf, false)); }
__device__ __forceinline__ float row16_sum(float v) { v += dpp_ror<8>(v); v += dpp_ror<4>(v); v += dpp_ror<2>(v); v += dpp_ror<1>(v); return v; }
__device__ __forceinline__ void norm_row8(bf16x8& k, const LAS float* g8) {
    v4u w = *reinterpret_cast<v4u*>(&k);
    float x[8] = {bflo(w.x), bfhi(w.x), bflo(w.y), bfhi(w.y), bflo(w.z), bfhi(w.z), bflo(w.w), bfhi(w.w)};
    float ss = 0.f;
#pragma unroll
    for (int e = 0; e < 8; ++e) ss += x[e] * x[e];
    ss = row16_sum(ss);
    const float rstd = __builtin_amdgcn_rsqf(ss * (1.f / 128.f) + NORM_EPS);
    const f32x4 g0 = *(const LAS f32x4*)g8, g1 = *(const LAS f32x4*)(g8 + 4);
    w.x = cvtpk(x[0] * rstd * g0.x, x[1] * rstd * g0.y); w.y = cvtpk(x[2] * rstd * g0.z, x[3] * rstd * g0.w);
    w.z = cvtpk(x[4] * rstd * g1.x, x[5] * rstd * g1.y); w.w = cvtpk(x[6] * rstd * g1.z, x[7] * rstd * g1.w);
    k = *reinterpret_cast<bf16x8*>(&w);
}
__device__ __forceinline__ void norm_q(bf16x8 (&qr)[8], const float* g, int hi) {
    float ss = 0.f;
#pragma unroll
    for (int d0 = 0; d0 < 8; ++d0) { const v4u w = *reinterpret_cast<const v4u*>(&qr[d0]);
        const float a0 = bflo(w.x), a1 = bfhi(w.x), a2 = bflo(w.y), a3 = bfhi(w.y), a4 = bflo(w.z), a5 = bfhi(w.z), a6 = bflo(w.w), a7 = bfhi(w.w);
        ss += (a0 * a0 + a1 * a1) + (a2 * a2 + a3 * a3) + (a4 * a4 + a5 * a5) + (a6 * a6 + a7 * a7); }
    ss += xhi_f(ss, hi);
    const float rstd = __builtin_amdgcn_rsqf(ss * (1.f / 128.f) + NORM_EPS);
#pragma unroll
    for (int d0 = 0; d0 < 8; ++d0) { v4u w = *reinterpret_cast<v4u*>(&qr[d0]);
        const f32x4 g0 = *(const f32x4*)(g + d0 * 16 + hi * 8), g1 = *(const f32x4*)(g + d0 * 16 + hi * 8 + 4);
        w.x = cvtpk(bflo(w.x) * rstd * g0.x, bfhi(w.x) * rstd * g0.y); w.y = cvtpk(bflo(w.y) * rstd * g0.z, bfhi(w.y) * rstd * g0.w);
        w.z = cvtpk(bflo(w.z) * rstd * g1.x, bfhi(w.z) * rstd * g1.y); w.w = cvtpk(bflo(w.w) * rstd * g1.z, bfhi(w.w) * rstd * g1.w);
        qr[d0] = *reinterpret_cast<bf16x8*>(&w); }
}
__device__ __forceinline__ void settle_q(bf16x8 (&qr)[8]) {
#pragma unroll
    for (int d0 = 0; d0 < 8; ++d0) { v4u w = *reinterpret_cast<v4u*>(&qr[d0]);
        asm volatile("v_mov_b32 %0, %0\n\tv_mov_b32 %1, %1\n\tv_mov_b32 %2, %2\n\tv_mov_b32 %3, %3" : "+v"(w.x), "+v"(w.y), "+v"(w.z), "+v"(w.w));
        qr[d0] = *reinterpret_cast<bf16x8*>(&w); }
}
struct Stage { bf16x8 k0, k1, v0, v1; };
template <class Pol, class TI>
__device__ __forceinline__ void stage_load(const Pol& P, const TI& ti, Stage& S, int sr, int sc) {
    S.k0 = *reinterpret_cast<const bf16x8*>(P.krow(ti, sr) + sc); S.k1 = *reinterpret_cast<const bf16x8*>(P.krow(ti, 32 + sr) + sc);
    S.v0 = *reinterpret_cast<const bf16x8*>(P.vrow(ti, sr) + sc); S.v1 = *reinterpret_cast<const bf16x8*>(P.vrow(ti, 32 + sr) + sc);
}
__device__ __forceinline__ void stage_write(LAS char* lds, int buf, const Stage& S, int kws, int vst0, int vst1) {
    *(LAS bf16x8*)(lds + OFF_K + buf * SHM + kws) = S.k0; *(LAS bf16x8*)(lds + OFF_K + buf * SHM + kws + 32 * 256) = S.k1;
    *(LAS bf16x8*)(lds + OFF_V + buf * SHM + vst0) = S.v0; *(LAS bf16x8*)(lds + OFF_V + buf * SHM + vst1) = S.v1;
}
template <int BUF, int VAR, class Pol, class TI>
__device__ __forceinline__ void tile_compute(const Pol& P, const TI& ti, LAS char* lds, int vb0, LAS float* wsf, int wid, int r32, int hi,
                                             const bf16x8 (&qr)[8], f32x16 (&o)[4], float& m_reg, float& l_reg) {
    f32x16 p0, p1; bf16x8 pa0, pa1, pa2, pa3;
    if (VAR & 1) { p0 = f32x16{}; p1 = f32x16{}; p0[0] = (float)r32; } else qkt<BUF>(p0, p1, lds, r32, hi, qr);
    if constexpr (Pol::SOFTMAX) {
        P.mask(p0, p1, ti, wid, r32, hi);
        float mn, alpha;
        partialSM(p0, p1, m_reg, mn, alpha);
        if (__any(alpha < 1.f)) {
            float f[16]; row_bcast(alpha, wsf, r32, hi, f);
#pragma unroll
            for (int d = 0; d < 4; ++d)
#pragma unroll
                for (int r = 0; r < 16; ++r) o[d][r] *= f[r];
        }
        finishSM(p0, p1, alpha, l_reg, pa0, pa1, pa2, pa3);
    } else {
        P.weights(p0, p1, ti, wid, r32, hi);
        pack_p(p0, p1, pa0, pa1, pa2, pa3);
    }
    SBAR();
    if (VAR & 2) { o[0][0] += __builtin_bit_cast(float, (int)pa0[0]) + __builtin_bit_cast(float, (int)pa1[0]) + __builtin_bit_cast(float, (int)pa2[0]) + __builtin_bit_cast(float, (int)pa3[0]); } else pv_tile<BUF>(o, vb0, pa0, pa1, pa2, pa3);
}
template <class Pol>
__device__ __forceinline__ void stage_prefetch(const Pol& P, Stage& S0, Stage& S1, int tid) {
    const int sr = tid >> 4, sc = (tid & 15) * 8;
    { const auto ti = P.tile(0); stage_load(P, ti, S0, sr, sc); }
    if (P.ntiles() > 1) { const auto t1 = P.tile(1); stage_load(P, t1, S1, sr, sc); }
}
template <class Pol, int VAR, bool PRE>
__device__ __forceinline__ void att_pass_core(const Pol& P, LAS char* lds, const bf16x8 (&qr)[8], f32x16 (&o)[4], float& m_reg, float& l_reg, int tid, Stage& S0, Stage& S1) {
    const int wid = __builtin_amdgcn_readfirstlane(tid >> 6), lane = tid & 63, r32 = lane & 31, hi = lane >> 5;
    const int sr = tid >> 4, sc = (tid & 15) * 8;
    const int kws = KSWZ(sr, sc * 2), vst0 = v_st(sr, sc), vst1 = v_st(32 + sr, sc);
    const int vb0 = (int)(unsigned)(uintptr_t)(lds + OFF_V) + v_rd_base(lane);
    LAS float* wsf = (LAS float*)(lds + OFF_WS) + wid * 256;
    const int NT = P.ntiles();
    const LAS float* kg = (const LAS float*)(lds + OFF_KG) + sc;
    if constexpr (Pol::KNORM) { int tk = tid; asm volatile("" : "+v"(tk)); if (tk < 128) ((LAS float*)(lds + OFF_KG))[tk] = P.kgain[tk]; }
    { if constexpr (!PRE) { const auto ti = P.tile(0); stage_load(P, ti, S0, sr, sc);
      if (NT > 1) { const auto t1 = P.tile(1); stage_load(P, t1, S1, sr, sc); } }
      if constexpr (Pol::KNORM) { __syncthreads(); norm_row8(S0.k0, kg); norm_row8(S0.k1, kg); }
      stage_write(lds, 0, S0, kws, vst0, vst1);
      if (NT > 2) { const auto t2 = P.tile(2); stage_load(P, t2, S0, sr, sc); } }
    __syncthreads();
    for (int t = 0; t < NT; t += 2) {
        { const auto ti = P.tile(t);
          SBAR();
          if (P.active(ti, wid)) tile_compute<0, VAR>(P, ti, lds, vb0, wsf, wid, r32, hi, qr, o, m_reg, l_reg);
          SBAR();
          if (t + 1 < NT) { if constexpr (Pol::KNORM) { norm_row8(S1.k0, kg); norm_row8(S1.k1, kg); } if (!(VAR & 8)) stage_write(lds, 1, S1, kws, vst0, vst1);
              if (!(VAR & 4) && t + 3 < NT) { const auto tn = P.tile(t + 3); stage_load(P, tn, S1, sr, sc); } }
          if (!(VAR & 16)) __syncthreads(); }
        if (t + 1 >= NT) break;
        { const auto ti = P.tile(t + 1);
          SBAR();
          if (P.active(ti, wid)) tile_compute<1, VAR>(P, ti, lds, vb0, wsf, wid, r32, hi, qr, o, m_reg, l_reg);
          SBAR();
          if (t + 2 < NT) { if constexpr (Pol::KNORM) { norm_row8(S0.k0, kg); norm_row8(S0.k1, kg); } if (!(VAR & 8)) stage_write(lds, 0, S0, kws, vst0, vst1);
              if (!(VAR & 4) && t + 4 < NT) { const auto tn = P.tile(t + 4); stage_load(P, tn, S0, sr, sc); } }
          if (!(VAR & 16)) __syncthreads(); }
    }
}
template <class Pol, int VAR = 0>
__device__ __forceinline__ void att_pass(const Pol& P, LAS char* lds, const bf16x8 (&qr)[8], f32x16 (&o)[4], float& m_reg, float& l_reg, int tid) {
    Stage S0, S1; att_pass_core<Pol, VAR, false>(P, lds, qr, o, m_reg, l_reg, tid, S0, S1);
}
template <class Pol, int VAR = 0>
__device__ __forceinline__ void att_pass_pre(const Pol& P, LAS char* lds, const bf16x8 (&qr)[8], f32x16 (&o)[4], float& m_reg, float& l_reg, int tid, Stage& S0, Stage& S1) {
    att_pass_core<Pol, VAR, true>(P, lds, qr, o, m_reg, l_reg, tid, S0, S1);
}
#ifndef ATT2_KDEPTH
#define ATT2_KDEPTH 1
#endif
template <int KB>
__device__ __forceinline__ void qkt_asm(f32x16& p0, f32x16& p1, const int (&ka)[4], const bf16x8 (&qr)[8]) {
    p0 = f32x16{}; p1 = f32x16{};
    bf16x8 f[2][4];
#define QA_RD(dst, dd, off) asm volatile("ds_read_b128 %0, %1 offset:%2" : "=&v"(dst) : "v"(ka[dd]), "i"(off) : "memory")
#define QA_LD(g, s) do { QA_RD(f[s][0], (2 * (g)) & 3, KB * SHM + ((2 * (g)) >> 2) * 128); QA_RD(f[s][1], (2 * (g)) & 3, KB * SHM + ((2 * (g)) >> 2) * 128 + 8192); \
        QA_RD(f[s][2], (2 * (g) + 1) & 3, KB * SHM + ((2 * (g) + 1) >> 2) * 128); QA_RD(f[s][3], (2 * (g) + 1) & 3, KB * SHM + ((2 * (g) + 1) >> 2) * 128 + 8192); } while (0)
#define QA_MM(g, s) do { p0 = __builtin_amdgcn_mfma_f32_32x32x16_bf16(f[s][0], qr[2 * (g)], p0, 0, 0, 0); p1 = __builtin_amdgcn_mfma_f32_32x32x16_bf16(f[s][1], qr[2 * (g)], p1, 0, 0, 0); \
        p0 = __builtin_amdgcn_mfma_f32_32x32x16_bf16(f[s][2], qr[2 * (g) + 1], p0, 0, 0, 0); p1 = __builtin_amdgcn_mfma_f32_32x32x16_bf16(f[s][3], qr[2 * (g) + 1], p1, 0, 0, 0); } while (0)
#define QA_W(n) asm volatile("s_waitcnt lgkmcnt(" #n ")" ::: "memory")
#if ATT2_KDEPTH == 2
    QA_LD(0, 0); QA_LD(1, 1); QA_W(4); SBAR(); QA_MM(0, 0); SBAR();
    QA_LD(2, 0); QA_W(4); SBAR(); QA_MM(1, 1); SBAR();
    QA_LD(3, 1); QA_W(4); SBAR(); QA_MM(2, 0); SBAR();
    QA_W(0); SBAR(); QA_MM(3, 1); SBAR();
#else
    QA_LD(0, 0); QA_W(0); SBAR(); QA_MM(0, 0); SBAR();
    QA_LD(1, 0); QA_W(0); SBAR(); QA_MM(1, 0); SBAR();
    QA_LD(2, 0); QA_W(0); SBAR(); QA_MM(2, 0); SBAR();
    QA_LD(3, 0); QA_W(0); SBAR(); QA_MM(3, 0); SBAR();
#endif
#undef QA_RD
#undef QA_LD
#undef QA_MM
#undef QA_W
}
template <int BUF, class Pol, class TI>
__device__ __forceinline__ void tile_x(const Pol& P, const TI& ti, const int (&ka)[4], int wid, int r32, int hi, const bf16x8 (&qr)[8], f32x16& p0, f32x16& p1, float& m_reg, float& alpha) {
    qkt_asm<BUF>(p0, p1, ka, qr);
    P.mask(p0, p1, ti, wid, r32, hi);
    float mn; partialSM(p0, p1, m_reg, mn, alpha);
}
template <int BUF>
__device__ __forceinline__ void tile_y(int vb0, LAS float* wsf, int r32, int hi, f32x16 (&o)[4], f32x16& p0, f32x16& p1, float alpha, float& l_reg) {
    if (__any(alpha < 1.f)) {
        float f[16]; row_bcast(alpha, wsf, r32, hi, f);
#pragma unroll
        for (int d = 0; d < 4; ++d)
#pragma unroll
            for (int r = 0; r < 16; ++r) o[d][r] *= f[r];
    }
    bf16x8 pa0, pa1, pa2, pa3;
    finishSM(p0, p1, alpha, l_reg, pa0, pa1, pa2, pa3);
    SBAR();
    pv_tile<BUF>(o, vb0, pa0, pa1, pa2, pa3);
}
template <class Pol>
__device__ __forceinline__ void att_pass2(const Pol& P, LAS char* lds, const bf16x8 (&qr)[8], f32x16 (&o)[4], float& m_reg, float& l_reg, int tid) {
    const int wid = __builtin_amdgcn_readfirstlane(tid >> 6), lane = tid & 63, r32 = lane & 31, hi = lane >> 5;
    const int sr = tid >> 4, sc = (tid & 15) * 8;
    int ka[4];
#pragma unroll
    for (int dd = 0; dd < 4; ++dd) ka[dd] = (int)(unsigned)(uintptr_t)(lds + OFF_K) + KSWZ(r32, (dd * 16 + hi * 8) * 2);
    const int kws = KSWZ(sr, sc * 2), vst0 = v_st(sr, sc), vst1 = v_st(32 + sr, sc);
    const int vb0 = (int)(unsigned)(uintptr_t)(lds + OFF_V) + v_rd_base(lane);
    LAS float* wsf = (LAS float*)(lds + OFF_WS) + wid * 256;
    const bool grpB = wid >= 4;
    const int NT = P.ntiles();
    Stage S;
    const LAS float* kg = (const LAS float*)(lds + OFF_KG) + sc;
    if constexpr (Pol::KNORM) { int tk = tid; asm volatile("" : "+v"(tk)); if (tk < 128) ((LAS float*)(lds + OFF_KG))[tk] = P.kgain[tk]; }
    { const auto ti = P.tile(0); stage_load(P, ti, S, sr, sc);
      if constexpr (Pol::KNORM) { __syncthreads(); norm_row8(S.k0, kg); norm_row8(S.k1, kg); }
      stage_write(lds, 0, S, kws, vst0, vst1);
      if (NT > 1) { const auto t1 = P.tile(1); stage_load(P, t1, S, sr, sc); } }
    __syncthreads();
#define ATT2_STAGE(s_, WB) do { \
        if ((s_) + 1 < NT) { if constexpr (Pol::KNORM) { norm_row8(S.k0, kg); norm_row8(S.k1, kg); } stage_write(lds, WB, S, kws, vst0, vst1); \
            if ((s_) + 2 < NT) { const auto tn = P.tile((s_) + 2); stage_load(P, tn, S, sr, sc); } } } while (0)
#define ATT2_BODY(s_, B_, WB) do { const auto ti = P.tile(s_); f32x16 p0, p1; float alpha = 1.f; const bool act = P.active(ti, wid); \
        if (grpB) ATT2_STAGE(s_, WB); \
        SBAR(); if (act) tile_x<B_>(P, ti, ka, wid, r32, hi, qr, p0, p1, m_reg, alpha); SBAR(); \
        __syncthreads(); \
        SBAR(); if (act) tile_y<B_>(vb0, wsf, r32, hi, o, p0, p1, alpha, l_reg); SBAR(); \
        if (!grpB) ATT2_STAGE(s_, WB); \
        __syncthreads(); } while (0)
    if (grpB) __syncthreads();
    for (int s = 0; s < NT; s += 2) { ATT2_BODY(s, 0, 1); if (s + 1 >= NT) break; ATT2_BODY(s + 1, 1, 0); }
    if (!grpB) __syncthreads();
#undef ATT2_BODY
#undef ATT2_STAGE
}
__device__ __forceinline__ void fx_softmax(f32x16& p0, f32x16& p1, float shiftC2, bf16x8& pa0, bf16x8& pa1, bf16x8& pa2, bf16x8& pa3) {
    constexpr float C2 = 1.4426950408889634f * ATT_SCALE;
#pragma unroll
    for (int r = 0; r < 16; ++r) { p0[r] = __builtin_amdgcn_exp2f(fmaf(p0[r], C2, -shiftC2)); p1[r] = __builtin_amdgcn_exp2f(fmaf(p1[r], C2, -shiftC2)); }
    pack_p(p0, p1, pa0, pa1, pa2, pa3);
}
__device__ __forceinline__ float gain_maxabs(const float* g, int lane) {
    float v = fmaxf(fabsf(g[lane]), fabsf(g[lane + 64]));
#pragma unroll
    for (int off = 1; off < 64; off <<= 1) v = fmaxf(v, __shfl_xor(v, off));
    return __builtin_bit_cast(float, __builtin_amdgcn_readfirstlane(__builtin_bit_cast(int, v)));
}
constexpr float FX_BOUND = 11.313708499f * 1.01f;
constexpr float FX_MAX = 40.f, LOG2E = 1.4426950408889634f;
__device__ __forceinline__ void fx_rowsum(f32x16& lacc, bf16x8 pa0, bf16x8 pa1, bf16x8 pa2, bf16x8 pa3) {
    const bf16x8 ones = (bf16x8){0x3F80, 0x3F80, 0x3F80, 0x3F80, 0x3F80, 0x3F80, 0x3F80, 0x3F80};
    lacc = __builtin_amdgcn_mfma_f32_32x32x16_bf16(pa0, ones, lacc, 0, 0, 0); lacc = __builtin_amdgcn_mfma_f32_32x32x16_bf16(pa1, ones, lacc, 0, 0, 0);
    lacc = __builtin_amdgcn_mfma_f32_32x32x16_bf16(pa2, ones, lacc, 0, 0, 0); lacc = __builtin_amdgcn_mfma_f32_32x32x16_bf16(pa3, ones, lacc, 0, 0, 0);
}
template <int BUF, class Pol, class TI>
__device__ __forceinline__ void tile_compute_fx(const Pol& P, const TI& ti, LAS char* lds, int vb0, int wid, int r32, int hi, const bf16x8 (&qr)[8], f32x16 (&o)[4], f32x16& lacc, float shiftC2) {
    f32x16 p0, p1; bf16x8 pa0, pa1, pa2, pa3;
    qkt<BUF>(p0, p1, lds, r32, hi, qr);
    P.mask(p0, p1, ti, wid, r32, hi);
    fx_softmax(p0, p1, shiftC2, pa0, pa1, pa2, pa3);
    SBAR();
    fx_rowsum(lacc, pa0, pa1, pa2, pa3);
    pv_tile<BUF>(o, vb0, pa0, pa1, pa2, pa3);
}
template <class Pol, bool PRE, bool KGRES = false>
__device__ __forceinline__ void att_pass_fx_core(const Pol& P, LAS char* lds, const bf16x8 (&qr)[8], f32x16 (&o)[4], f32x16& lacc, float shiftC2, int tid, Stage& S0, Stage& S1) {
    const int wid = __builtin_amdgcn_readfirstlane(tid >> 6), lane = tid & 63, r32 = lane & 31, hi = lane >> 5;
    const int sr = tid >> 4, sc = (tid & 15) * 8;
    const int kws = KSWZ(sr, sc * 2), vst0 = v_st(sr, sc), vst1 = v_st(32 + sr, sc);
    const int vb0 = (int)(unsigned)(uintptr_t)(lds + OFF_V) + v_rd_base(lane);
    const int NT = P.ntiles();
    const LAS float* kg = (const LAS float*)(lds + (KGRES ? XTRA_OFF : OFF_KG)) + sc;
    if constexpr (Pol::KNORM && !KGRES) { int tk = tid; asm volatile("" : "+v"(tk)); if (tk < 128) ((LAS float*)(lds + OFF_KG))[tk] = P.kgain[tk]; }
    { if constexpr (!PRE) { const auto ti = P.tile(0); stage_load(P, ti, S0, sr, sc);
      if (NT > 1) { const auto t1 = P.tile(1); stage_load(P, t1, S1, sr, sc); } }
      if constexpr (Pol::KNORM) { if constexpr (!KGRES) __syncthreads(); norm_row8(S0.k0, kg); norm_row8(S0.k1, kg); }
      stage_write(lds, 0, S0, kws, vst0, vst1);
      if (NT > 2) { const auto t2 = P.tile(2); stage_load(P, t2, S0, sr, sc); } }
    __syncthreads();
    for (int t = 0; t < NT; t += 2) {
        { const auto ti = P.tile(t);
          SBAR();
          if (P.active(ti, wid)) tile_compute_fx<0>(P, ti, lds, vb0, wid, r32, hi, qr, o, lacc, shiftC2);
          SBAR();
          if (t + 1 < NT) { if constexpr (Pol::KNORM) { norm_row8(S1.k0, kg); norm_row8(S1.k1, kg); } stage_write(lds, 1, S1, kws, vst0, vst1);
              if (t + 3 < NT) { const auto tn = P.tile(t + 3); stage_load(P, tn, S1, sr, sc); } }
          __syncthreads(); }
        if (t + 1 >= NT) break;
        { const auto ti = P.tile(t + 1);
          SBAR();
          if (P.active(ti, wid)) tile_compute_fx<1>(P, ti, lds, vb0, wid, r32, hi, qr, o, lacc, shiftC2);
          SBAR();
          if (t + 2 < NT) { if constexpr (Pol::KNORM) { norm_row8(S0.k0, kg); norm_row8(S0.k1, kg); } stage_write(lds, 0, S0, kws, vst0, vst1);
              if (t + 4 < NT) { const auto tn = P.tile(t + 4); stage_load(P, tn, S0, sr, sc); } }
          __syncthreads(); }
    }
}
template <class Pol>
__device__ __forceinline__ void att_pass_fx(const Pol& P, LAS char* lds, const bf16x8 (&qr)[8], f32x16 (&o)[4], f32x16& lacc, float shiftC2, int tid) {
    Stage S0, S1; att_pass_fx_core<Pol, false>(P, lds, qr, o, lacc, shiftC2, tid, S0, S1);
}
template <class Pol, bool KGRES = false>
__device__ __forceinline__ void att_pass_fx_pre(const Pol& P, LAS char* lds, const bf16x8 (&qr)[8], f32x16 (&o)[4], f32x16& lacc, float shiftC2, int tid, Stage& S0, Stage& S1) {
    att_pass_fx_core<Pol, true, KGRES>(P, lds, qr, o, lacc, shiftC2, tid, S0, S1);
}
constexpr int OFF_V3 = 0, OFF_K3 = 3 * SHM, OFF_WS3 = 6 * SHM;
template <int KB>
__device__ __forceinline__ void qkt3(f32x16& p0, f32x16& p1, const LAS char* lds, int r32, int hi, const bf16x8 (&qr)[8]) {
    p0 = f32x16{}; p1 = f32x16{};
    const LAS char* kb[4];
#pragma unroll
    for (int dd = 0; dd < 4; ++dd) kb[dd] = lds + OFF_K3 + KB * SHM + KSWZ(r32, (dd * 16 + hi * 8) * 2);
    bf16x8 f[2][4];
#define QK_LD(g, s) do { const LAS char* a0_ = kb[(2 * (g)) & 3] + ((2 * (g)) >> 2) * 128; const LAS char* a1_ = kb[(2 * (g) + 1) & 3] + ((2 * (g) + 1) >> 2) * 128; \
        f[s][0] = *reinterpret_cast<const LAS bf16x8*>(a0_); f[s][1] = *reinterpret_cast<const LAS bf16x8*>(a0_ + 32 * 256); \
        f[s][2] = *reinterpret_cast<const LAS bf16x8*>(a1_); f[s][3] = *reinterpret_cast<const LAS bf16x8*>(a1_ + 32 * 256); } while (0)
#define QK_MM(g, s) do { p0 = __builtin_amdgcn_mfma_f32_32x32x16_bf16(f[s][0], qr[2 * (g)], p0, 0, 0, 0); p1 = __builtin_amdgcn_mfma_f32_32x32x16_bf16(f[s][1], qr[2 * (g)], p1, 0, 0, 0); \
        p0 = __builtin_amdgcn_mfma_f32_32x32x16_bf16(f[s][2], qr[2 * (g) + 1], p0, 0, 0, 0); p1 = __builtin_amdgcn_mfma_f32_32x32x16_bf16(f[s][3], qr[2 * (g) + 1], p1, 0, 0, 0); } while (0)
    QK_LD(0, 0); SBAR();
    QK_LD(1, 1); SBAR(); QK_MM(0, 0); SBAR();
    QK_LD(2, 0); SBAR(); QK_MM(1, 1); SBAR();
    QK_LD(3, 1); SBAR(); QK_MM(2, 0); SBAR();
    QK_MM(3, 1); SBAR();
#undef QK_LD
#undef QK_MM
}
template <int BUF, class Pol, class TI>
__device__ __forceinline__ void tile_compute_fx3(const Pol& P, const TI& ti, LAS char* lds, int vb0, int wid, int r32, int hi, const bf16x8 (&qr)[8], f32x16 (&o)[4], f32x16& lacc, float shiftC2) {
    f32x16 p0, p1; bf16x8 pa0, pa1, pa2, pa3;
    qkt3<BUF>(p0, p1, lds, r32, hi, qr);
    float sh = shiftC2;
    if constexpr (Pol::LANEPRED) {
        if (ti.bit == P.cur) P.mask(p0, p1, ti, wid, r32, hi); else sh = ((P.sel >> ti.bit) & 1u) ? shiftC2 : __builtin_inff();
    } else P.mask(p0, p1, ti, wid, r32, hi);
    fx_softmax(p0, p1, sh, pa0, pa1, pa2, pa3);
    SBAR();
    fx_rowsum(lacc, pa0, pa1, pa2, pa3);
    pv_tile<BUF>(o, vb0, pa0, pa1, pa2, pa3);
}
__device__ __forceinline__ void fxd_offsets(int wid, int lane, unsigned (&koff)[2], unsigned (&voff)[2]) {
#pragma unroll
    for (int i = 0; i < 2; ++i) { const int q = wid * 128 + i * 64 + lane;
        { const int row = q >> 4, pos = q & 15; koff[i] = (unsigned)(row * 256 + ((pos ^ (row & 7)) << 4)); }
        { const int sidx = q >> 5, w = q & 31, kk = (sidx >> 2) * 8 + (w >> 2), c = (sidx & 3) * 32 + (w & 3) * 8; const int k = (kk & ~0xC) | ((kk & 4) << 1) | ((kk & 8) >> 1); voff[i] = (unsigned)(k * 256 + c * 2); } }
}
template <class Pol>
__device__ __forceinline__ void fxd_prefetch(const Pol& P, LAS char* lds, int tid) {
    const int wid = __builtin_amdgcn_readfirstlane(tid >> 6), lane = tid & 63;
    unsigned koff[2], voff[2]; fxd_offsets(wid, lane, koff, voff);
    const unsigned ldsw = (unsigned)wid * 2048u;
    const int NT = P.ntiles();
#pragma unroll
    for (int t = 0; t < 2; ++t) { if (t < NT) { const auto ti_ = P.tile(t); const char* kt_ = (const char*)P.krow(ti_, 0); const char* vt_ = (const char*)P.vrow(ti_, 0);
#pragma unroll
        for (int i = 0; i < 2; ++i) {
            __builtin_amdgcn_global_load_lds((const unsigned*)(kt_ + koff[i]), (LAS unsigned*)(lds + OFF_K3 + t * SHM + ldsw + i * 1024), 16, 0, 0);
            __builtin_amdgcn_global_load_lds((const unsigned*)(vt_ + voff[i]), (LAS unsigned*)(lds + OFF_V3 + t * SHM + ldsw + i * 1024), 16, 0, 0); } } }
}
template <class Pol, bool PRE = false>
__device__ __forceinline__ void att_pass_fxd(const Pol& P, LAS char* lds, const bf16x8 (&qr)[8], f32x16 (&o)[4], f32x16& lacc, float shiftC2, int tid) {
    const int wid = __builtin_amdgcn_readfirstlane(tid >> 6), lane = tid & 63, r32 = lane & 31, hi = lane >> 5;
    const int vb0 = (int)(unsigned)(uintptr_t)(lds + OFF_V3) + v_rd_base(lane);
    const int NT = P.ntiles();
    unsigned koff[2], voff[2]; fxd_offsets(wid, lane, koff, voff);
    const unsigned ldsw = (unsigned)wid * 2048u;
#define DMA_BAR() do { asm volatile("s_waitcnt lgkmcnt(0)" ::: "memory"); __builtin_amdgcn_s_barrier(); asm volatile("" ::: "memory"); } while (0)
#define DMA_TILE(t_, buf_) do { const auto ti_ = P.tile(t_); const char* kt_ = (const char*)P.krow(ti_, 0); const char* vt_ = (const char*)P.vrow(ti_, 0); \
        _Pragma("unroll") for (int i = 0; i < 2; ++i) { \
            __builtin_amdgcn_global_load_lds((const unsigned*)(kt_ + koff[i]), (LAS unsigned*)(lds + OFF_K3 + (buf_) * SHM + ldsw + i * 1024), 16, 0, 0); \
            __builtin_amdgcn_global_load_lds((const unsigned*)(vt_ + voff[i]), (LAS unsigned*)(lds + OFF_V3 + (buf_) * SHM + ldsw + i * 1024), 16, 0, 0); } } while (0)
    if constexpr (PRE) asm volatile("s_waitcnt vmcnt(0)" ::: "memory");
    else { DMA_TILE(0, 0);
        if (NT > 1) { DMA_TILE(1, 1); asm volatile("s_waitcnt vmcnt(4)" ::: "memory"); } else asm volatile("s_waitcnt vmcnt(0)" ::: "memory"); }
    DMA_BAR();
#define DMA_STEP(t_, B_, BN2_) do { const auto ti = P.tile(t_); \
        if ((t_) + 2 < NT) DMA_TILE((t_) + 2, BN2_);                        \
        SBAR(); \
        if (P.active(ti, wid)) tile_compute_fx3<B_>(P, ti, lds, vb0, wid, r32, hi, qr, o, lacc, shiftC2); \
        SBAR(); \
        if ((t_) + 2 < NT) asm volatile("s_waitcnt vmcnt(4)" ::: "memory"); else asm volatile("s_waitcnt vmcnt(0)" ::: "memory");     \
        DMA_BAR(); } while (0)
    for (int t = 0; t < NT; t += 3) {
        DMA_STEP(t, 0, 2);
        if (t + 1 >= NT) break;
        DMA_STEP(t + 1, 1, 0);
        if (t + 2 >= NT) break;
        DMA_STEP(t + 2, 2, 1);
    }
    __syncthreads();
#undef DMA_STEP
#undef DMA_TILE
#undef DMA_BAR
}
}

template <int MAP>
__device__ __forceinline__ int src_col(int n) {
    if (MAP == 0) return n;
    if (MAP == 2) {
        if (n >= 2048) return n;
        const int pn = n >> 8, q = (n >> 3) & 31, e = n & 7, c = 128 * pn + 4 * q + (e & 3);
        return e < 4 ? c : 1024 + c;
    }
    const int cb = n >> 7, c = n & 127;
    if (cb < 16) { const int q8 = c >> 3, e = c & 7; return cb * 128 + (e < 4 ? 4 * q8 + e : 64 + 4 * q8 + (e - 4)); }
    if (cb < 52) return n;
    if (cb == 52) return c < 24 ? 6656 + c : -1;
    if (cb < 61) return 6680 + (cb - 53) * 128 + c;
    return -1;
}
template <int MAP>
__device__ __forceinline__ void p0_transpose_item(const float* W, int K, int N, int ldw, const float* gk, bf16* WT, LAS float* scr, int item, int lane) {
    const int nblk = N / 32, kb = item / nblk, nb = item % nblk, k0 = 64 * kb, n0 = 32 * nb;
    const int sc = src_col<MAP>(n0 + (lane & 31));
    float vv[32];
#pragma unroll
    for (int i = 0; i < 32; ++i) { const int kk = 2 * i + (lane >> 5); vv[i] = (sc >= 0) ? __builtin_nontemporal_load(W + (size_t)(k0 + kk) * ldw + sc) : 0.f; }
    if (gk) {
        const float g0 = gk[k0 + (lane & 31) * 2 + (lane >> 5)];
#pragma unroll
        for (int i = 0; i < 32; ++i) vv[i] *= __shfl(g0, i + (lane & 32));
    }
#pragma unroll
    for (int i = 0; i < 32; ++i) { const int kk = 2 * i + (lane >> 5); scr[kk * 33 + (lane & 31)] = vv[i]; }
    LDS_WAIT(); asm volatile("" ::: "memory");
    const int c = lane & 7;
#pragma unroll
    for (int j = 0; j < 4; ++j) { const int n = (lane >> 3) + 8 * j; const LAS float* s = scr + (8 * c) * 33 + n;
        v4u o; o.x = cvtpk(s[0 * 33], s[1 * 33]); o.y = cvtpk(s[2 * 33], s[3 * 33]); o.z = cvtpk(s[4 * 33], s[5 * 33]); o.w = cvtpk(s[6 * 33], s[7 * 33]);
        *(v4u*)(WT + (size_t)(n0 + n) * K + k0 + 8 * c) = o; }
    LDS_WAIT(); asm volatile("" ::: "memory");
}
template <int MAP>
__device__ __forceinline__ void p0_item_load(const float* W, int N, int ldw, int item, int lane, float (&vv)[32]) {
    const int nblk = N / 32, kb = item / nblk, nb = item % nblk, k0 = 64 * kb, n0 = 32 * nb;
    const int sc = src_col<MAP>(n0 + (lane & 31));
#pragma unroll
    for (int i = 0; i < 32; ++i) { const int kk = 2 * i + (lane >> 5); vv[i] = (sc >= 0) ? __builtin_nontemporal_load(W + (size_t)(k0 + kk) * ldw + sc) : 0.f; }
}
__device__ __forceinline__ void p0_item_finish(int K, int N, const float* gk, bf16* WT, LAS float* scr, int item, int lane, float (&vv)[32]) {
    const int nblk = N / 32, kb = item / nblk, nb = item % nblk, k0 = 64 * kb, n0 = 32 * nb;
    if (gk) {
        const float g0 = gk[k0 + (lane & 31) * 2 + (lane >> 5)];
#pragma unroll
        for (int i = 0; i < 32; ++i) vv[i] *= __shfl(g0, i + (lane & 32));
    }
#pragma unroll
    for (int i = 0; i < 32; ++i) { const int kk = 2 * i + (lane >> 5); scr[kk * 33 + (lane & 31)] = vv[i]; }
    LDS_WAIT(); asm volatile("" ::: "memory");
    const int c = lane & 7;
#pragma unroll
    for (int j = 0; j < 4; ++j) { const int n = (lane >> 3) + 8 * j; const LAS float* sp = scr + (8 * c) * 33 + n;
        v4u o; o.x = cvtpk(sp[0 * 33], sp[1 * 33]); o.y = cvtpk(sp[2 * 33], sp[3 * 33]); o.z = cvtpk(sp[4 * 33], sp[5 * 33]); o.w = cvtpk(sp[6 * 33], sp[7 * 33]);
        *(v4u*)(WT + (size_t)(n0 + n) * K + k0 + 8 * c) = o; }
    LDS_WAIT(); asm volatile("" ::: "memory");
}
__device__ __forceinline__ void rms_row_to_bf16(const float* xrow, bf16* orow, int lane) {
    const f32x4* xr = (const f32x4*)xrow + lane;
    f32x4 v[8]; float s = 0.f;
#pragma unroll
    for (int j = 0; j < 8; ++j) { v[j] = xr[64 * j]; s += (v[j].x * v[j].x + v[j].y * v[j].y) + (v[j].z * v[j].z + v[j].w * v[j].w); }
    const float rstd = __builtin_amdgcn_rsqf(wave_sum(s) * (1.f / DM) + NORM_EPS);
    v2u* o8 = (v2u*)orow + lane;
#pragma unroll
    for (int j = 0; j < 8; ++j) { v2u w; w.x = cvtpk(v[j].x * rstd, v[j].y * rstd); w.y = cvtpk(v[j].z * rstd, v[j].w * rstd); o8[64 * j] = w; }
}
__device__ __forceinline__ void rms_row2_to_bf16(const float* xrow, bf16* orow, int lane) {
    const f32x4* xr = (const f32x4*)xrow + lane;
    f32x4 v[16]; float s0 = 0.f, s1 = 0.f;
#pragma unroll
    for (int j = 0; j < 16; ++j) v[j] = __builtin_nontemporal_load(xr + 64 * j);
#pragma unroll
    for (int j = 0; j < 8; ++j) { s0 += (v[j].x * v[j].x + v[j].y * v[j].y) + (v[j].z * v[j].z + v[j].w * v[j].w); s1 += (v[8 + j].x * v[8 + j].x + v[8 + j].y * v[8 + j].y) + (v[8 + j].z * v[8 + j].z + v[8 + j].w * v[8 + j].w); }
    const float r0 = __builtin_amdgcn_rsqf(wave_sum(s0) * (1.f / DM) + NORM_EPS), r1 = __builtin_amdgcn_rsqf(wave_sum(s1) * (1.f / DM) + NORM_EPS);
    v2u* o8 = (v2u*)orow + lane;
#pragma unroll
    for (int j = 0; j < 16; ++j) { const float r = j < 8 ? r0 : r1; v2u w; w.x = cvtpk(v[j].x * r, v[j].y * r); w.y = cvtpk(v[j].z * r, v[j].w * r); o8[64 * j] = w; }
}
constexpr int P0_IA = (DM / 64) * (N0 / 32);
constexpr int P0_IB = (2048 / 64) * (DM / 32);
constexpr int P0_IC = (DM / 64) * (N1 / 32);
constexpr int P0_ID = (K1OUT / 64) * (DM / 32);
constexpr int P0_IE = (2048 / 64) * (128 / 32);
constexpr int P0_NITEMS = P0_IA + P0_IB + P0_IC + P0_ID + 4 * P0_IE;
constexpr int P0_DEFER = 5120;
constexpr int P0_DEFER3 = P0_IC + P0_ID;
__device__ __forceinline__ void p0_weight_items(Frame& F, int first, int last, int stride, int lane_) {
    LAS float* scr = (LAS float*)(F.lds + F.wave * 16384);
    bf16* W0IN = (bf16*)(F.ws + WS_W0IN); bf16* W0OUT = (bf16*)(F.ws + WS_W0OUT); bf16* W1IN = (bf16*)(F.ws + WS_W1IN); bf16* W1OUT = (bf16*)(F.ws + WS_W1OUT); bf16* CW = (bf16*)(F.ws + WS_CW);
    for (int it = first; it < last; it += stride) {
        int r = it;
        if (r < P0_IA) { p0_transpose_item<1>(F.in[2], DM, N0, 7704, F.in[1], W0IN, scr, r, lane_); continue; } r -= P0_IA;
        if (r < P0_IB) { p0_transpose_item<0>(F.in[3], 2048, DM, DM, nullptr, W0OUT, scr, r, lane_); continue; } r -= P0_IB;
        if (r < 4 * P0_IE) { const int q = r / P0_IE, rr = r % P0_IE, kv = q >> 1, half = q & 1;
            p0_transpose_item<0>(F.in[kv ? 11 : 9] + (size_t)half * 2048 * 128, 2048, 128, 128, nullptr, CW + (size_t)kv * 256 * 2048 + (size_t)half * 128 * 2048, scr, rr, lane_); continue; } r -= 4 * P0_IE;
        if (r < P0_IC) { p0_transpose_item<2>(F.in[14], DM, N1, N1, F.in[13], W1IN, scr, r, lane_); continue; } r -= P0_IC;
        p0_transpose_item<0>(F.in[15], K1OUT, DM, DM, nullptr, W1OUT, scr, r, lane_);
    }
}
__device__ __forceinline__ void p0_weight_pair(Frame& F, int itA, int itB, int lane_) {
    LAS float* scr = (LAS float*)(F.lds + F.wave * 16384);
    const int base = P0_NITEMS - P0_IC - P0_ID;
    float va[32], vb[32];
    if (itA - base < P0_IC) { const int ra = itA - base, rb = itB - base; bf16* W1IN = (bf16*)(F.ws + WS_W1IN);
        p0_item_load<2>(F.in[14], N1, N1, ra, lane_, va); p0_item_load<2>(F.in[14], N1, N1, rb, lane_, vb);
        p0_item_finish(DM, N1, F.in[13], W1IN, scr, ra, lane_, va); p0_item_finish(DM, N1, F.in[13], W1IN, scr, rb, lane_, vb);
    } else { const int ra = itA - base - P0_IC, rb = itB - base - P0_IC; bf16* W1OUT = (bf16*)(F.ws + WS_W1OUT);
        p0_item_load<0>(F.in[15], DM, DM, ra, lane_, va); p0_item_load<0>(F.in[15], DM, DM, rb, lane_, vb);
        p0_item_finish(K1OUT, DM, nullptr, W1OUT, scr, ra, lane_, va); p0_item_finish(K1OUT, DM, nullptr, W1OUT, scr, rb, lane_, vb); }
}
template <int SKIP = 0>
__device__ __forceinline__ void p0_prologue(Frame& F, int defer = 0) {
    const int gw = blockIdx.x * NWAVES + F.wave, NGW = F.G * NWAVES;
    if (!(SKIP & 1)) p0_weight_items(F, gw, P0_NITEMS - defer, NGW, F.lane);
    bf16* XN = (bf16*)(F.ws + WS_A);
    if (!(SKIP & 2)) for (int m = 2 * gw; m < MROWS; m += 2 * NGW) rms_row2_to_bf16(F.in[0] + (size_t)m * DM, XN + (size_t)m * DM, F.lane);
    float* rope = (float*)(F.ws + WS_MISC + ROPE_OFF);
    for (int e = blockIdx.x * NTHREADS + F.tid; e < SEQ * 64; e += F.G * NTHREADS) {
        const int s = e >> 6, i = e & 63;
        double iv = 1.0; for (int k = 0; k < i; ++k) iv *= 0.8659643233600653;
        const float ang = (float)s * (float)iv;
        const double x = (double)ang; const double q = __builtin_rint(x * 0.6366197723675814); const double r = __builtin_fma(-q, 1.5707963267948966, x) - q * 6.123233995736766e-17;
        const double r2 = r * r;
        double sp = -7.647163731819816e-13; sp = sp * r2 + 1.6059043836821613e-10; sp = sp * r2 - 2.505210838544172e-08; sp = sp * r2 + 2.7557319223985893e-06; sp = sp * r2 - 1.984126984126984e-04; sp = sp * r2 + 8.333333333333333e-03; sp = sp * r2 - 1.6666666666666666e-01;
        const double sn = r + r * r2 * sp;
        double cp = 4.779477332387385e-14; cp = cp * r2 - 1.1470745597729725e-11; cp = cp * r2 + 2.08767569878681e-09; cp = cp * r2 - 2.755731922398589e-07; cp = cp * r2 + 2.48015873015873e-05; cp = cp * r2 - 1.388888888888889e-03; cp = cp * r2 + 4.1666666666666664e-02; cp = cp * r2 - 0.5;
        const double cs = 1.0 + r2 * cp;
        const int qi = ((int)q) & 3;
        const double sv = (qi == 0) ? sn : (qi == 1) ? cs : (qi == 2) ? -sn : -cs;
        const double cv = (qi == 0) ? cs : (qi == 1) ? -sn : (qi == 2) ? -cs : sn;
        rope[(size_t)s * 128 + i] = (float)cv; rope[(size_t)s * 128 + 64 + i] = (float)sv;
    }
    if (blockIdx.x == 0 && F.wave == 0) {
        const float a = att::gain_maxabs(F.in[5], F.lane), ks = att::gain_maxabs(F.in[6] + 128, F.lane), kw = att::gain_maxabs(F.in[6] + 256, F.lane);
        const float dq = att::gain_maxabs(F.in[20], F.lane), dk = att::gain_maxabs(F.in[21], F.lane);
        float* fxb = (float*)(F.ws + WS_MISC + FXB_OFF);
        const float kc = att::gain_maxabs(F.in[6], F.lane);
        if (F.lane == 0) { fxb[0] = att::FX_BOUND * a * ks; fxb[1] = att::FX_BOUND * a * kw; fxb[2] = att::FX_BOUND * dq * dk; fxb[3] = att::FX_BOUND * a * kc; }
    }
    { float* cbp = (float*)(F.ws + WS_MISC + 1536 * 1024);
      for (int it = gw; it < 64; it += NGW) { const int kv = it >> 5, pt = it & 31;
          const float* pos = F.in[kv ? 8 : 7] + pt * 128; const float* w1 = F.in[kv ? 11 : 9] + (size_t)pt * 128 * 128;
          float s0 = 0.f, s1 = 0.f;
#pragma unroll 1
          for (int k0 = 0; k0 < 128; k0 += 32) { float wa[32], wb[32];
#pragma unroll
              for (int kk = 0; kk < 32; ++kk) { wa[kk] = w1[(size_t)(k0 + kk) * 128 + F.lane]; wb[kk] = w1[(size_t)(k0 + kk) * 128 + 64 + F.lane]; }
#pragma unroll
              for (int kk = 0; kk < 32; ++kk) { const float pv = pos[k0 + kk]; s0 += pv * wa[kk]; s1 += pv * wb[kk]; } }
          cbp[(size_t)it * 128 + F.lane] = s0; cbp[(size_t)it * 128 + 64 + F.lane] = s1; } }
}

template <int MODE>
__device__ __forceinline__ void rowop_item(bf16* blk, int row0, const float* g, const float* rope, int tid, float lgs = 0.f, float fmul = 1.f) {
    const int c = tid & 15, rr = tid >> 4;
#pragma unroll 2
    for (int p = 0; p < 8; ++p) {
        const int row = row0 + p * 32 + rr;
        v4u* ptr = (v4u*)(blk + (size_t)row * 128 + c * 8);
        const v4u w = *ptr;
        float x[8] = {bflo(w.x), bfhi(w.x), bflo(w.y), bfhi(w.y), bflo(w.z), bfhi(w.z), bflo(w.w), bfhi(w.w)};
        float y[8];
        if (MODE == 0) {
            v4u pw; pw.x = __shfl_xor(w.x, 8); pw.y = __shfl_xor(w.y, 8); pw.z = __shfl_xor(w.z, 8); pw.w = __shfl_xor(w.w, 8);
            const float px[8] = {bflo(pw.x), bfhi(pw.x), bflo(pw.y), bfhi(pw.y), bflo(pw.z), bfhi(pw.z), bflo(pw.w), bfhi(pw.w)};
            const int s = row & (SEQ - 1), i0 = (c & 7) * 8;
            const f32x4 c0 = *(const f32x4*)(rope + (size_t)s * 128 + i0), c1 = *(const f32x4*)(rope + (size_t)s * 128 + i0 + 4);
            const f32x4 s0 = *(const f32x4*)(rope + (size_t)s * 128 + 64 + i0), s1 = *(const f32x4*)(rope + (size_t)s * 128 + 64 + i0 + 4);
            const float cs[8] = {c0.x, c0.y, c0.z, c0.w, c1.x, c1.y, c1.z, c1.w}, sn[8] = {s0.x, s0.y, s0.z, s0.w, s1.x, s1.y, s1.z, s1.w};
            const float sg = (c < 8) ? -1.f : 1.f;
            const float fr = __builtin_amdgcn_exp2f((float)s * lgs) * fmul;
#pragma unroll
            for (int k = 0; k < 8; ++k) y[k] = (x[k] * cs[k] + sg * px[k] * sn[k]) * fr;
        } else {
            float ss = 0.f;
#pragma unroll
            for (int k = 0; k < 8; ++k) ss += x[k] * x[k];
            ss += __shfl_xor(ss, 1); ss += __shfl_xor(ss, 2); ss += __shfl_xor(ss, 4); ss += __shfl_xor(ss, 8);
            const float rstd = __builtin_amdgcn_rsqf(ss * (1.f / 128.f) + NORM_EPS);
            const f32x4 g0 = *(const f32x4*)(g + c * 8), g1 = *(const f32x4*)(g + c * 8 + 4);
            const float gg[8] = {g0.x, g0.y, g0.z, g0.w, g1.x, g1.y, g1.z, g1.w};
#pragma unroll
            for (int k = 0; k < 8; ++k) y[k] = x[k] * rstd * gg[k];
        }
        v4u o; o.x = cvtpk(y[0], y[1]); o.y = cvtpk(y[2], y[3]); o.z = cvtpk(y[4], y[5]); o.w = cvtpk(y[6], y[7]);
        *ptr = o;
    }
}

__device__ __forceinline__ void cmp_tail_unit(Frame& F, int unit) {
    const int kv = unit >> 7, b = (unit >> 3) & 15, g = (unit >> 2) & 1, qt = unit & 3;
    int tid = F.tid; asm volatile("" : "+v"(tid));
    LAS float* Ws = (LAS float*)F.lds;
    LAS float* Gt = (LAS float*)(F.lds + 65536);
    LAS float* bias = (LAS float*)(F.lds + 65536 + 16896);
    const float* cpr = (const float*)(F.ws + WS_CPR) + (size_t)kv * 4096 * 256;
    const float* cpr2 = (const float*)(F.ws + WS_CPR2) + (size_t)kv * 4096 * 256;
    const float* w2 = F.in[kv ? 12 : 10];
    { f32x4 wv[8];
#pragma unroll
      for (int i = 0; i < 8; ++i) wv[i] = *(const f32x4*)(w2 + (size_t)(tid + 512 * i) * 4);
      if (tid < 128) { const float* cbp = (const float*)(F.ws + WS_MISC + 1536 * 1024) + (size_t)kv * 32 * 128 + tid; float pb[32];
#pragma unroll
          for (int pt = 0; pt < 32; ++pt) pb[pt] = cbp[pt * 128];
          float sb = 0.f;
#pragma unroll
          for (int pt = 0; pt < 32; ++pt) sb += pb[pt];
          bias[tid] = sb; }
#pragma unroll
      for (int i = 0; i < 8; ++i) *(LAS f32x4*)(Ws + (size_t)(tid + 512 * i) * 4) = wv[i]; }
    __syncthreads();
    const int rbase = g * 2048 + b * 128 + 32 * qt;
    { float p0[8], p1[8], p2[8], p3[8];
#pragma unroll
      for (int i = 0; i < 8; ++i) { const int idx = tid + 512 * i, n = idx >> 7, j = idx & 127; const bool ok = 32 * qt + n < 127; const size_t r = (size_t)(rbase + (ok ? n : 0));
          p0[i] = cpr[r * 256 + j]; p1[i] = cpr2[r * 256 + j]; p2[i] = cpr[(r + 1) * 256 + 128 + j]; p3[i] = cpr2[(r + 1) * 256 + 128 + j]; }
#pragma unroll
      for (int i = 0; i < 8; ++i) { const int idx = tid + 512 * i, n = idx >> 7, j = idx & 127; const bool ok = 32 * qt + n < 127;
          const float pre = (p0[i] + p1[i]) + (p2[i] + p3[i]) + bias[j];
          const float u = 0.7978845608028654f * (pre + 0.044715f * pre * pre * pre);
          const float th = 1.0f - 2.0f * __builtin_amdgcn_rcpf(fast_exp(2.0f * u) + 1.0f);
          Gt[j * 33 + n] = ok ? 0.5f * pre * (1.0f + th) : 0.f; } }
    __syncthreads();
    const int n = tid >> 4, cg = tid & 15;
    float acc[8];
#pragma unroll
    for (int c = 0; c < 8; ++c) acc[c] = 0.f;
#pragma unroll 4
    for (int j = 0; j < 128; ++j) {
        const float a = Gt[j * 33 + n];
        const f32x4 w0 = *(const LAS f32x4*)(Ws + j * 128 + cg * 8), w1 = *(const LAS f32x4*)(Ws + j * 128 + cg * 8 + 4);
        acc[0] += a * w0.x; acc[1] += a * w0.y; acc[2] += a * w0.z; acc[3] += a * w0.w; acc[4] += a * w1.x; acc[5] += a * w1.y; acc[6] += a * w1.z; acc[7] += a * w1.w;
    }
    if (kv == 0) {
        float ss = 0.f;
#pragma unroll
        for (int c = 0; c < 8; ++c) ss += acc[c] * acc[c];
        ss += __shfl_xor(ss, 1); ss += __shfl_xor(ss, 2); ss += __shfl_xor(ss, 4); ss += __shfl_xor(ss, 8);
        const float rstd = __builtin_amdgcn_rsqf(ss * (1.f / 128.f) + NORM_EPS);
        const float* kg = F.in[6];
#pragma unroll
        for (int c = 0; c < 8; ++c) acc[c] *= rstd * kg[cg * 8 + c];
    }
    bf16* dst = (bf16*)(F.ws + WS_KCMP) + ((size_t)kv * 32 + (b * 2 + g)) * 128 * 128 + (size_t)(32 * qt + n) * 128 + cg * 8;
    v4u o; o.x = cvtpk(acc[0], acc[1]); o.y = cvtpk(acc[2], acc[3]); o.z = cvtpk(acc[4], acc[5]); o.w = cvtpk(acc[6], acc[7]);
    if (32 * qt + n == 127) o = (v4u){0u, 0u, 0u, 0u};
    *(v4u*)dst = o;
}

struct PolRet {
    static constexpr bool SOFTMAX = false, KNORM = false;
    const bf16 *Kb, *Vb; int t0; const float* kgain;
    struct TI { int kb; };
    __device__ __forceinline__ int ntiles() const { return 4; }
    __device__ __forceinline__ TI tile(int t) const { return TI{t0 + 64 * t}; }
    __device__ __forceinline__ const bf16* krow(const TI& ti, int i) const { return Kb + (size_t)(ti.kb + i) * 128; }
    __device__ __forceinline__ const bf16* vrow(const TI& ti, int i) const { return Vb + (size_t)(ti.kb + i) * 128; }
    __device__ __forceinline__ bool active(const TI& ti, int wid) const { return ti.kb <= t0 + 32 * wid + 31; }
    __device__ __forceinline__ void weights(f32x16& p0, f32x16& p1, const TI& ti, int wid, int r32, int hi) const {
        const int qlo = t0 + 32 * wid;
        if (ti.kb + 63 > qlo) {
            const int dq = qlo + r32 - ti.kb - 4 * hi;
#pragma unroll
            for (int r = 0; r < 16; ++r) { const int c = (r & 3) + 8 * (r >> 2);
                p0[r] = (dq - c >= 0) ? p0[r] : 0.f; p1[r] = (dq - c - 32 >= 0) ? p1[r] : 0.f; }
        }
    }
};
constexpr size_t WS_TST = WS_A + 64 * MiB;
__device__ __forceinline__ void ret_state_unit(Frame& F, int unit) {
    int tid = F.tid; asm volatile("" : "+v"(tid));
    const int wid = F.wave, lane = tid & 63, r32 = lane & 31, hi = lane >> 5;
    const int b = unit >> 3, h = unit & 7;
    const size_t rowb = (size_t)b * SEQ;
    const bf16* Kb = hblk(F, CB_RK + h) + rowb * 128; const bf16* Vb = hblk(F, CB_RV + h) + rowb * 128;
    bf16* tst = (bf16*)(F.ws + WS_TST) + (size_t)unit * 7 * 16384;
    LAS char* lds = (LAS char*)F.lds;
    const int sr = tid >> 4, sc = (tid & 15) * 8, vst0 = att::v_st(sr, sc), vst1 = att::v_st(32 + sr, sc);
    const int a = wid >> 1, c0 = 2 * (wid & 1);
    const int vbK = (int)(unsigned)(uintptr_t)(lds + att::OFF_K) + att::v_rd_base(lane) + a * 512;
    const int vbV = (int)(unsigned)(uintptr_t)(lds + att::OFF_V) + att::v_rd_base(lane) + c0 * 512;
    f32x16 acc0 = {}, acc1 = {};
    bf16x8 ka0, ka1, va0, va1, kb0, kb1, vb0_, vb1_;
#define RS_LOAD(K0, K1, V0, V1, t_) do { K0 = *reinterpret_cast<const bf16x8*>(Kb + (size_t)(64 * (t_) + sr) * 128 + sc); K1 = *reinterpret_cast<const bf16x8*>(Kb + (size_t)(64 * (t_) + 32 + sr) * 128 + sc); \
        V0 = *reinterpret_cast<const bf16x8*>(Vb + (size_t)(64 * (t_) + sr) * 128 + sc); V1 = *reinterpret_cast<const bf16x8*>(Vb + (size_t)(64 * (t_) + 32 + sr) * 128 + sc); } while (0)
#define RS_WRITE(K0, K1, V0, V1, buf_) do { *(LAS bf16x8*)(lds + att::OFF_K + (buf_) * att::SHM + vst0) = K0; *(LAS bf16x8*)(lds + att::OFF_K + (buf_) * att::SHM + vst1) = K1; \
        *(LAS bf16x8*)(lds + att::OFF_V + (buf_) * att::SHM + vst0) = V0; *(LAS bf16x8*)(lds + att::OFF_V + (buf_) * att::SHM + vst1) = V1; } while (0)
#define RS_TR(dst, base, off) asm volatile("ds_read_b64_tr_b16 %0, %1 offset:%2" : "=&v"(dst) : "v"(base), "i"(off) : "memory")
#define RS_COMPUTE(BUF) do { _Pragma("unroll") for (int ks = 0; ks < 4; ++ks) { s16x4 al, ah, bl0, bh0, bl1, bh1; \
            if (ks == 0) { RS_TR(al, vbK, BUF * att::SHM + 0); RS_TR(ah, vbK, BUF * att::SHM + 2048); RS_TR(bl0, vbV, BUF * att::SHM + 0); RS_TR(bh0, vbV, BUF * att::SHM + 2048); RS_TR(bl1, vbV, BUF * att::SHM + 512); RS_TR(bh1, vbV, BUF * att::SHM + 512 + 2048); } \
            if (ks == 1) { RS_TR(al, vbK, BUF * att::SHM + 4096); RS_TR(ah, vbK, BUF * att::SHM + 4096 + 2048); RS_TR(bl0, vbV, BUF * att::SHM + 4096); RS_TR(bh0, vbV, BUF * att::SHM + 4096 + 2048); RS_TR(bl1, vbV, BUF * att::SHM + 4096 + 512); RS_TR(bh1, vbV, BUF * att::SHM + 4096 + 512 + 2048); } \
            if (ks == 2) { RS_TR(al, vbK, BUF * att::SHM + 8192); RS_TR(ah, vbK, BUF * att::SHM + 8192 + 2048); RS_TR(bl0, vbV, BUF * att::SHM + 8192); RS_TR(bh0, vbV, BUF * att::SHM + 8192 + 2048); RS_TR(bl1, vbV, BUF * att::SHM + 8192 + 512); RS_TR(bh1, vbV, BUF * att::SHM + 8192 + 512 + 2048); } \
            if (ks == 3) { RS_TR(al, vbK, BUF * att::SHM + 12288); RS_TR(ah, vbK, BUF * att::SHM + 12288 + 2048); RS_TR(bl0, vbV, BUF * att::SHM + 12288); RS_TR(bh0, vbV, BUF * att::SHM + 12288 + 2048); RS_TR(bl1, vbV, BUF * att::SHM + 12288 + 512); RS_TR(bh1, vbV, BUF * att::SHM + 12288 + 512 + 2048); } \
            asm volatile("s_waitcnt lgkmcnt(0)" ::: "memory"); SBAR(); \
            const bf16x8 A_ = (bf16x8){al[0], al[1], al[2], al[3], ah[0], ah[1], ah[2], ah[3]}; \
            acc0 = __builtin_amdgcn_mfma_f32_32x32x16_bf16(A_, (bf16x8){bl0[0], bl0[1], bl0[2], bl0[3], bh0[0], bh0[1], bh0[2], bh0[3]}, acc0, 0, 0, 0); \
            acc1 = __builtin_amdgcn_mfma_f32_32x32x16_bf16(A_, (bf16x8){bl1[0], bl1[1], bl1[2], bl1[3], bh1[0], bh1[1], bh1[2], bh1[3]}, acc1, 0, 0, 0); } } while (0)
#define RS_STORE(t_) do { if (((t_) & 3) == 3) { bf16* tp = tst + (size_t)((t_) >> 2) * 16384; \
            _Pragma("unroll") for (int r = 0; r < 16; ++r) { const int row = 32 * a + att::crow(r, hi); \
                const float x0 = acc0[r], x0n = __shfl_xor(x0, 1), x1 = acc1[r], x1n = __shfl_xor(x1, 1); \
                if ((r32 & 1) == 0) { *(unsigned*)(tp + (size_t)row * 128 + 32 * c0 + r32) = cvtpk(x0, x0n); *(unsigned*)(tp + (size_t)row * 128 + 32 * (c0 + 1) + r32) = cvtpk(x1, x1n); } } } } while (0)
    RS_LOAD(ka0, ka1, va0, va1, 0); RS_WRITE(ka0, ka1, va0, va1, 0);
    RS_LOAD(ka0, ka1, va0, va1, 1); RS_LOAD(kb0, kb1, vb0_, vb1_, 2);
    __syncthreads();
#pragma unroll 1
    for (int t = 0; t < 28; t += 2) {
        SBAR(); RS_COMPUTE(0); SBAR();
        RS_WRITE(ka0, ka1, va0, va1, 1);
        if (t + 3 < 28) RS_LOAD(ka0, ka1, va0, va1, t + 3);
        RS_STORE(t);
        __syncthreads();
        SBAR(); RS_COMPUTE(1); SBAR();
        if (t + 2 < 28) RS_WRITE(kb0, kb1, vb0_, vb1_, 0);
        if (t + 4 < 28) RS_LOAD(kb0, kb1, vb0_, vb1_, t + 4);
        RS_STORE(t + 1);
        __syncthreads();
    }
#undef RS_LOAD
#undef RS_WRITE
#undef RS_TR
#undef RS_COMPUTE
#undef RS_STORE
}
template <int VAR>
__device__ __forceinline__ void retention_unit(Frame& F, int unit) {
    const int qb = 7 - (unit >> 7), bh = unit & 127, b = bh >> 3, h = bh & 7;
    int tid = F.tid; asm volatile("" : "+v"(tid));
    const int wid = F.wave, lane = tid & 63, r32 = lane & 31, hi = lane >> 5;
    const int t0 = qb * 256;
    const size_t rowb = (size_t)b * SEQ;
    const bf16* Qb = hblk(F, CB_RQ + h) + rowb * 128;
    bf16x8 qr[8];
    { const bf16* qp = Qb + (size_t)(t0 + wid * 32 + r32) * 128 + hi * 8;
#pragma unroll
      for (int d0 = 0; d0 < 8; ++d0) qr[d0] = *reinterpret_cast<const bf16x8*>(qp + d0 * 16); }
    PolRet P{hblk(F, CB_RK + h) + rowb * 128, hblk(F, CB_RV + h) + rowb * 128, t0, nullptr};
    att::Stage S0, S1; att::stage_prefetch(P, S0, S1, tid);
    att::settle_q(qr);
    f32x16 o[4] = {}; float m_reg = 0.f, l_reg = 0.f;
    if (qb > 0) {
        const bf16* tp = (const bf16*)(F.ws + WS_TST) + ((size_t)bh * 7 + (qb - 1)) * 16384;
        const int sr = tid >> 4, sc = (tid & 15) * 8, vst0 = att::v_st(sr, sc), vst1 = att::v_st(32 + sr, sc);
        LAS char* lds = (LAS char*)F.lds;
        { const bf16x8 a0 = *reinterpret_cast<const bf16x8*>(tp + (size_t)sr * 128 + sc), a1 = *reinterpret_cast<const bf16x8*>(tp + (size_t)(32 + sr) * 128 + sc);
          const bf16x8 b0 = *reinterpret_cast<const bf16x8*>(tp + (size_t)(64 + sr) * 128 + sc), b1 = *reinterpret_cast<const bf16x8*>(tp + (size_t)(96 + sr) * 128 + sc);
          *(LAS bf16x8*)(lds + att::OFF_V + vst0) = a0; *(LAS bf16x8*)(lds + att::OFF_V + vst1) = a1;
          *(LAS bf16x8*)(lds + att::OFF_V + att::SHM + vst0) = b0; *(LAS bf16x8*)(lds + att::OFF_V + att::SHM + vst1) = b1; }
        __syncthreads();
        const int vb0 = (int)(unsigned)(uintptr_t)(lds + att::OFF_V) + att::v_rd_base(lane);
        att::pv_tile<0>(o, vb0, qr[0], qr[1], qr[2], qr[3]);
        att::pv_tile<1>(o, vb0, qr[4], qr[5], qr[6], qr[7]);
        __syncthreads();
    }
    att::att_pass_pre<PolRet, VAR>(P, (LAS char*)F.lds, qr, o, m_reg, l_reg, tid, S0, S1);
    if (VAR != 0) { if (o[0][0] + o[1][1] + o[2][2] + o[3][3] == 12345.678f) F.MISC[20] = 1u; return; }
    float ss[16];
#pragma unroll
    for (int r = 0; r < 16; ++r) { float s = 0.f;
#pragma unroll
        for (int d = 0; d < 4; ++d) s += o[d][r] * o[d][r];
        s += __shfl_xor(s, 1); s += __shfl_xor(s, 2); s += __shfl_xor(s, 4); s += __shfl_xor(s, 8); s += __shfl_xor(s, 16);
        ss[r] = __builtin_amdgcn_rsqf(s * (1.f / 128.f) + NORM_EPS); }
    const float* rg = F.in[4] + h * 128;
    const bf16* Zb = hblk(F, CB_RZ + h) + rowb * 128;
    bf16* mix = (bf16*)(F.ws + WS_MIX);
    int rl = r32, hl = hi; asm volatile("" : "+v"(rl), "+v"(hl));
    float gd[4];
#pragma unroll
    for (int d = 0; d < 4; ++d) gd[d] = rg[d * 32 + rl];
    LAS float* st = (LAS float*)(F.lds + wid * 16384);
#pragma unroll
    for (int r = 0; r < 16; ++r)
#pragma unroll
        for (int d = 0; d < 4; ++d) st[att::crow(r, hl) * 128 + d * 32 + rl] = o[d][r] * ss[r] * gd[d];
    asm volatile("s_waitcnt lgkmcnt(0)" ::: "memory");
    int ll = lane; asm volatile("" : "+v"(ll));
    const int c8 = (ll & 15) * 8, rq = ll >> 4;
    v4u zz[8];
#pragma unroll
    for (int p = 0; p < 8; ++p) zz[p] = *(const v4u*)(Zb + (size_t)(t0 + wid * 32 + 4 * p + rq) * 128 + c8);
#pragma unroll
    for (int p = 0; p < 8; ++p) { const int row = 4 * p + rq;
        const f32x4 a = *(const LAS f32x4*)(st + row * 128 + c8), bq = *(const LAS f32x4*)(st + row * 128 + c8 + 4);
        v4u w; w.x = cvtpk(a.x * bflo(zz[p].x), a.y * bfhi(zz[p].x)); w.y = cvtpk(a.z * bflo(zz[p].y), a.w * bfhi(zz[p].y));
        w.z = cvtpk(bq.x * bflo(zz[p].z), bq.y * bfhi(zz[p].z)); w.w = cvtpk(bq.z * bflo(zz[p].w), bq.w * bfhi(zz[p].w));
        *(v4u*)(mix + (rowb + t0 + wid * 32 + row) * DM + h * 128 + c8) = w; }
}

struct PolWin {
    static constexpr bool SOFTMAX = true, KNORM = false, LANEPRED = false;
    const bf16 *Kb, *Vb; int t0, tile0, nt; const float* kgain;
    struct TI { int kb; };
    __device__ __forceinline__ int ntiles() const { return nt; }
    __device__ __forceinline__ TI tile(int t) const { return TI{64 * (tile0 + t)}; }
    __device__ __forceinline__ const bf16* krow(const TI& ti, int i) const { return Kb + (size_t)(ti.kb + i) * 128; }
    __device__ __forceinline__ const bf16* vrow(const TI& ti, int i) const { return Vb + (size_t)(ti.kb + i) * 128; }
    __device__ __forceinline__ bool active(const TI& ti, int wid) const { const int slo = t0 + 8 * wid; return ti.kb <= slo + 7 && ti.kb + 63 >= slo - 511; }
    __device__ __forceinline__ void mask(f32x16& p0, f32x16& p1, const TI& ti, int wid, int r32, int hi) const {
        const int slo = t0 + 8 * wid;
        if (ti.kb + 63 > slo || ti.kb < slo + 7 - 511) att::mask_tile(p0, p1, slo + (r32 >> 2) - ti.kb - 4 * hi, 512u);
    }
};
struct PolSel {
    static constexpr bool SOFTMAX = true, KNORM = false, LANEPRED = true;
    const bf16 *Kb, *Vb; int t0, cur; unsigned umask, wmask, sel; const float* kgain;
    struct TI { int kb, bit; };
    __device__ __forceinline__ int ntiles() const { return __builtin_popcount(umask); }
    __device__ __forceinline__ TI tile(int t) const { unsigned m = umask; for (int k = 0; k < t; ++k) m &= m - 1u; const int bit = __builtin_ctz(m); return TI{64 * bit, bit}; }
    __device__ __forceinline__ const bf16* krow(const TI& ti, int i) const { return Kb + (size_t)(ti.kb + i) * 128; }
    __device__ __forceinline__ const bf16* vrow(const TI& ti, int i) const { return Vb + (size_t)(ti.kb + i) * 128; }
    __device__ __forceinline__ bool active(const TI& ti, int wid) const { return (wmask >> ti.bit) & 1u; }
    __device__ __forceinline__ void mask(f32x16& p0, f32x16& p1, const TI& ti, int wid, int r32, int hi) const {
        const bool on = (sel >> ti.bit) & 1u;
        if (ti.bit == cur) {
            const int dq = on ? (t0 + 8 * wid + (r32 >> 2) - ti.kb - 4 * hi) : -100000;
            att::mask_tile(p0, p1, dq, 0x7fffffffu);
        } else if (!__all(on)) {
            const float NEG = -__builtin_inff();
#pragma unroll
            for (int r = 0; r < 16; ++r) { p0[r] = on ? p0[r] : NEG; p1[r] = on ? p1[r] : NEG; }
        }
    }
};
template <int VAR>
__device__ __forceinline__ void nsa_unit(Frame& F, int unit) {
    const int j = 31 - (unit >> 5), bg = unit & 31, b = bg >> 1, g = bg & 1;
    int tid = F.tid; asm volatile("" : "+v"(tid));
    const int wid = F.wave, lane = tid & 63, r32 = lane & 31, hi = lane >> 5;
    const int t0 = 64 * j, cur = j;
    const size_t rowb = (size_t)b * SEQ;
    const int tok = t0 + 8 * wid + (r32 >> 2), hd = g * 4 + (r32 & 3);
    LAS char* lds = (LAS char*)F.lds;
    LAS float* wsf = (LAS float*)(lds + att::OFF_WS) + wid * 256;
    LAS float* wsf3 = (LAS float*)(lds + att::OFF_WS3) + wid * 256;
    float* slab = (float*)(F.ws + WS_A) + (size_t)blockIdx.x * 65536;
#define NSA_LOADQ(qr_, zz_) do { const bf16* qp_ = hblk(F, CB_NQ + hd) + (rowb + tok + (size_t)(zz_)) * 128 + hi * 8; \
        _Pragma("unroll") for (int d0 = 0; d0 < 8; ++d0) qr_[d0] = *reinterpret_cast<const bf16x8*>(qp_ + d0 * 16); att::norm_q(qr_, F.in[5], hi); } while (0)
#define NSA_GATE(br_, zz_) sigmoidf_(bf2f(hblk(F, CB_NG)[(rowb + tok + (size_t)(zz_)) * 128 + (br_) * 8 + hd]))
    const int sr = tid >> 4, sc = (tid & 15) * 8;
    const int kws = KSWZ(sr, sc * 2), vst0 = att::v_st(sr, sc), vst1 = att::v_st(32 + sr, sc);
    const int vb0 = (int)(unsigned)(uintptr_t)(lds + att::OFF_V) + att::v_rd_base(lane);
    unsigned sel;
    sel = 0xffffffffu;
    if (!((DBG_SKIP | VAR) & 8)) {
        const bf16* kc = (const bf16*)(F.ws + WS_KCMP) + (size_t)(b * 2 + g) * 128 * 128;
        const bf16* vc = kc + (size_t)32 * 128 * 128;
        const bool two = t0 >= 992;
        att::Stage SC[2];
#pragma unroll
        for (int T = 0; T < 2; ++T) { if (T == 1 && !two) break;
            SC[T].k0 = *reinterpret_cast<const bf16x8*>(kc + (size_t)(64 * T + sr) * 128 + sc); SC[T].k1 = *reinterpret_cast<const bf16x8*>(kc + (size_t)(64 * T + 32 + sr) * 128 + sc);
            SC[T].v0 = *reinterpret_cast<const bf16x8*>(vc + (size_t)(64 * T + sr) * 128 + sc); SC[T].v1 = *reinterpret_cast<const bf16x8*>(vc + (size_t)(64 * T + 32 + sr) * 128 + sc); }
        bf16x8 qr[8]; NSA_LOADQ(qr, 0); const float g0 = NSA_GATE(0, 0);
#pragma unroll
        for (int T = 0; T < 2; ++T) { if (T == 1 && !two) break; att::stage_write(lds, T, SC[T], kws, vst0, vst1); }
        __syncthreads();
        const int nmax = (tok - 31) >> 4;
        const bool anyv = nmax >= 0;
        constexpr float C2 = 1.4426950408889634f * ATT_SCALE;
        const float bn0 = ((const float*)(F.ws + WS_MISC + FXB_OFF))[3];
        float mb;
        if (FX_NSA && bn0 <= att::FX_MAX) mb = anyv ? -bn0 * att::LOG2E : 0.f;
        else {
        float mx;
        { f32x16 p0, p1;
          att::qkt<0>(p0, p1, lds, r32, hi, qr); att::mask_tile(p0, p1, nmax - 4 * hi, 0x7fffffffu);
          mx = p0[0];
#pragma unroll
          for (int r = 0; r < 16; ++r) { mx = fmaxf(mx, p0[r]); mx = fmaxf(mx, p1[r]); }
          SBAR();
          if (two) { att::qkt<1>(p0, p1, lds, r32, hi, qr); att::mask_tile(p0, p1, nmax - 64 - 4 * hi, 0x7fffffffu);
#pragma unroll
              for (int r = 0; r < 16; ++r) { mx = fmaxf(mx, p0[r]); mx = fmaxf(mx, p1[r]); } }
          mx = fmaxf(mx, att::xhi_f(mx, hi)); }
        mb = anyv ? -mx * C2 : 0.f; }
        float sum = 0.f; float im[16], ls[16];
        f32x16 o[4] = {};
        SBAR();
        { f32x16 p0, p1; bf16x8 pa0, pa1, pa2, pa3;
          att::qkt<0>(p0, p1, lds, r32, hi, qr); att::mask_tile(p0, p1, nmax - 4 * hi, 0x7fffffffu);
#pragma unroll
          for (int r = 0; r < 16; ++r) { p0[r] = __builtin_amdgcn_exp2f(fmaf(p0[r], C2, mb)); p1[r] = __builtin_amdgcn_exp2f(fmaf(p1[r], C2, mb)); sum += p0[r] + p1[r]; }
#pragma unroll
          for (int q = 0; q < 4; ++q) { im[q] = (p0[4 * q] + p0[4 * q + 1]) + (p0[4 * q + 2] + p0[4 * q + 3]); ls[q] = p0[4 * q + 3];
              im[4 + q] = (p1[4 * q] + p1[4 * q + 1]) + (p1[4 * q + 2] + p1[4 * q + 3]); ls[4 + q] = p1[4 * q + 3]; }
          att::pack_p(p0, p1, pa0, pa1, pa2, pa3); SBAR(); att::pv_tile<0>(o, vb0, pa0, pa1, pa2, pa3); }
        SBAR();
        if (two) { f32x16 p0, p1; bf16x8 pa0, pa1, pa2, pa3;
          att::qkt<1>(p0, p1, lds, r32, hi, qr); att::mask_tile(p0, p1, nmax - 64 - 4 * hi, 0x7fffffffu);
#pragma unroll
          for (int r = 0; r < 16; ++r) { p0[r] = __builtin_amdgcn_exp2f(fmaf(p0[r], C2, mb)); p1[r] = __builtin_amdgcn_exp2f(fmaf(p1[r], C2, mb)); sum += p0[r] + p1[r]; }
#pragma unroll
          for (int q = 0; q < 4; ++q) { im[8 + q] = (p0[4 * q] + p0[4 * q + 1]) + (p0[4 * q + 2] + p0[4 * q + 3]); ls[8 + q] = p0[4 * q + 3];
              im[12 + q] = (p1[4 * q] + p1[4 * q + 1]) + (p1[4 * q + 2] + p1[4 * q + 3]); ls[12 + q] = p1[4 * q + 3]; }
          att::pack_p(p0, p1, pa0, pa1, pa2, pa3); SBAR(); att::pv_tile<1>(o, vb0, pa0, pa1, pa2, pa3); }
        else {
#pragma unroll
            for (int u = 8; u < 16; ++u) { im[u] = 0.f; ls[u] = 0.f; } }
        SBAR();
        sum += att::xhi_f(sum, hi);
        const float inv = (anyv && sum > 0.f) ? __builtin_amdgcn_rcpf(sum) : 0.f;
        { float f[16]; att::row_bcast(g0 * inv, wsf, r32, hi, f);
          int rl = r32, hl = hi; asm volatile("" : "+v"(rl), "+v"(hl));
#pragma unroll
          for (int r = 0; r < 16; ++r)
#pragma unroll
              for (int d = 0; d < 4; ++d) slab[(size_t)(wid * 32 + att::crow(r, hl)) * 128 + d * 32 + rl] = o[d][r] * f[r]; }
        SBAR();
        if (!((DBG_SKIP | VAR) & 1) && cur >= 16) {
            LAS float* Gs = (LAS float*)(lds + 73728 + wid * 3072); LAS float* Ls = Gs + 256; LAS float* Vs = Gs + 512;
            const int tl = r32 >> 2;
#pragma unroll
            for (int u = 0; u < 16; ++u) { float a = im[u] * inv, c = ls[u] * inv;
                a += __shfl_xor(a, 1); a += __shfl_xor(a, 2); c += __shfl_xor(c, 1); c += __shfl_xor(c, 2);
                if ((r32 & 3) == 0) { Gs[tl * 32 + 2 * u + hi] = a; Ls[tl * 32 + 2 * u + hi] = c; } }
            asm volatile("s_waitcnt lgkmcnt(0)" ::: "memory");
            int k4 = 4 * (2 * (r32 & 3) + hi); asm volatile("" : "+v"(k4));
            float my[4];
#pragma unroll
            for (int i = 0; i < 4; ++i) { const int jj = k4 + i; const float prev = jj > 0 ? Ls[tl * 32 + (jj > 0 ? jj - 1 : 0)] : 0.f;
                const float v = Gs[tl * 32 + jj] + prev; const bool forced = (jj == 0) || (jj == cur) || (jj == cur - 1);
                my[i] = forced ? 1e30f : (jj > cur ? -1e30f : v); }
            *(LAS f32x4*)(Vs + tl * 32 + k4) = (f32x4){my[0], my[1], my[2], my[3]};
            asm volatile("s_waitcnt lgkmcnt(0)" ::: "memory");
            int cnt[4] = {0, 0, 0, 0};
#pragma unroll
            for (int q = 0; q < 8; ++q) { const f32x4 c = *(const LAS f32x4*)(Vs + tl * 32 + 4 * q);
#pragma unroll
                for (int i = 0; i < 4; ++i) { const int jm = k4 + i;
                    cnt[i] += (int)(c.x > my[i]) | ((int)(c.x == my[i]) & (int)(4 * q + 0 < jm)); cnt[i] += (int)(c.y > my[i]) | ((int)(c.y == my[i]) & (int)(4 * q + 1 < jm));
                    cnt[i] += (int)(c.z > my[i]) | ((int)(c.z == my[i]) & (int)(4 * q + 2 < jm)); cnt[i] += (int)(c.w > my[i]) | ((int)(c.w == my[i]) & (int)(4 * q + 3 < jm)); } }
            unsigned bits = 0u;
#pragma unroll
            for (int i = 0; i < 4; ++i) if (cnt[i] < 16) bits |= 1u << (k4 + i);
            bits |= __shfl_xor(bits, 1); bits |= __shfl_xor(bits, 2); bits |= att::xhi_u(bits, hi);
            sel = bits & ((2u << cur) - 1u);
        } else {
            sel = (2u << cur) - 1u;
        }
        __syncthreads();
    }
    asm volatile("" : "+v"(sel));
    bool winpre = false;
    if (!((DBG_SKIP | VAR) & 2)) {
        unsigned wm = sel;
#pragma unroll
        for (int off = 1; off < 64; off <<= 1) wm |= __shfl_xor(wm, off);
        wm = __builtin_amdgcn_readfirstlane(wm);
        LAS unsigned* xs = (LAS unsigned*)(F.lds + XTRA_OFF);
        if (lane == 0) xs[wid] = wm;
        __syncthreads();
        unsigned um = 0u;
#pragma unroll
        for (int w = 0; w < 8; ++w) um |= xs[w];
        um = __builtin_amdgcn_readfirstlane(um);
        int z2 = 0; asm volatile("" : "+s"(z2));
        const size_t rb2 = rowb + (size_t)z2;
        PolSel P{hblk(F, CB_KS + g) + rb2 * 128, hblk(F, CB_VS + g) + rb2 * 128, t0, cur, um, wm, sel, F.in[6] + 128};
        const float bn = ((const float*)(F.ws + WS_MISC + FXB_OFF))[0];
        const bool fx2 = FX_NSA && bn <= att::FX_MAX;
        if (fx2) { int tp_ = tid; asm volatile("" : "+v"(tp_)); att::fxd_prefetch(P, lds, tp_); }
        bf16x8 qr[8]; NSA_LOADQ(qr, z2);
        f32x16 o[4] = {}; float f[16];
        if (fx2) {
            f32x16 lacc = {};
            { int tp_ = tid; asm volatile("" : "+v"(tp_)); att::att_pass_fxd<PolSel, true>(P, lds, qr, o, lacc, bn * att::LOG2E, tp_); }
            if (!((DBG_SKIP | VAR) & 4) && FX_NSA && ((const float*)(F.ws + WS_MISC + FXB_OFF))[1] <= att::FX_MAX) {
                const int tile0w = j > 8 ? j - 8 : 0;
                PolWin Pw{hblk(F, CB_KW + g) + rb2 * 128, hblk(F, CB_VW + g) + rb2 * 128, t0, tile0w, j - tile0w + 1, F.in[6] + 256};
                int tp_ = tid; asm volatile("" : "+v"(tp_)); att::fxd_prefetch(Pw, lds, tp_); winpre = true; }
            const float g1 = NSA_GATE(1, z2);
            att::row_bcast(g1, wsf3, r32, hi, f);
#pragma unroll
            for (int r = 0; r < 16; ++r) f[r] *= __builtin_amdgcn_rcpf(lacc[r]);
        } else {
            float m_reg = -1e30f, l_reg = 0.f;
            { int tp_ = tid; asm volatile("" : "+v"(tp_)); att::att_pass(P, lds, qr, o, m_reg, l_reg, tp_); }
            const float g1 = NSA_GATE(1, z2);
            att::row_bcast(g1 * __builtin_amdgcn_rcpf(l_reg), wsf, r32, hi, f);
        }
        int rl = r32, hl = hi; asm volatile("" : "+v"(rl), "+v"(hl));
#pragma unroll
        for (int r = 0; r < 16; ++r)
#pragma unroll
            for (int d = 0; d < 4; ++d) slab[32768 + (size_t)(wid * 32 + att::crow(r, hl)) * 128 + d * 32 + rl] = o[d][r] * f[r];
    }
    if (!((DBG_SKIP | VAR) & 4)) {
        const int tile0 = j > 8 ? j - 8 : 0;
        int z3 = 0; asm volatile("" : "+s"(z3));
        const size_t rb3 = rowb + (size_t)z3;
        bf16x8 qr[8]; NSA_LOADQ(qr, z3);
        PolWin P{hblk(F, CB_KW + g) + rb3 * 128, hblk(F, CB_VW + g) + rb3 * 128, t0, tile0, j - tile0 + 1, F.in[6] + 256};
        f32x16 o[4] = {}; float f[16];
        const float bn = ((const float*)(F.ws + WS_MISC + FXB_OFF))[1];
        if (FX_NSA && bn <= att::FX_MAX) {
            f32x16 lacc = {};
            if (!winpre) { int tp_ = tid; asm volatile("" : "+v"(tp_)); att::fxd_prefetch(P, lds, tp_); }
            { int tp_ = tid; asm volatile("" : "+v"(tp_)); att::att_pass_fxd<PolWin, true>(P, lds, qr, o, lacc, bn * att::LOG2E, tp_); }
            const float g2 = NSA_GATE(2, z3);
            att::row_bcast(g2, wsf3, r32, hi, f);
#pragma unroll
            for (int r = 0; r < 16; ++r) f[r] *= __builtin_amdgcn_rcpf(lacc[r]);
        } else {
            float m_reg = -1e30f, l_reg = 0.f;
            { int tp_ = tid; asm volatile("" : "+v"(tp_)); att::att_pass(P, lds, qr, o, m_reg, l_reg, tp_); }
            const float g2 = NSA_GATE(2, z3);
            att::row_bcast(g2 * __builtin_amdgcn_rcpf(l_reg), wsf, r32, hi, f);
        }
        bf16* mix = (bf16*)(F.ws + WS_MIX);
        int rl = r32, hl = hi; asm volatile("" : "+v"(rl), "+v"(hl));
        LAS float* st = (LAS float*)(F.lds + wid * 16384);
        __syncthreads();
#pragma unroll
        for (int r = 0; r < 16; ++r)
#pragma unroll
            for (int d = 0; d < 4; ++d) st[att::crow(r, hl) * 128 + d * 32 + rl] = o[d][r] * f[r];
        asm volatile("s_waitcnt lgkmcnt(0)" ::: "memory");
        int ll = lane; asm volatile("" : "+v"(ll));
        const int c8 = (ll & 15) * 8, rq = ll >> 4;
#pragma unroll
        for (int half = 0; half < 2; ++half) {
            asm volatile("" ::: "memory");
            f32x4 s0[4][2], s1[4][2]; v4u zz[4];
#pragma unroll
            for (int p = 0; p < 4; ++p) { const int row = 4 * (4 * half + p) + rq; const int tk = t0 + 8 * wid + (row >> 2), hh = g * 4 + (row & 3);
                const float* sp = slab + (size_t)(wid * 32 + row) * 128 + c8;
                s0[p][0] = *(const f32x4*)sp; s0[p][1] = *(const f32x4*)(sp + 4); s1[p][0] = *(const f32x4*)(sp + 32768); s1[p][1] = *(const f32x4*)(sp + 32768 + 4);
                zz[p] = *(const v4u*)(hblk(F, CB_NZ + hh) + (rb3 + tk) * 128 + c8); }
#pragma unroll
            for (int p = 0; p < 4; ++p) { const int row = 4 * (4 * half + p) + rq; const int tk = t0 + 8 * wid + (row >> 2), hh = g * 4 + (row & 3);
                const f32x4 a = *(const LAS f32x4*)(st + row * 128 + c8) + s0[p][0] + s1[p][0], bq = *(const LAS f32x4*)(st + row * 128 + c8 + 4) + s0[p][1] + s1[p][1];
                v4u w; w.x = cvtpk(a.x * bflo(zz[p].x), a.y * bfhi(zz[p].x)); w.y = cvtpk(a.z * bflo(zz[p].y), a.w * bfhi(zz[p].y));
                w.z = cvtpk(bq.x * bflo(zz[p].z), bq.y * bfhi(zz[p].z)); w.w = cvtpk(bq.z * bflo(zz[p].w), bq.w * bfhi(zz[p].w));
                if (VAR == 0) *(v4u*)(mix + (rb3 + tk) * DM + 1024 + hh * 128 + c8) = w; else if (w.x == 0x12345678u) F.MISC[21] = 1u; }
        }
    }
#undef NSA_LOADQ
#undef NSA_GATE
}

__device__ __forceinline__ float wave_sum_dpp(float v) {
    v = att::row16_sum(v);
    const float a = __builtin_bit_cast(float, __builtin_amdgcn_readlane(__builtin_bit_cast(int, v), 0)), b = __builtin_bit_cast(float, __builtin_amdgcn_readlane(__builtin_bit_cast(int, v), 16));
    const float c = __builtin_bit_cast(float, __builtin_amdgcn_readlane(__builtin_bit_cast(int, v), 32)), d = __builtin_bit_cast(float, __builtin_amdgcn_readlane(__builtin_bit_cast(int, v), 48));
    return (a + b) + (c + d);
}
constexpr int CFR = 2;
__device__ __forceinline__ void conv_finalize_rows(Frame& F, size_t m0, int n, int lane) {
    bf16* mix = (bf16*)(F.ws + WS_MIX);
    float g[16], bb[16];
#pragma unroll
    for (int q = 0; q < 4; ++q) { const f32x4 a = *(const f32x4*)(F.in[18] + 16 * lane + 4 * q), c = *(const f32x4*)(F.in[19] + 16 * lane + 4 * q);
        g[4 * q] = a.x; g[4 * q + 1] = a.y; g[4 * q + 2] = a.z; g[4 * q + 3] = a.w; bb[4 * q] = c.x; bb[4 * q + 1] = c.y; bb[4 * q + 2] = c.z; bb[4 * q + 3] = c.w; }
    const bf16* czb = hblk(F, CB_CZ + (lane >> 3)) + (lane & 7) * 16;
#pragma unroll 1
    for (int r0 = 0; r0 < n; r0 += CFR) {
        v4u yq[CFR][2], zq[CFR][2];
#pragma unroll
        for (int j = 0; j < CFR; ++j) { const size_t m = m0 + r0 + j; const v4u* yp = (const v4u*)(mix + m * K1OUT + 16 * lane);
            yq[j][0] = yp[0]; yq[j][1] = yp[1]; zq[j][0] = *(const v4u*)(czb + m * 128); zq[j][1] = *(const v4u*)(czb + m * 128 + 8); }
#pragma unroll
        for (int j = 0; j < CFR; ++j) { const size_t m = m0 + r0 + j; const v4u y0 = yq[j][0], y1 = yq[j][1], z0 = zq[j][0], z1 = zq[j][1];
            float y[16] = {bflo(y0.x), bfhi(y0.x), bflo(y0.y), bfhi(y0.y), bflo(y0.z), bfhi(y0.z), bflo(y0.w), bfhi(y0.w), bflo(y1.x), bfhi(y1.x), bflo(y1.y), bfhi(y1.y), bflo(y1.z), bfhi(y1.z), bflo(y1.w), bfhi(y1.w)};
            const float z[16] = {bflo(z0.x), bfhi(z0.x), bflo(z0.y), bfhi(z0.y), bflo(z0.z), bfhi(z0.z), bflo(z0.w), bfhi(z0.w), bflo(z1.x), bfhi(z1.x), bflo(z1.y), bfhi(z1.y), bflo(z1.z), bfhi(z1.z), bflo(z1.w), bfhi(z1.w)};
            float s = 0.f;
#pragma unroll
            for (int e = 0; e < 16; ++e) s += y[e];
            const float mu = wave_sum_dpp(s) * (1.f / 1024.f);
            float q = 0.f;
#pragma unroll
            for (int e = 0; e < 16; ++e) { y[e] -= mu; q += y[e] * y[e]; }
            const float rstd = __builtin_amdgcn_rsqf(wave_sum_dpp(q) * (1.f / 1024.f) + NORM_EPS);
            float o[16];
#pragma unroll
            for (int e = 0; e < 16; ++e) o[e] = siluf_(y[e] * rstd * g[e] + bb[e]) * z[e];
            v4u w0, w1;
            w0.x = cvtpk(o[0], o[1]); w0.y = cvtpk(o[2], o[3]); w0.z = cvtpk(o[4], o[5]); w0.w = cvtpk(o[6], o[7]);
            w1.x = cvtpk(o[8], o[9]); w1.y = cvtpk(o[10], o[11]); w1.z = cvtpk(o[12], o[13]); w1.w = cvtpk(o[14], o[15]);
            v4u* yo = (v4u*)(mix + m * K1OUT + 16 * lane); yo[0] = w0; yo[1] = w1; }
    }
}
__device__ __forceinline__ void conv_finalize_rows4(Frame& F, size_t m0, int n, int lane, LAS float* gb) {
    bf16* mix = (bf16*)(F.ws + WS_MIX);
#pragma unroll
    for (int q = 0; q < 4; ++q) { *(LAS f32x4*)(gb + q * 256 + lane * 4) = *(const f32x4*)(F.in[18] + 16 * lane + 4 * q); *(LAS f32x4*)(gb + (4 + q) * 256 + lane * 4) = *(const f32x4*)(F.in[19] + 16 * lane + 4 * q); }
    const bf16* czb = hblk(F, CB_CZ + (lane >> 3)) + (lane & 7) * 16;
#pragma unroll 1
    for (int r0 = 0; r0 < n; r0 += 4) {
        v4u yq[4][2], zq[4][2];
#pragma unroll
        for (int j = 0; j < 4; ++j) { const size_t m = m0 + r0 + j; const v4u* yp = (const v4u*)(mix + m * K1OUT + 16 * lane);
            yq[j][0] = yp[0]; yq[j][1] = yp[1]; zq[j][0] = *(const v4u*)(czb + m * 128); zq[j][1] = *(const v4u*)(czb + m * 128 + 8); }
#pragma unroll
        for (int j = 0; j < 4; ++j) { const size_t m = m0 + r0 + j; const v4u y0 = yq[j][0], y1 = yq[j][1], z0 = zq[j][0], z1 = zq[j][1];
            float y[16] = {bflo(y0.x), bfhi(y0.x), bflo(y0.y), bfhi(y0.y), bflo(y0.z), bfhi(y0.z), bflo(y0.w), bfhi(y0.w), bflo(y1.x), bfhi(y1.x), bflo(y1.y), bfhi(y1.y), bflo(y1.z), bfhi(y1.z), bflo(y1.w), bfhi(y1.w)};
            const unsigned zw[8] = {z0.x, z0.y, z0.z, z0.w, z1.x, z1.y, z1.z, z1.w};
            float s = 0.f;
#pragma unroll
            for (int e = 0; e < 16; ++e) s += y[e];
            const float mu = wave_sum_dpp(s) * (1.f / 1024.f);
            float q = 0.f;
#pragma unroll
            for (int e = 0; e < 16; ++e) { y[e] -= mu; q += y[e] * y[e]; }
            const float rstd = __builtin_amdgcn_rsqf(wave_sum_dpp(q) * (1.f / 1024.f) + NORM_EPS);
            unsigned w[8];
#pragma unroll
            for (int qd = 0; qd < 4; ++qd) { const f32x4 g4 = *(const LAS f32x4*)(gb + qd * 256 + lane * 4), b4 = *(const LAS f32x4*)(gb + (4 + qd) * 256 + lane * 4);
                const float o0 = siluf_(y[4 * qd] * rstd * g4.x + b4.x) * bflo(zw[2 * qd]), o1 = siluf_(y[4 * qd + 1] * rstd * g4.y + b4.y) * bfhi(zw[2 * qd]);
                const float o2 = siluf_(y[4 * qd + 2] * rstd * g4.z + b4.z) * bflo(zw[2 * qd + 1]), o3 = siluf_(y[4 * qd + 3] * rstd * g4.w + b4.w) * bfhi(zw[2 * qd + 1]);
                w[2 * qd] = cvtpk(o0, o1); w[2 * qd + 1] = cvtpk(o2, o3); }
            v4u* yo = (v4u*)(mix + m * K1OUT + 16 * lane); yo[0] = (v4u){w[0], w[1], w[2], w[3]}; yo[1] = (v4u){w[4], w[5], w[6], w[7]}; __builtin_amdgcn_sched_barrier(0); }
    }
}
__device__ __forceinline__ void conv_dma_rows(Frame& F, LAS unsigned char* at, size_t rowb, int T0, int tok0, int nrows, int wid, int lane) {
    for (int r = wid; r < nrows; r += NWAVES) { const int s = tok0 + r; LAS unsigned char* dst = at + ((s - T0 + 32) & 63) * 2048;
#pragma unroll
        for (int h = 0; h < 2; ++h) { const int chunk = h * 64 + lane;
            __builtin_amdgcn_global_load_lds((const unsigned*)(hblk(F, chunk >> 4) + (rowb + s) * 128 + (chunk & 15) * 8), (LAS unsigned*)(dst + h * 1024), 16, 0, 0); } }
}
template <int VAR>
__device__ __forceinline__ void conv_unit(Frame& F, int unit) {
    const int b = unit >> 4, T0 = (unit & 15) * 128;
    int tid = F.tid; asm volatile("" : "+v"(tid));
    const int wid = F.wave, lane = tid & 63;
    const size_t rowb = (size_t)b * SEQ;
    LAS unsigned char* at = F.lds;
    int c0 = 2 * tid; asm volatile("" : "+v"(c0));
    if (T0 == 0) { for (int idx = tid; idx < 30 * 128; idx += NTHREADS) *(LAS v4u*)(at + (((idx >> 7) - 30 + 32) & 63) * 2048 + (idx & 127) * 16) = (v4u){0u, 0u, 0u, 0u}; }
    else conv_dma_rows(F, at, rowb, T0, T0 - 30, 30, wid, lane);
    conv_dma_rows(F, at, rowb, T0, T0, 16, wid, lane);
    f32x2 ww[31];
    { const float* dw = F.in[16];
#pragma unroll
      for (int k = 0; k < 31; ++k) ww[k] = *(const f32x2*)(dw + (size_t)k * 1024 + c0); }
    const f32x2 bias = *(const f32x2*)(F.in[17] + c0);
    bf16* mix = (bf16*)(F.ws + WS_MIX);
#pragma unroll 1
    for (int st = 0; st < 8; ++st) {
        const int t0 = T0 + 16 * st;
        if (st == 0) asm volatile("s_waitcnt vmcnt(0) lgkmcnt(0)" ::: "memory");
        else asm volatile("s_waitcnt vmcnt(16) lgkmcnt(0)" ::: "memory");
        __syncthreads();
        if (st < 7) conv_dma_rows(F, at, rowb, T0, t0 + 16, 16, wid, lane);
        f32x2 yy[16];
#pragma unroll
        for (int i = 0; i < 16; ++i) yy[i] = bias;
        const int rb = 16 * st + 2;
#pragma unroll
        for (int jr = 0; jr < ((VAR & 2) ? 0 : 46); ++jr) {
            const unsigned w = *(const LAS unsigned*)(at + ((rb + jr) & 63) * 2048 + c0 * 2); const f32x2 a = (f32x2){bflo(w), bfhi(w)};
#pragma unroll
            for (int i = 0; i < 16; ++i) { const int k = jr - i; if (k >= 0 && k <= 30) yy[i] = __builtin_elementwise_fma(a, ww[k], yy[i]); }
        }
#pragma unroll
        for (int i = 0; i < 16; ++i) { if (VAR == 0) *(unsigned*)(mix + (rowb + t0 + i) * K1OUT + c0) = cvtpk(yy[i].x, yy[i].y);
            else if (yy[i].x == 12345.678f) at[0] = 1; }
    }
    asm volatile("s_waitcnt vmcnt(0)" ::: "memory");
    __syncthreads();
    if (VAR == 0 && CONV_FIN_IN_UNIT) { int l2 = tid & 63; asm volatile("" : "+v"(l2)); conv_finalize_rows4(F, rowb + T0 + 16 * wid, 16, l2, (LAS float*)(F.lds + wid * 16384)); }
}
__device__ __forceinline__ void conv_finalize(Frame& F) {
    const int gw = blockIdx.x * NWAVES + F.wave, NGW = F.G * NWAVES, lane = F.lane;
    bf16* mix = (bf16*)(F.ws + WS_MIX);
    float g[16], bb[16];
#pragma unroll
    for (int q = 0; q < 4; ++q) { const f32x4 a = *(const f32x4*)(F.in[18] + 16 * lane + 4 * q), c = *(const f32x4*)(F.in[19] + 16 * lane + 4 * q);
        g[4 * q] = a.x; g[4 * q + 1] = a.y; g[4 * q + 2] = a.z; g[4 * q + 3] = a.w; bb[4 * q] = c.x; bb[4 * q + 1] = c.y; bb[4 * q + 2] = c.z; bb[4 * q + 3] = c.w; }
    const bf16* czb = hblk(F, CB_CZ + (lane >> 3)) + (lane & 7) * 16;
    for (int m = gw; m < MROWS; m += NGW) {
        v4u* yp = (v4u*)(mix + (size_t)m * K1OUT + 16 * lane);
        const v4u y0 = yp[0], y1 = yp[1]; const v4u z0 = *(const v4u*)(czb + (size_t)m * 128), z1 = *(const v4u*)(czb + (size_t)m * 128 + 8);
        float y[16] = {bflo(y0.x), bfhi(y0.x), bflo(y0.y), bfhi(y0.y), bflo(y0.z), bfhi(y0.z), bflo(y0.w), bfhi(y0.w), bflo(y1.x), bfhi(y1.x), bflo(y1.y), bfhi(y1.y), bflo(y1.z), bfhi(y1.z), bflo(y1.w), bfhi(y1.w)};
        const float z[16] = {bflo(z0.x), bfhi(z0.x), bflo(z0.y), bfhi(z0.y), bflo(z0.z), bfhi(z0.z), bflo(z0.w), bfhi(z0.w), bflo(z1.x), bfhi(z1.x), bflo(z1.y), bfhi(z1.y), bflo(z1.z), bfhi(z1.z), bflo(z1.w), bfhi(z1.w)};
        float s = 0.f;
#pragma unroll
        for (int e = 0; e < 16; ++e) s += y[e];
        const float mu = wave_sum_dpp(s) * (1.f / 1024.f);
        float q = 0.f;
#pragma unroll
        for (int e = 0; e < 16; ++e) { y[e] -= mu; q += y[e] * y[e]; }
        const float rstd = __builtin_amdgcn_rsqf(wave_sum_dpp(q) * (1.f / 1024.f) + NORM_EPS);
        float o[16];
#pragma unroll
        for (int e = 0; e < 16; ++e) o[e] = siluf_(y[e] * rstd * g[e] + bb[e]) * z[e];
        v4u w0, w1;
        w0.x = cvtpk(o[0], o[1]); w0.y = cvtpk(o[2], o[3]); w0.z = cvtpk(o[4], o[5]); w0.w = cvtpk(o[6], o[7]);
        w1.x = cvtpk(o[8], o[9]); w1.y = cvtpk(o[10], o[11]); w1.z = cvtpk(o[12], o[13]); w1.w = cvtpk(o[14], o[15]);
        yp[0] = w0; yp[1] = w1;
    }
}

struct PolDil {
    static constexpr bool SOFTMAX = true, KNORM = true, LANEPRED = false;
    const bf16 *Kb, *Vb; int mul, addA, addB, tile0, ntc, q0; bool two; const float* kgain;
    struct TI { int kb, cls; };
    __device__ __forceinline__ int ntiles() const { return two ? 2 * ntc : ntc; }
    __device__ __forceinline__ TI tile(int t) const { const int cls = (two && t >= ntc) ? 1 : 0; return TI{64 * (tile0 + t - cls * ntc), cls}; }
    __device__ __forceinline__ const bf16* krow(const TI& ti, int i) const { return Kb + (size_t)(mul * (ti.kb + i) + (ti.cls ? addB : addA)) * 128; }
    __device__ __forceinline__ const bf16* vrow(const TI& ti, int i) const { return Vb + (size_t)(mul * (ti.kb + i) + (ti.cls ? addB : addA)) * 128; }
    __device__ __forceinline__ int qlo(int wid) const { return q0 + 32 * (two ? (wid & 3) : wid); }
    __device__ __forceinline__ bool active(const TI& ti, int wid) const { const int ql = qlo(wid); return (!two || (wid >> 2) == ti.cls) && ti.kb <= ql + 31 && ti.kb + 63 >= ql - 128; }
    __device__ __forceinline__ void mask(f32x16& p0, f32x16& p1, const TI& ti, int wid, int r32, int hi) const {
        const int ql = qlo(wid);
        if (ti.kb + 63 > ql || ti.kb < ql + 31 - 128) att::mask_tile(p0, p1, ql + r32 - ti.kb - 4 * hi, 129u);
    }
};
template <bool FX>
__device__ __forceinline__ void dil_unit(Frame& F, int unit) {
    const int typ = unit >> 9, u = unit & 511;
    int tid = F.tid; asm volatile("" : "+v"(tid));
    const int wid = F.wave, lane = tid & 63, r32 = lane & 31, hi = lane >> 5;
    int b, slot, mul, addA, addB = 0, q0, tile0, ntc; bool two = false;
    if (typ == 0) { b = u >> 5; slot = (u >> 3) & 3; const int qb = u & 7; mul = 1; addA = 0; q0 = 256 * qb; tile0 = qb ? 4 * qb - 2 : 0; ntc = 4 * qb + 4 - tile0; }
    else if (typ == 1) { b = u >> 5; slot = (u >> 3) & 3; const int c4 = (u >> 1) & 3, qb = u & 1; mul = 4; addA = c4; q0 = 256 * qb; tile0 = qb ? 2 : 0; ntc = 4 * qb + 4 - tile0; }
    else { b = u >> 5; slot = (u >> 3) & 3; const int pr = u & 7; mul = 16; addA = 2 * pr; addB = 2 * pr + 1; q0 = 0; tile0 = 0; ntc = 2; two = true; }
    const int head = typ * 4 + slot;
    const size_t rowb = (size_t)b * SEQ;
    PolDil P{hblk(F, CB_DK + head) + rowb * 128, hblk(F, CB_DV + head) + rowb * 128, mul, addA, addB, tile0, ntc, q0, two, F.in[21]};
    const int qpos = P.qlo(wid) + r32, cls = two ? (wid >> 2) : 0;
    const int tok = mul * qpos + (cls ? addB : addA);
    bf16x8 qr[8];
    { const bf16* qp = hblk(F, CB_DQ + head) + (rowb + tok) * 128 + hi * 8;
#pragma unroll
      for (int d0 = 0; d0 < 8; ++d0) qr[d0] = *reinterpret_cast<const bf16x8*>(qp + d0 * 16); }
    att::Stage S0, S1;
    if constexpr (FX) att::stage_prefetch(P, S0, S1, tid);
    att::norm_q(qr, F.in[20], hi);
    f32x16 o[4] = {}; float f[16];
    float* lse = (float*)(F.ws + WS_DLSE) + (size_t)typ * MROWS * 4;
    const int qbase = P.qlo(wid);
    const float bn = ((const float*)(F.ws + WS_MISC + FXB_OFF))[2];
    if constexpr (FX) {
        f32x16 lacc = {};
        att::att_pass_fx_pre<PolDil, DIL_KG_RES != 0>(P, (LAS char*)F.lds, qr, o, lacc, bn * att::LOG2E, tid, S0, S1);
        int rl0 = r32, hl0 = hi; asm volatile("" : "+v"(rl0), "+v"(hl0));
#pragma unroll
        for (int r = 0; r < 16; ++r) { f[r] = __builtin_amdgcn_rcpf(lacc[r]);
            if (rl0 == 0) lse[(rowb + mul * (qbase + att::crow(r, hl0)) + (cls ? addB : addA)) * 4 + slot] = bn + __builtin_amdgcn_logf(lacc[r]) * 0.6931471805599453f; }
    } else {
        float m_reg = -1e30f, l_reg = 0.f;
        att::att_pass(P, (LAS char*)F.lds, qr, o, m_reg, l_reg, tid);
        LAS float* wsf = (LAS float*)(F.lds + att::OFF_WS) + wid * 256;
        att::row_bcast(__builtin_amdgcn_rcpf(l_reg), wsf, r32, hi, f);
        if (hi == 0) lse[(rowb + tok) * 4 + slot] = m_reg * ATT_SCALE + __builtin_amdgcn_logf(l_reg) * 0.6931471805599453f;
    }
    bf16* part = (bf16*)(F.ws + WS_DPART) + (size_t)typ * MROWS * 512;
    int rl = r32, hl = hi; asm volatile("" : "+v"(rl), "+v"(hl));
    if constexpr (FX) {
        LAS float* st = (LAS float*)(F.lds + wid * 16384);
#pragma unroll
        for (int r = 0; r < 16; ++r)
#pragma unroll
            for (int d = 0; d < 4; ++d) st[att::crow(r, hl) * 128 + d * 32 + rl] = o[d][r] * f[r];
        asm volatile("s_waitcnt lgkmcnt(0)" ::: "memory");
        int ll = tid & 63; asm volatile("" : "+v"(ll));
        const int c8 = (ll & 15) * 8, rq = ll >> 4;
#pragma unroll
        for (int p = 0; p < 8; ++p) { const int row = 4 * p + rq; const int tk = mul * (qbase + row) + (cls ? addB : addA);
            const f32x4 a = *(const LAS f32x4*)(st + row * 128 + c8), bq = *(const LAS f32x4*)(st + row * 128 + c8 + 4);
            v4u w; w.x = cvtpk(a.x, a.y); w.y = cvtpk(a.z, a.w); w.z = cvtpk(bq.x, bq.y); w.w = cvtpk(bq.z, bq.w);
            *(v4u*)(part + (rowb + tk) * 512 + slot * 128 + c8) = w; }
    } else {
#pragma unroll
    for (int r = 0; r < 16; ++r) { const int tk = mul * (qbase + att::crow(r, hl)) + (cls ? addB : addA);
#pragma unroll
        for (int d = 0; d < 4; ++d) { const float v = o[d][r] * f[r]; const float vn = __shfl_xor(v, 1);
            if ((rl & 1) == 0) *(unsigned*)(part + (rowb + tk) * 512 + slot * 128 + d * 32 + rl) = cvtpk(v, vn); } }
    }
}
__device__ __forceinline__ void dil_combine(Frame& F) {
    const bf16* part = (const bf16*)(F.ws + WS_DPART); const float* lse = (const float*)(F.ws + WS_DLSE);
    bf16* mix = (bf16*)(F.ws + WS_MIX);
    const size_t NE = (size_t)MROWS * 64, ST = (size_t)F.G * NTHREADS;
    for (size_t e0 = (size_t)blockIdx.x * NTHREADS + F.tid; e0 < NE; e0 += 2 * ST) {
        float l0[2], l1[2], l2[2]; v4u a[2], bq[2], cq[2], z[2]; bool ok[2];
#pragma unroll
        for (int u = 0; u < 2; ++u) { const size_t e = e0 + u * ST; ok[u] = e < NE; const size_t ee = ok[u] ? e : e0;
            const size_t m = ee >> 6; const int ch = (int)(ee & 63), slot = ch >> 4, c = (ch & 15) * 8;
            l0[u] = lse[m * 4 + slot]; l1[u] = lse[(size_t)MROWS * 4 + m * 4 + slot]; l2[u] = lse[(size_t)2 * MROWS * 4 + m * 4 + slot];
            a[u] = *(const v4u*)(part + m * 512 + slot * 128 + c); bq[u] = *(const v4u*)(part + (size_t)MROWS * 512 + m * 512 + slot * 128 + c); cq[u] = *(const v4u*)(part + (size_t)2 * MROWS * 512 + m * 512 + slot * 128 + c);
            z[u] = *(const v4u*)(hblk(F, CB_DZ + slot) + m * 128 + c); }
#pragma unroll
        for (int u = 0; u < 2; ++u) { const size_t e = e0 + u * ST; if (!ok[u]) continue;
            const size_t m = e >> 6; const int ch = (int)(e & 63), slot = ch >> 4, c = (ch & 15) * 8;
            const float mx = fmaxf(l0[u], fmaxf(l1[u], l2[u]));
            float w0 = fast_exp(l0[u] - mx), w1 = fast_exp(l1[u] - mx), w2 = fast_exp(l2[u] - mx);
            const float inv = 1.0f / (w0 + w1 + w2); w0 *= inv; w1 *= inv; w2 *= inv;
            v4u o;
#define DC_(X) cvtpk((w0 * bflo(a[u].X) + w1 * bflo(bq[u].X) + w2 * bflo(cq[u].X)) * bflo(z[u].X), (w0 * bfhi(a[u].X) + w1 * bfhi(bq[u].X) + w2 * bfhi(cq[u].X)) * bfhi(z[u].X))
            o.x = DC_(x); o.y = DC_(y); o.z = DC_(z); o.w = DC_(w);
#undef DC_
            *(v4u*)(mix + m * K1OUT + 1024 + slot * 128 + c) = o; }
    }
}

constexpr int N_PHASES = 12;
struct Args { const float* in[22]; float* out; unsigned char* ws; int ph_lo, ph_hi; };
__global__ void __launch_bounds__(NTHREADS, 2) hybrid_fwd(Args args) {
    extern __shared__ __attribute__((aligned(16))) unsigned char lds_raw[];
    Frame F;
    F.lds = (LAS unsigned char*)lds_raw;
    F.MISC = (volatile LAS unsigned*)(F.lds + LDSCTL_OFF);
    F.tid = threadIdx.x; F.lane = F.tid & 63; F.wave = __builtin_amdgcn_readfirstlane(F.tid >> 6);
    F.G = gridDim.x; F.ws = args.ws; F.ctl = (gu32*)(args.ws + WS_CTL); F.out = args.out;
#pragma unroll
    for (int i = 0; i < 22; ++i) F.in[i] = args.in[i];
    for (int u = F.tid; u < 256; u += NTHREADS) ((LAS unsigned*)(F.lds + LDSCTL_OFF))[u] = 0u;
    __syncthreads();
    XcdBarrier bar = xcd_barrier_post((unsigned*)(F.ctl + CW_BAR), F.MISC + 8);
    const int lo = args.ph_lo, hi = args.ph_hi;
#ifndef PH_MASK
#define PH_MASK 0xFFF
#endif
#define INR(k) (lo <= (k) && (k) < hi)
#define IN(k) (((PH_MASK >> (k)) & 1) && INR(k))
#ifndef REPEAT_MASK
#define REPEAT_MASK 0
#endif
#ifndef REP8_SKIP
#define REP8_SKIP 0
#endif
#ifndef CONV_VAR
#define CONV_VAR 0
#endif
#ifndef RET_VAR
#define RET_VAR 0
#endif
#ifndef NSA_VAR
#define NSA_VAR 0
#endif
#define NREP(k) (((REPEAT_MASK >> (k)) & 1) ? 2 : 1)
#define SEAM(k) do { if (INR(k) && INR((k) + 1)) xcd_barrier(bar); } while (0)
    bf16* XN = (bf16*)(F.ws + WS_A);
    bf16* MIX = (bf16*)(F.ws + WS_MIX);

    const bool fold = FOLD_P2 && F.G == 256 && lo <= 0 && hi > 2;
    const bool defer3 = DEFER_P3 && lo <= 0 && hi > 3;
    if (IN(0)) { p0_prologue(F, defer3 ? P0_DEFER3 : ((fold && DEFER_W1) ? P0_DEFER : 0)); }
#if (REPEAT_MASK >> 0) & 1
    xcd_barrier(bar); if (IN(0)) { p0_prologue<P0_REP_SKIP>(F); }
#endif
    SEAM(0);
    if (IN(1)) {
        gu32* kv_done = F.ctl + CW_Q + 64 * 22;
        pg8::Gemm g{XN, (const bf16*)(F.ws + WS_W0IN), MROWS, N0, DM}; pg8::NotifyOrder S; S.init(MROWS, N0, F.G, (int)blockIdx.x);
        S.cnt = (unsigned*)kv_done; S.mask = fold ? ((1u << 20) | (1u << 21) | (1u << 22) | (1u << 24)) : 0u;
        pg8::EpiH E{hblk(F, 0), HBLK, CB_RZ, CB_RZ + 8, CB_NZ, CB_NZ + 8, (const float*)(F.ws + WS_MISC + ROPE_OFF), 16};
        pg8::gemm_phase<pg8::EpiH, pg8::NotifyOrder, true, true>(F.lds, g, S, E);
        if (fold && blockIdx.x >= 128) {
            if (F.tid < 64) {
                unsigned sp = 0;
                while ((unsigned)__builtin_amdgcn_readfirstlane(__hip_atomic_load(kv_done, RLX_AGENT)) < 512u) { __builtin_amdgcn_s_sleep(2); if (++sp > (1u << 22)) break; }
                __builtin_amdgcn_fence(__ATOMIC_ACQUIRE, "agent");
                asm volatile("s_waitcnt vmcnt(0)" ::: "memory");
            }
            __syncthreads();
            if (blockIdx.x < 192) {
                const int ix = (int)blockIdx.x - 128, kv = ix >> 5, kh = (ix >> 4) & 1;
                pg8::Gemm g2{hblk(F, kv ? CB_VC : CB_KC) + kh * 1024, (const bf16*)(F.ws + WS_CW) + (size_t)kv * 256 * 2048 + kh * 1024, 4096, 256, 2048, 16}; pg8::StaticOrder S2; S2.init(4096, 256, 16, ix & 15);
                pg8::EpiF32 E2{(float*)(F.ws + (kh ? WS_CPR2 : WS_CPR)) + (size_t)kv * 4096 * 256, 256};
                pg8::gemm_phase<pg8::EpiF32, pg8::StaticOrder, false, true>(F.lds, g2, S2, E2);
                if (CT_IN_TAIL) {
                    asm volatile("s_waitcnt vmcnt(0)" ::: "memory");
                    __syncthreads();
                    if (F.tid == 0) { __threadfence(); __hip_atomic_fetch_add(F.ctl + CW_Q + 64 * 23, 1u, RLX_AGENT); }
                }
            }
            for (int it = wq_first(F, 0); it < 4 * 128;) {
                const unsigned nx = wq_issue(F, 0);
                const int bi = it >> 7, row0 = (it & 127) * 256;
                if (bi < 2) rowop_item<1>(hblk(F, CB_KS + bi), row0, F.in[6] + 128, nullptr, F.tid);
                else rowop_item<1>(hblk(F, CB_KW + bi - 2), row0, F.in[6] + 256, nullptr, F.tid);
                it = wq_take(F, nx);
            }
            if (CT_IN_TAIL) {
                gu32* cg_done = F.ctl + CW_Q + 64 * 23;
                if (F.tid < 64) {
                    unsigned sp = 0;
                    while ((unsigned)__builtin_amdgcn_readfirstlane(__hip_atomic_load(cg_done, RLX_AGENT)) < 64u) { __builtin_amdgcn_s_sleep(2); if (++sp > (1u << 22)) break; }
                    __builtin_amdgcn_fence(__ATOMIC_ACQUIRE, "agent");
                    asm volatile("s_waitcnt vmcnt(0)" ::: "memory");
                }
                __syncthreads();
                cmp_tail_unit(F, (int)blockIdx.x - 128);
                __syncthreads();
                cmp_tail_unit(F, (int)blockIdx.x);
                __syncthreads();
            }
            if (DEFER_W1) p0_weight_items(F, P0_NITEMS - P0_DEFER + ((int)blockIdx.x - 128) * NWAVES + F.wave, P0_NITEMS, 128 * NWAVES, F.lane);
        }
    }
#if (REPEAT_MASK >> 1) & 1
    xcd_barrier(bar);
    if (IN(1)) {
        pg8::Gemm g{XN, (const bf16*)(F.ws + WS_W0IN), MROWS, N0, DM}; pg8::StaticOrder S; S.init(MROWS, N0, F.G, (int)blockIdx.x);
        pg8::EpiH E{hblk(F, 0), HBLK, CB_RZ, CB_RZ + 8, CB_NZ, CB_NZ + 8, (const float*)(F.ws + WS_MISC + ROPE_OFF), 16};
        pg8::gemm_phase<pg8::EpiH, pg8::StaticOrder, true, true>(F.lds, g, S, E);
    }
#endif
    SEAM(1);
    if (IN(2) && !fold) {
        if (blockIdx.x < 64 && F.G >= 64) {
            const int kv = blockIdx.x >> 5, kh = (blockIdx.x >> 4) & 1;
            pg8::Gemm g{hblk(F, kv ? CB_VC : CB_KC) + kh * 1024, (const bf16*)(F.ws + WS_CW) + (size_t)kv * 256 * 2048 + kh * 1024, 4096, 256, 2048, 16}; pg8::StaticOrder S; S.init(4096, 256, 16, (int)(blockIdx.x & 15));
            pg8::EpiF32 E{(float*)(F.ws + (kh ? WS_CPR2 : WS_CPR)) + (size_t)kv * 4096 * 256, 256};
            pg8::gemm_phase<pg8::EpiF32, pg8::StaticOrder, false, true>(F.lds, g, S, E);
        }
        const float* rope = (const float*)(F.ws + WS_MISC + ROPE_OFF);
        constexpr int NITEM = 4 * 128;
        for (int it = wq_first(F, 0); it < NITEM;) {
            const unsigned nx = wq_issue(F, 0);
            const int bi = it >> 7, row0 = (it & 127) * 256;
            if (bi < 2) rowop_item<1>(hblk(F, CB_KS + bi), row0, F.in[6] + 128, nullptr, F.tid);
            else rowop_item<1>(hblk(F, CB_KW + bi - 2), row0, F.in[6] + 256, nullptr, F.tid);
            it = wq_take(F, nx);
        }
        if (F.G < 64) {
            for (int kv = 0; kv < 2; ++kv) {
                pg8::Gemm g{hblk(F, kv ? CB_VC : CB_KC), (const bf16*)(F.ws + WS_CW) + (size_t)kv * 256 * 2048, 4096, 256, 2048}; pg8::StaticOrder S; S.init(4096, 256, F.G, (int)blockIdx.x);
                pg8::EpiF32 E{(float*)(F.ws + WS_CPR) + (size_t)kv * 4096 * 256, 256};
                for (size_t e = (size_t)blockIdx.x * NTHREADS + F.tid; e < (size_t)4096 * 256; e += (size_t)F.G * NTHREADS) ((float*)(F.ws + WS_CPR2))[(size_t)kv * 4096 * 256 + e] = 0.f;
                __syncthreads();
                pg8::gemm_phase<pg8::EpiF32, pg8::StaticOrder, false, true>(F.lds, g, S, E);
            }
        }
    }
    if (!fold) SEAM(2);
    if (IN(3)) {
        const int NCT = (fold && CT_IN_TAIL) ? 0 : 256;
        gu32* cmp_done = F.ctl + CW_Q + 64 * 20; gu32* st_done = F.ctl + CW_Q + 64 * 21;
        bool cmp_ok = (fold && CT_IN_TAIL), st_ok = false;
        const int n3 = NCT + 128 + 1024 + 1024 + (defer3 ? P0_DEFER3 / 16 : 0);
        for (int it = wq_first(F, 1); it < n3;) {
            const unsigned nx = wq_issue(F, 1);
            if (it < NCT) {
                cmp_tail_unit(F, it);
                asm volatile("s_waitcnt vmcnt(0)" ::: "memory");
                __syncthreads();
                if (F.tid == 0) { __threadfence(); __hip_atomic_fetch_add(cmp_done, 1u, RLX_AGENT); }
            } else if (it < NCT + 128) {
                ret_state_unit(F, it - NCT);
                asm volatile("s_waitcnt vmcnt(0)" ::: "memory");
                __syncthreads();
                if (F.tid == 0) { __threadfence(); __hip_atomic_fetch_add(st_done, 1u, RLX_AGENT); }
            } else if (it < NCT + 128 + 1024) {
                if (!cmp_ok) {
                    if (F.tid < 64) {
                        unsigned sp = 0;
                        while ((unsigned)__builtin_amdgcn_readfirstlane(__hip_atomic_load(cmp_done, RLX_AGENT)) < (unsigned)NCT) { __builtin_amdgcn_s_sleep(2); if (++sp > (1u << 22)) break; }
                        __builtin_amdgcn_fence(__ATOMIC_ACQUIRE, "agent");
                        asm volatile("s_waitcnt vmcnt(0)" ::: "memory");
                    }
                    __syncthreads();
                    cmp_ok = true;
                }
                nsa_unit<0>(F, it - NCT - 128);
            } else if (it >= NCT + 128 + 1024 + 1024) {
                const int i0 = P0_NITEMS - P0_DEFER3 + 16 * (it - (NCT + 128 + 1024 + 1024));
                int ld = F.tid & 63; asm volatile("" : "+v"(ld));
                p0_weight_pair(F, i0 + F.wave, i0 + 8 + F.wave, ld);
            } else {
                if (!st_ok) {
                    if (F.tid < 64) {
                        unsigned sp = 0;
                        while ((unsigned)__builtin_amdgcn_readfirstlane(__hip_atomic_load(st_done, RLX_AGENT)) < 128u) { __builtin_amdgcn_s_sleep(2); if (++sp > (1u << 22)) break; }
                        __builtin_amdgcn_fence(__ATOMIC_ACQUIRE, "agent");
                        asm volatile("s_waitcnt vmcnt(0)" ::: "memory");
                    }
                    __syncthreads();
                    st_ok = true;
                }
                retention_unit<0>(F, it - NCT - 128 - 1024);
            }
            it = wq_take(F, nx);
        }
    }
    SEAM(3);
    if (IN(5)) {
        pg8::Gemm g{MIX, (const bf16*)(F.ws + WS_W0OUT), MROWS, DM, 2048}; pg8::StaticOrder S; S.init(MROWS, DM, F.G, (int)blockIdx.x);
        pg8::EpiRes2 E{F.in[0], F.out, XN, (float*)(F.ws + WS_CTL + 512 * 1024), DM};
        pg8::gemm_phase<pg8::EpiRes2, pg8::StaticOrder, false, true>(F.lds, g, S, E);
    }
    SEAM(5);
    if (IN(7)) {
        pg8::Gemm g{XN, (const bf16*)(F.ws + WS_W1IN), MROWS, N1, DM}; pg8::StaticOrder S; S.init(MROWS, N1, F.G, (int)blockIdx.x);
        pg8::EpiHS E{hblk(F, 0), HBLK, (const float*)(F.ws + WS_CTL + 512 * 1024), 1.f / DM, NORM_EPS, 8, CB_CZ, CB_CZ + 8, CB_DZ, CB_DZ + 4};
        pg8::gemm_phase<pg8::EpiHS, pg8::StaticOrder, true, true>(F.lds, g, S, E);
    }
    SEAM(7);
    if (IN(8)) {
        if (FX_DIL && ((const float*)(F.ws + WS_MISC + FXB_OFF))[2] <= att::FX_MAX) {
            if (DIL_KG_RES) { if (F.tid < 128) ((LAS float*)(F.lds + XTRA_OFF))[F.tid] = F.in[21][F.tid]; __syncthreads(); }
            for (int it = wq_first(F, 3); it < 1536 + 256;) {
                const unsigned nx = wq_issue(F, 3);
                if (it < 256) { if (!(DBG_SKIP & 16)) conv_unit<0>(F, it); } else if (!(DBG_SKIP & 32)) dil_unit<true>(F, it - 256);
                it = wq_take(F, nx);
            }
        } else {
            for (int it = wq_first(F, 3); it < 1536 + 256;) {
                const unsigned nx = wq_issue(F, 3);
                if (it < 256) { if (!(DBG_SKIP & 16)) conv_unit<0>(F, it); } else if (!(DBG_SKIP & 32)) dil_unit<false>(F, it - 256);
                it = wq_take(F, nx);
            }
        }
    }
#if (REPEAT_MASK >> 8) & 1
    xcd_barrier(bar);
    if (IN(8)) {
        for (int it = wq_first(F, 11); it < 1536 + 256;) {
            const unsigned nx = wq_issue(F, 11);
            if (it < 256) { if (!(REP8_SKIP & 1)) conv_unit<CONV_VAR>(F, it); } else if (!(REP8_SKIP & 2)) dil_unit<true>(F, it - 256);
            it = wq_take(F, nx);
        }
    }
#endif
    SEAM(8);
    if (IN(10)) { dil_combine(F); if (!CONV_FIN_IN_UNIT) conv_finalize(F); }
#if (REPEAT_MASK >> 10) & 1
    xcd_barrier(bar); if (IN(10)) { dil_combine(F); }
#endif
    SEAM(10);
    if (IN(11)) {
        pg8::Gemm g{MIX, (const bf16*)(F.ws + WS_W1OUT), MROWS, DM, K1OUT}; pg8::StaticOrder S; S.init(MROWS, DM, F.G, (int)blockIdx.x);
        pg8::EpiRes E{F.out, F.out, DM};
        pg8::gemm_phase<pg8::EpiRes, pg8::StaticOrder, false, true>(F.lds, g, S, E);
    }
#undef IN
#undef INR
#undef SEAM
}

#ifndef MK_CUTS
#define MK_CUTS 0
#endif
extern "C" void kernel_launch(void* const* d_in, const int* in_sizes, int n_in, void* d_out, int out_size, void* d_ws, size_t ws_size, hipStream_t stream) {
    static int grid = 0;
    if (grid == 0) {
        if (n_in != 22 || out_size != MROWS * DM || ws_size < WS_END) { fprintf(stderr, "kernel_launch: unexpected shapes (n_in %d, out %d, ws %zu)\n", n_in, out_size, ws_size); grid = -1; return; }
        int dev = 0, cus = 0, per_cu = 0;
        if (hipGetDevice(&dev) != hipSuccess || hipDeviceGetAttribute(&cus, hipDeviceAttributeMultiprocessorCount, dev) != hipSuccess) { grid = -1; return; }
        if (hipFuncSetAttribute((const void*)hybrid_fwd, hipFuncAttributeMaxDynamicSharedMemorySize, LDS_BYTES) != hipSuccess) { fprintf(stderr, "kernel_launch: hipFuncSetAttribute failed\n"); grid = -1; return; }
        if (hipOccupancyMaxActiveBlocksPerMultiprocessor(&per_cu, (const void*)hybrid_fwd, NTHREADS, LDS_BYTES) != hipSuccess || per_cu < 1)
            fprintf(stderr, "kernel_launch: note: occupancy query reports %d workgroups per CU\n", per_cu);
        (void)hipGetLastError();
        grid = cus;
        if (grid > 256) grid = 256;
    }
    if (grid < 0) return;
    if (hipMemsetAsync((char*)d_ws + WS_CTL, 0, CTL_ZERO_BYTES, stream) != hipSuccess) return;
    Args a{};
    for (int i = 0; i < 22; ++i) a.in[i] = (const float*)d_in[i];
    a.out = (float*)d_out; a.ws = (unsigned char*)d_ws;
#if MK_CUTS
    for (int p = 0; p < N_PHASES; ++p) { a.ph_lo = p; a.ph_hi = p + 1; hipLaunchKernelGGL(hybrid_fwd, dim3(grid), dim3(NTHREADS), LDS_BYTES, stream, a); }
#else
    a.ph_lo = 0; a.ph_hi = N_PHASES;
    hipLaunchKernelGGL(hybrid_fwd, dim3(grid), dim3(NTHREADS), LDS_BYTES, stream, a);
#endif
}
```
